# Optimizing an MI355X kernel written in HIP

```python
import jax, jax.numpy as jnp
from jax import lax
import numpy as np

D_MODEL = 1024
BATCH = 4
SEQ = 8192
DEPTH = 1

CHUNK = 64
MIX_WIDTH = D_MODEL
HEAD_DIM = 64
CONV_WIDTH = MIX_WIDTH // 2
RWKV_WIDTH = MIX_WIDTH - CONV_WIDTH
CONV_GROUPS = CONV_WIDTH // HEAD_DIM
RWKV_HEADS = RWKV_WIDTH // HEAD_DIM
CONV_K = 3
DECAY_LORA = 64
AAA_LORA = 64
GATE_LORA = 128
N_EXPERTS = 32
TOP_K = 4
D_FF = D_MODEL
SWIGLU_LIMIT = 7.0
SWIGLU_ALPHA = 1.702
MOE_BLOCK = 128
NORM_EPS = 1e-5
GN_EPS = HEAD_DIM * 1e-5

CONV_COLS = 3 * CONV_WIDTH
RWKV_COLS = 3 * RWKV_WIDTH + DECAY_LORA + AAA_LORA + GATE_LORA
IN_COLS = CONV_COLS + RWKV_COLS

kernel_name = "hymba_conv_rwkv7_moe_encoder"


def rms_norm(x, g):
    xf = x.astype(jnp.float32)
    y = xf * lax.rsqrt(jnp.mean(xf * xf, axis=-1, keepdims=True) + NORM_EPS)
    return (y * g.astype(jnp.float32)).astype(x.dtype)


def group_rms_norm(y, g, groups):
    lead = y.shape[:-1]
    yf = y.astype(jnp.float32).reshape(*lead, groups, -1)
    yf = yf * lax.rsqrt(jnp.mean(yf * yf, axis=-1, keepdims=True) + NORM_EPS)
    return (yf.reshape(*lead, -1) * g.astype(jnp.float32)).astype(y.dtype)


def token_shift_lerp(p, mu):
    prev = jnp.pad(p, ((0, 0), (1, 0), (0, 0)))[:, :-1]
    return p + (prev - p) * mu


def causal_depthwise_conv(z, w):
    C = z.shape[-1]
    return lax.conv_general_dilated(
        z, w.reshape(CONV_K, 1, C).astype(z.dtype), window_strides=(1,),
        padding=[(CONV_K - 1, 0)], dimension_numbers=("NWC", "WIO", "NWC"),
        feature_group_count=C)


def short_conv_mixer(p, conv_w, conv_norm_g):
    u, b_gate, c_gate = jnp.split(p, 3, axis=-1)
    y = b_gate * causal_depthwise_conv(c_gate * u, conv_w)
    return group_rms_norm(y, conv_norm_g, CONV_GROUPS)


def wkv7_scan(r, w, k, v, kk, a):
    B_, S_, H, N = r.shape
    n_chunks = S_ // CHUNK

    def to_chunks(t):
        return t.reshape(B_, n_chunks, CHUNK, H, N).transpose(1, 2, 0, 3, 4)

    def frame_step(state, inp):
        r_t, w_t, k_t, v_t, kk_t, a_t = inp
        sa = jnp.einsum("bhvk,bhk->bhv", state, -kk_t)
        state = (state * w_t[:, :, None, :]
                 + sa[..., None] * (kk_t * a_t)[:, :, None, :]
                 + v_t[..., None] * k_t[:, :, None, :])
        return state, jnp.einsum("bhvk,bhk->bhv", state, r_t)

    def chunk_step(state, chunk_inp):
        return lax.scan(frame_step, state, chunk_inp)

    state0 = jnp.zeros((B_, H, N, N), jnp.float32)
    _, out = lax.scan(chunk_step, state0, tuple(to_chunks(t) for t in (r, w, k, v, kk, a)))
    return out.transpose(2, 0, 1, 3, 4).reshape(B_, S_, H, N)


def rwkv7_mixer(p, mu, w0, w_up, a0, a_up, g_up, k_k, k_a, r_k, gn_w, gn_b):
    B_, S_, _ = p.shape
    f32 = jnp.float32
    q = token_shift_lerp(p, mu)
    i1 = RWKV_WIDTH
    i2 = 2 * RWKV_WIDTH
    i3 = 3 * RWKV_WIDTH
    i4 = i3 + DECAY_LORA
    i5 = i4 + AAA_LORA
    r, k, v, dw, da, dg = jnp.split(q, [i1, i2, i3, i4, i5], axis=-1)
    w_log = -jax.nn.softplus(-(w0 + jnp.tanh(dw) @ w_up).astype(f32)) - 0.5
    decay = jnp.exp(-jnp.exp(w_log))
    a = jax.nn.sigmoid((a0 + da @ a_up).astype(f32))
    g = jax.nn.sigmoid(dg) @ g_up

    def heads(t):
        return t.astype(f32).reshape(B_, S_, RWKV_HEADS, HEAD_DIM)

    kk = heads(k * k_k)
    kk = kk / jnp.maximum(jnp.linalg.norm(kk, axis=-1, keepdims=True), 1e-12)
    k_mod = k.astype(f32) * (1.0 + (a - 1.0) * k_a.astype(f32))
    r_h, k_h, v_h = heads(r), heads(k_mod), heads(v)
    a_h, w_h = heads(a), heads(decay)
    o = wkv7_scan(r_h, w_h, k_h, v_h, kk, a_h)
    mean = jnp.mean(o, axis=-1, keepdims=True)
    var = jnp.mean(jnp.square(o - mean), axis=-1, keepdims=True)
    o = ((o - mean) * lax.rsqrt(var + GN_EPS)).reshape(B_, S_, RWKV_WIDTH)
    o = o * gn_w.astype(f32) + gn_b.astype(f32)
    bonus = jnp.sum(r_h * k_h * r_k.astype(f32), axis=-1, keepdims=True) * v_h
    o = o + bonus.reshape(B_, S_, RWKV_WIDTH)
    return (o * g.astype(f32)).astype(p.dtype)


def moe_ffn(h, w_router, b_router, w_gu, b_gu, w_down, b_down):
    B_, S_, D = h.shape
    n_tok = B_ * S_
    t = h.reshape(n_tok, D)
    logits = (t @ w_router + b_router).astype(jnp.float32)
    top_logit, top_e = lax.top_k(logits, TOP_K)
    gates = jax.nn.softmax(top_logit, axis=-1)
    n_assign = n_tok * TOP_K
    flat_e = top_e.reshape(n_assign).astype(jnp.int32)
    flat_tok = jnp.arange(n_assign, dtype=jnp.int32) // TOP_K
    order = jnp.argsort(flat_e)
    sorted_e = flat_e[order]
    counts = jnp.bincount(flat_e, length=N_EXPERTS).astype(jnp.int32)
    padded = (counts + MOE_BLOCK - 1) // MOE_BLOCK * MOE_BLOCK
    pad_end = jnp.cumsum(padded)
    pad_start = pad_end - padded
    start = jnp.cumsum(counts) - counts
    rank = jnp.arange(n_assign, dtype=jnp.int32) - start[sorted_e]
    dest = jnp.zeros((n_assign,), jnp.int32).at[order].set(pad_start[sorted_e] + rank)
    n_slots = n_assign + N_EXPERTS * MOE_BLOCK
    n_blocks = n_slots // MOE_BLOCK
    slot_tok = jnp.full((n_slots,), n_tok, jnp.int32).at[dest].set(flat_tok)
    block_e = jnp.minimum(
        jnp.searchsorted(pad_end, jnp.arange(n_blocks, dtype=jnp.int32) * MOE_BLOCK, side="right"),
        N_EXPERTS - 1).astype(jnp.int32)
    t_pad = jnp.concatenate([t, jnp.zeros((1, D), t.dtype)], axis=0)
    xin = t_pad[slot_tok].reshape(n_blocks, MOE_BLOCK, D)

    def expert_block(args):
        xb, e = args
        gu = xb @ w_gu[e] + b_gu[e]
        gate, up = gu[:, :D_FF], gu[:, D_FF:]
        gate = jnp.minimum(gate, SWIGLU_LIMIT)
        up = jnp.clip(up, -SWIGLU_LIMIT, SWIGLU_LIMIT)
        act = (up + 1.0) * (gate * jax.nn.sigmoid(SWIGLU_ALPHA * gate))
        return act @ w_down[e] + b_down[e]

    y_slots = lax.map(expert_block, (xin, block_e)).reshape(n_slots, D)
    y = y_slots[dest].reshape(n_tok, TOP_K, D)
    out = jnp.einsum("tkd,tk->td", y, gates.astype(y.dtype))
    return out.reshape(B_, S_, D)


def setup_inputs(seed: int = 0) -> dict:
    key = jax.random.key(seed)
    ks = jax.random.split(key, 26)
    f32 = jnp.float32
    L = DEPTH

    def nrm(k, shape, scale):
        return jax.random.normal(k, shape, f32) * scale

    def gain(k, shape):
        return 1.0 + 0.02 * jax.random.normal(k, shape, f32)

    return {
        "x": nrm(ks[0], (BATCH, SEQ, D_MODEL), 1.0),
        "w_in": nrm(ks[1], (L, D_MODEL, IN_COLS), D_MODEL ** -0.5),
        "conv_w": nrm(ks[2], (L, CONV_K, CONV_WIDTH), CONV_K ** -0.5),
        "conv_norm_g": gain(ks[3], (L, CONV_WIDTH)),
        "rwkv_mu": jax.random.uniform(ks[4], (L, RWKV_COLS), f32, 0.0, 1.0),
        "w0": jax.random.uniform(ks[5], (L, RWKV_WIDTH), f32, -6.0, 0.0),
        "w_up": nrm(ks[6], (L, DECAY_LORA, RWKV_WIDTH), 0.5 * DECAY_LORA ** -0.5),
        "a0": nrm(ks[7], (L, RWKV_WIDTH), 0.5),
        "a_up": nrm(ks[8], (L, AAA_LORA, RWKV_WIDTH), 0.5 * AAA_LORA ** -0.5),
        "g_up": nrm(ks[9], (L, GATE_LORA, RWKV_WIDTH), GATE_LORA ** -0.5),
        "k_k": 0.85 + 0.05 * jax.random.normal(ks[10], (L, RWKV_WIDTH), f32),
        "k_a": 1.0 + 0.05 * jax.random.normal(ks[11], (L, RWKV_WIDTH), f32),
        "r_k": nrm(ks[12], (L, RWKV_HEADS, HEAD_DIM), 0.1),
        "gn_w": gain(ks[13], (L, RWKV_WIDTH)),
        "gn_b": nrm(ks[14], (L, RWKV_WIDTH), 0.01),
        "w_out": nrm(ks[15], (L, MIX_WIDTH, D_MODEL), MIX_WIDTH ** -0.5),
        "norm_mix_g": gain(ks[16], (L, D_MODEL)),
        "norm_ffn_g": gain(ks[17], (L, D_MODEL)),
        "w_router": nrm(ks[18], (L, D_MODEL, N_EXPERTS), D_MODEL ** -0.5),
        "b_router": nrm(ks[19], (L, N_EXPERTS), 0.01),
        "w_gu": nrm(ks[20], (L, N_EXPERTS, D_MODEL, 2 * D_FF), D_MODEL ** -0.5),
        "b_gu": nrm(ks[21], (L, N_EXPERTS, 2 * D_FF), 0.01),
        "w_down": nrm(ks[22], (L, N_EXPERTS, D_FF, D_MODEL), D_FF ** -0.5),
        "b_down": nrm(ks[23], (L, N_EXPERTS, D_MODEL), 0.01),
        "norm_final_g": gain(ks[24], (D_MODEL,)),
    }


def reference(x, w_in, conv_w, conv_norm_g, rwkv_mu, w0, w_up, a0, a_up, g_up, k_k, k_a, r_k,
              gn_w, gn_b, w_out, norm_mix_g, norm_ffn_g, w_router, b_router, w_gu, b_gu,
              w_down, b_down, norm_final_g):
    for l in range(DEPTH):
        h = rms_norm(x, norm_mix_g[l])
        p = h @ w_in[l]
        y_conv = short_conv_mixer(p[..., :CONV_COLS], conv_w[l], conv_norm_g[l])
        y_rwkv = rwkv7_mixer(p[..., CONV_COLS:], rwkv_mu[l], w0[l], w_up[l], a0[l], a_up[l],
                             g_up[l], k_k[l], k_a[l], r_k[l], gn_w[l], gn_b[l])
        y = jnp.concatenate([y_conv, y_rwkv], axis=-1)
        x = x + y @ w_out[l]
        h = rms_norm(x, norm_ffn_g[l])
        x = x + moe_ffn(h, w_router[l], b_router[l], w_gu[l], b_gu[l], w_down[l], b_down[l])
    return rms_norm(x, norm_final_g)
```

```cpp
#include <hip/hip_runtime.h>
#include <cstdio>
#include <cstdint>
namespace pg8 {
#define PG8_LAS __attribute__((address_space(3)))
typedef unsigned short bf16_t;
typedef short bf16x8 __attribute__((ext_vector_type(8)));
typedef float f32x4 __attribute__((ext_vector_type(4)));
typedef unsigned u32x4 __attribute__((ext_vector_type(4)));
constexpr int BM = 256, BK = 64, HALF = 128, HTB = HALF * BK * 2  , STAGE_BYTES = 8 * HTB, NXCD = 8, WGM = 8;

__host__ __device__ __forceinline__ int lds_byte(int r, int c) { const int st = (r >> 4) * 2 + (c >> 5), rr = r & 15, cc = c & 31, ob = rr * 64 + cc * 2; return st * 1024 + (ob ^ (((ob >> 9) & 1) << 5)); }
__host__ __device__ __forceinline__ void stage_rc(int b, int& R, int& C) { const int st = b / 1024, sb = b % 1024, swz = sb ^ (((sb >> 9) & 1) << 5); R = (st >> 1) * 16 + swz / 64; C = (st & 1) * 32 + (swz % 64) / 2; }
__host__ __device__ __forceinline__ int perm32(int rho) { const int n = rho >> 4, i = rho & 15; return 8 * (i >> 2) + 4 * n + (i & 3); }

struct Unit { int pm, pn, pb, e; };
struct Gemm { const bf16_t* A; const bf16_t* Bt; int M, N, K; };

struct StaticOrder {
    int nM, nN, nwg, G, c;
    __host__ __device__ void init(int M, int N, int G_, int c_) { nM = M / BM; nN = N / BM; nwg = nM * nN; G = G_; c = c_; }
    __host__ __device__ bool next(int i, Unit& u) const {
        const long L = (long)i * G + c; if (L >= nwg) return false;
        int wgid = (int)L; { const int q = nwg / NXCD, r = nwg % NXCD, xcd = wgid % NXCD, off = wgid / NXCD; wgid = (xcd < r ? xcd * (q + 1) : r * (q + 1) + (xcd - r) * q) + off; }
        const int nig = WGM * nN, gid = wgid / nig, fm = gid * WGM, gsz = (nM - fm) < WGM ? (nM - fm) : WGM;
        u.pm = fm + ((wgid % nig) % gsz); u.pn = (wgid % nig) / gsz; u.pb = u.pn; u.e = 0; return true;
    }
    __device__ __forceinline__ void a_ready(const Unit&) const {}
    __device__ __forceinline__ void done(const Unit&) const {}
};

__device__ __forceinline__ unsigned cvt_pk_bf16(float lo, float hi) { unsigned r; asm volatile("v_cvt_pk_bf16_f32 %0, %1, %2" : "=v"(r) : "v"(lo), "v"(hi)); return r; }
typedef float f32x2 __attribute__((ext_vector_type(2)));
__device__ __forceinline__ f32x2 gelu_pk(f32x2 v) {
    const f32x2 av = __builtin_elementwise_abs(v), d = av * 0.2316418882f + 1.0f;
    f32x2 t; t.x = __builtin_amdgcn_rcpf(d.x); t.y = __builtin_amdgcn_rcpf(d.y);
    f32x2 q = t * 0.5307027145f + (-0.7265760135f); q = q * t + 0.7107068705f; q = q * t + (-0.142248368f); q = q * t + 0.127414796f; q = q * t;
    const f32x2 s = (v * v) * (-0.72134752044f);
    f32x2 e; e.x = __builtin_amdgcn_exp2f(s.x); e.y = __builtin_amdgcn_exp2f(s.y);
    const f32x2 m = v * (q * e), r = v - m;
    f32x2 o; o.x = v.x < 0.f ? m.x : r.x; o.y = v.y < 0.f ? m.y : r.y; return o;
}

template <int ACT  > struct EpiBf16 {
    static constexpr bool PERM = true, AFTER_DRAIN = false; static_assert(ACT == 0 || ACT == 1, "EpiBf16: ACT is 0 (none) or 1 (gelu_pk)");
    bf16_t* O; int ldc; const float* bias; int split_cols; size_t split_stride; float scale0;
    __device__ __forceinline__ void operator()(const f32x4 (&acc)[2][2][4][2], const Unit& u, int wr, int wc, int fr, int fq) const {
        const int row0 = u.pm * BM + wr * 64 + fr; int colt = u.pn * BM; bf16_t* base = O;
        float sc = 1.f; if (split_cols) { const int t = colt / split_cols; base += (size_t)t * split_stride; colt -= t * split_cols; if (t == 0) sc = scale0; }
        const int col0 = colt + wc * 32 + 8 * fq, bcol0 = u.pn * BM + wc * 32 + 8 * fq;
        f32x4 bv[2][2];
#pragma unroll
        for (int bj = 0; bj < 2; ++bj)
#pragma unroll
            for (int n = 0; n < 2; ++n) bv[bj][n] = bias ? *(const f32x4*)(bias + bcol0 + bj * HALF + 4 * n) : (f32x4){0.f, 0.f, 0.f, 0.f};
#pragma unroll
        for (int ai = 0; ai < 2; ++ai)
#pragma unroll
            for (int m = 0; m < 4; ++m) { bf16_t* rowp = base + (size_t)(row0 + ai * HALF + m * 16) * ldc + col0;
#pragma unroll
                for (int bj = 0; bj < 2; ++bj) { f32x4 v0 = acc[ai][bj][m][0] + bv[bj][0], v1 = acc[ai][bj][m][1] + bv[bj][1];
                    if (ACT == 1) { f32x2 a = gelu_pk((f32x2){v0[0], v0[1]}), b = gelu_pk((f32x2){v0[2], v0[3]}), c = gelu_pk((f32x2){v1[0], v1[1]}), d = gelu_pk((f32x2){v1[2], v1[3]});
                        v0 = (f32x4){a.x, a.y, b.x, b.y}; v1 = (f32x4){c.x, c.y, d.x, d.y}; }
                    v0 = v0 * sc; v1 = v1 * sc; u32x4 w; w.x = cvt_pk_bf16(v0[0], v0[1]); w.y = cvt_pk_bf16(v0[2], v0[3]); w.z = cvt_pk_bf16(v1[0], v1[1]); w.w = cvt_pk_bf16(v1[2], v1[3]);
                    *(u32x4*)(rowp + bj * HALF) = w; } }
    }
};

template <class Epi, class Sched, bool ALIGN_EPI = false, bool SP2 = false>
__device__ __forceinline__ void gemm_phase(PG8_LAS unsigned char* lds, const Gemm g, const Sched& S, const Epi& E) {
    const int tid = threadIdx.x, wid = __builtin_amdgcn_readfirstlane(tid >> 6), lane = tid & 63, wr = wid >> 2, wc = wid & 3, fr = lane & 15, fq = lane >> 4;
    const int K = g.K, nt = K / BK;
    unsigned voffA[2], voffB[2];
#pragma unroll
    for (int i = 0; i < 2; ++i) { int R, C; stage_rc(tid * 16 + i * 8192, R, C); const int Rb = Epi::PERM ? ((R & ~31) + perm32(R & 31)) : R;
        voffA[i] = (unsigned)(R * K + C) * 2u; voffB[i] = (unsigned)(Rb * K + C) * 2u; }
    const size_t kstep = (size_t)(BK * 2);
    const size_t hstep = (size_t)HALF * K * 2;
    const size_t tstep = 2 * hstep;
    const unsigned ldsw = (unsigned)wid * 1024u;
    const int aoff = lds_byte(wr * 64 + fr, fq * 8), boff = lds_byte(wc * 32 + fr, fq * 8);
#define PG8_SA(b, h) (((b) * 2 + (h)) * HTB)
#define PG8_SB(b, h) ((4 + (b) * 2 + (h)) * HTB)
#define PG8_STAGE(bufoff, gbase, voff) do { _Pragma("unroll") for (int _i = 0; _i < 2; ++_i) \
        __builtin_amdgcn_global_load_lds((const unsigned*)((const char*)(gbase) + (voff)[_i]), (PG8_LAS unsigned*)(lds + (bufoff) + ldsw + _i * 8192), 16, 0, 0); } while (0)
#define PG8_LDA(dst, b, h) do { _Pragma("unroll") for (int m = 0; m < 4; ++m) _Pragma("unroll") for (int k = 0; k < 2; ++k) dst[m][k] = *(const PG8_LAS bf16x8*)(lds + PG8_SA(b, h) + aoff + m * 2048 + k * 1024); } while (0)
#define PG8_LDB(dst, b, h) do { _Pragma("unroll") for (int n = 0; n < 2; ++n) _Pragma("unroll") for (int k = 0; k < 2; ++k) dst[n][k] = *(const PG8_LAS bf16x8*)(lds + PG8_SB(b, h) + boff + n * 2048 + k * 1024); } while (0)
#define PG8_MMA(ai, bj, At, Bt) do { __builtin_amdgcn_s_setprio(1); _Pragma("unroll") for (int m = 0; m < 4; ++m) _Pragma("unroll") for (int n = 0; n < 2; ++n) _Pragma("unroll") for (int k = 0; k < 2; ++k) \
        acc[ai][bj][m][n] = __builtin_amdgcn_mfma_f32_16x16x32_bf16(Bt[n][k], At[m][k], acc[ai][bj][m][n], 0, 0, 0); __builtin_amdgcn_s_setprio(0); } while (0)
#define PG8_WAIT_V(n) asm volatile("s_waitcnt vmcnt(" #n ")" ::: "memory")
#define PG8_WAIT_L(n) asm volatile("s_waitcnt lgkmcnt(" #n ")" ::: "memory")
#define PG8_BAR __builtin_amdgcn_s_barrier()
#define PG8_SCHED __builtin_amdgcn_sched_barrier(0)
    Unit cur, nxt; int ui = 0;
    if (!S.next(0, cur)) return;
    f32x4 acc[2][2][4][2];
#pragma unroll
    for (int a = 0; a < 2; ++a)
#pragma unroll
        for (int b = 0; b < 2; ++b)
#pragma unroll
            for (int m = 0; m < 4; ++m)
#pragma unroll
                for (int n = 0; n < 2; ++n) acc[a][b][m][n] = (f32x4){0.f, 0.f, 0.f, 0.f};
    bf16x8 At[4][2], B0[2][2], B1[2][2];
    const char* cA = (const char*)g.A + (size_t)cur.pm * tstep; const char* cB = (const char*)g.Bt + (size_t)cur.pb * tstep;
    S.a_ready(cur);
    if constexpr (SP2) {
        PG8_STAGE(PG8_SB(0, 0), cB, voffB); PG8_STAGE(PG8_SB(0, 1), cB + hstep, voffB); PG8_STAGE(PG8_SA(0, 0), cA, voffA); PG8_STAGE(PG8_SA(0, 1), cA + hstep, voffA);
        if (wr == 1) PG8_BAR;
        PG8_WAIT_V(2); PG8_BAR;
        PG8_STAGE(PG8_SB(1, 0), cB + kstep, voffB); PG8_STAGE(PG8_SA(1, 0), cA + kstep, voffA); PG8_STAGE(PG8_SB(1, 1), cB + hstep + kstep, voffB);
        PG8_WAIT_V(6); PG8_BAR;
    } else {
        PG8_STAGE(PG8_SB(0, 0), cB, voffB); PG8_STAGE(PG8_SA(0, 0), cA, voffA); PG8_STAGE(PG8_SB(0, 1), cB + hstep, voffB); PG8_STAGE(PG8_SA(0, 1), cA + hstep, voffA);
        if (wr == 1) PG8_BAR;
        PG8_WAIT_V(4); PG8_BAR;
        PG8_STAGE(PG8_SB(1, 0), cB + kstep, voffB); PG8_STAGE(PG8_SA(1, 0), cA + kstep, voffA); PG8_STAGE(PG8_SB(1, 1), cB + hstep + kstep, voffB);
        PG8_WAIT_V(6); PG8_BAR;
    }
    for (;;) {
        const bool has_next = S.next(ui + 1, nxt);
        const char* nA = has_next ? (const char*)g.A + (size_t)nxt.pm * tstep : cA; const char* nB = has_next ? (const char*)g.Bt + (size_t)nxt.pb * tstep : cB;
        for (int t = 0; t < nt; t += 2) {
            const bool last = (t == nt - 2);
            const char* a1 = cA + (size_t)(t + 1) * kstep;
            const char* a2 = last ? nA : cA + (size_t)(t + 2) * kstep; const char* b2 = last ? nB : cB + (size_t)(t + 2) * kstep;
            const char* a3 = a2 + kstep; const char* b3 = b2 + kstep;
            if (last && has_next) S.a_ready(nxt);
            if constexpr (SP2) {
            PG8_LDB(B0, 0, 0); PG8_LDB(B1, 0, 1); PG8_SCHED; PG8_LDA(At, 0, 0); PG8_STAGE(PG8_SA(1, 1), a1 + hstep, voffA);
            PG8_WAIT_V(8); PG8_WAIT_L(0); PG8_BAR; PG8_MMA(0, 0, At, B0); PG8_MMA(0, 1, At, B1); PG8_BAR; PG8_SCHED;
            PG8_LDA(At, 0, 1); PG8_STAGE(PG8_SB(0, 0), b2, voffB); PG8_STAGE(PG8_SB(0, 1), b2 + hstep, voffB); PG8_STAGE(PG8_SA(0, 0), a2, voffA);
            PG8_WAIT_V(8); PG8_WAIT_L(0); PG8_BAR; PG8_MMA(1, 0, At, B0); PG8_MMA(1, 1, At, B1); PG8_BAR; PG8_SCHED;
            PG8_LDB(B0, 1, 0); PG8_LDB(B1, 1, 1); PG8_SCHED; PG8_LDA(At, 1, 0); PG8_STAGE(PG8_SA(0, 1), a2 + hstep, voffA);
            PG8_WAIT_V(8); PG8_WAIT_L(0); PG8_BAR; PG8_MMA(0, 0, At, B0); PG8_MMA(0, 1, At, B1); PG8_BAR; PG8_SCHED;
            PG8_LDA(At, 1, 1); PG8_STAGE(PG8_SB(1, 0), b3, voffB); PG8_STAGE(PG8_SB(1, 1), b3 + hstep, voffB); PG8_STAGE(PG8_SA(1, 0), a3, voffA);
            PG8_WAIT_V(8); PG8_WAIT_L(0); PG8_BAR; PG8_MMA(1, 0, At, B0); PG8_MMA(1, 1, At, B1); PG8_BAR; PG8_SCHED;
            } else {
            PG8_LDB(B0, 0, 0); PG8_SCHED; PG8_LDA(At, 0, 0); PG8_STAGE(PG8_SA(1, 1), a1 + hstep, voffA);
            PG8_WAIT_L(8); PG8_BAR; PG8_WAIT_L(0); PG8_MMA(0, 0, At, B0); PG8_BAR; PG8_SCHED;
            PG8_LDB(B1, 0, 1); PG8_STAGE(PG8_SB(0, 0), b2, voffB);
            PG8_BAR; PG8_WAIT_L(0); PG8_MMA(0, 1, At, B1); PG8_BAR;
            PG8_LDA(At, 0, 1); PG8_STAGE(PG8_SA(0, 0), a2, voffA);
            PG8_BAR; PG8_WAIT_L(0); PG8_MMA(1, 0, At, B0); PG8_BAR; PG8_SCHED;
            PG8_STAGE(PG8_SB(0, 1), b2 + hstep, voffB);
            PG8_WAIT_V(6); PG8_BAR; PG8_MMA(1, 1, At, B1); PG8_BAR;
            PG8_LDB(B0, 1, 0); PG8_SCHED; PG8_LDA(At, 1, 0); PG8_STAGE(PG8_SA(0, 1), a2 + hstep, voffA);
            PG8_WAIT_L(8); PG8_BAR; PG8_WAIT_L(0); PG8_MMA(0, 0, At, B0); PG8_BAR; PG8_SCHED;
            PG8_LDB(B1, 1, 1); PG8_STAGE(PG8_SB(1, 0), b3, voffB);
            PG8_BAR; PG8_WAIT_L(0); PG8_MMA(0, 1, At, B1); PG8_BAR;
            PG8_LDA(At, 1, 1); PG8_STAGE(PG8_SA(1, 0), a3, voffA);
            PG8_BAR; PG8_WAIT_L(0); PG8_MMA(1, 0, At, B0); PG8_BAR; PG8_SCHED;
            PG8_STAGE(PG8_SB(1, 1), b3 + hstep, voffB);
            PG8_WAIT_V(6); PG8_BAR; PG8_MMA(1, 1, At, B1); PG8_BAR;
            }
        }
        if constexpr (ALIGN_EPI) { if (wr == 0) PG8_BAR; }
        if constexpr (!Epi::AFTER_DRAIN) { E(acc, cur, wr, wc, fr, fq); S.done(cur); }
        if (!has_next) break;
#pragma unroll
        for (int a = 0; a < 2; ++a)
#pragma unroll
            for (int b = 0; b < 2; ++b)
#pragma unroll
                for (int m = 0; m < 4; ++m)
#pragma unroll
                    for (int n = 0; n < 2; ++n) acc[a][b][m][n] = (f32x4){0.f, 0.f, 0.f, 0.f};
        cur = nxt; cA = nA; cB = nB; ++ui;
        if constexpr (ALIGN_EPI) { if (wr == 1) PG8_BAR; }
    }
    PG8_WAIT_V(0);
    if constexpr (!ALIGN_EPI) { if (wr == 0) PG8_BAR; }
    PG8_BAR;
    if constexpr (Epi::AFTER_DRAIN) { E.fused(acc, cur, wr, wc, fr, fq, lds, wid, lane); S.done(cur); }
#undef PG8_SA
#undef PG8_SB
#undef PG8_STAGE
#undef PG8_LDA
#undef PG8_LDB
#undef PG8_MMA
#undef PG8_WAIT_V
#undef PG8_WAIT_L
#undef PG8_BAR
#undef PG8_SCHED
}
}
#define GAS __attribute__((address_space(1)))
#define LAS __attribute__((address_space(3)))
typedef unsigned short bf16;
typedef unsigned v4u __attribute__((ext_vector_type(4)));
typedef float f32x4 __attribute__((ext_vector_type(4)));
typedef short bf16x8 __attribute__((ext_vector_type(8)));
typedef GAS unsigned gu32;
typedef GAS unsigned long long gu64;
#define RLX_AGENT __ATOMIC_RELAXED, __HIP_MEMORY_SCOPE_AGENT
#define LDS_WAIT() asm volatile("s_waitcnt lgkmcnt(0)" ::: "memory")
#define VM_WAIT() asm volatile("s_waitcnt vmcnt(0)" ::: "memory")
__device__ __forceinline__ unsigned long long rt() { return __builtin_amdgcn_s_memrealtime(); }
__device__ __forceinline__ unsigned f2bf(float f) { unsigned u = __builtin_bit_cast(unsigned, f); return (u + 0x7fffu + ((u >> 16) & 1u)) >> 16; }
__device__ __forceinline__ unsigned pk2(float lo, float hi) { return f2bf(lo) | (f2bf(hi) << 16); }

#define XB_TMO      128
#define XB_XCNT(j)  (256  + 64 * (j))
#define XB_XSUB(j)  (1280 + 64 * (j))
#define XB_XGEN(j)  (2304 + 64 * (j))
#define XB_TOP      3328
#define XB_TOPGEN   3392
#define XCD_BAR_WORDS 3456
#define XB_SPIN_CAP (1u << 18)

__device__ __forceinline__ unsigned xb_ld(unsigned* p)              { return __hip_atomic_load(p, __ATOMIC_RELAXED, __HIP_MEMORY_SCOPE_AGENT); }
__device__ __forceinline__ unsigned xb_add(unsigned* p, unsigned v) { return __hip_atomic_fetch_add(p, v, __ATOMIC_RELAXED, __HIP_MEMORY_SCOPE_AGENT); }
__device__ __forceinline__ unsigned xb_xcc_id() { return (unsigned)__builtin_amdgcn_s_getreg((3 << 11) | 20) & 0xFu; }
#define XB_SPIN(cond, bar) do { unsigned _sp = 0; while (cond) { __builtin_amdgcn_s_sleep(1); \
    if ((++_sp & 255u) == 0u) { if (xb_ld(&(bar)[XB_TMO])) break; if (_sp > XB_SPIN_CAP) { atomicAdd(&(bar)[XB_TMO], 1u); break; } } } } while (0)

struct XcdBarrier {
    unsigned* bar; unsigned x;
    volatile LAS unsigned* st;
};

__device__ __forceinline__ XcdBarrier xcd_barrier_post(unsigned* bar, volatile LAS unsigned* st) {
    XcdBarrier b; b.bar = bar; b.x = xb_xcc_id(); b.st = st;
    if (threadIdx.x == 0) (void)xb_add(&bar[XB_XCNT(b.x)], 1u);
    return b;
}
__device__ __forceinline__ void xcd_barrier_complete(unsigned* bar, unsigned x, unsigned& nloc, unsigned& nx) {
    const unsigned G = gridDim.x * gridDim.y * gridDim.z;
    unsigned sum, cnt, mine, sp = 0u;
    for (;;) {
        sum = 0u; cnt = 0u; mine = 0u;
#pragma unroll
        for (unsigned j = 0; j < 16; ++j) { const unsigned c = xb_ld(&bar[XB_XCNT(j)]); sum += c; cnt += (c > 0u) ? 1u : 0u; mine = (j == x) ? c : mine; }
        if (sum == G) break;
        __builtin_amdgcn_s_sleep(1);
        if ((++sp & 255u) == 0u) { if (xb_ld(&bar[XB_TMO])) break; if (sp > XB_SPIN_CAP) { atomicAdd(&bar[XB_TMO], 1u); break; } }
    }
    nloc = mine > 0u ? mine : 1u; nx = cnt > 0u ? cnt : 1u;
}

__device__ __forceinline__ void xcd_barrier(const XcdBarrier& b) {
    asm volatile("s_waitcnt vmcnt(0)" ::: "memory");
    __syncthreads();
    if (threadIdx.x == 0) {
        unsigned* bar = b.bar;
        __builtin_amdgcn_s_waitcnt(0);
        unsigned nloc = b.st[0], nx = b.st[1];
        if (nloc == 0u) { xcd_barrier_complete(bar, b.x, nloc, nx); b.st[0] = nloc; b.st[1] = nx; }
        const unsigned old = xb_add(&bar[XB_XSUB(b.x)], 1u);
        const unsigned gen = old / nloc;
        if (old + 1u == (gen + 1u) * nloc) {
            __builtin_amdgcn_fence(__ATOMIC_RELEASE, "agent");
            asm volatile("s_waitcnt vmcnt(0)" ::: "memory");
            const unsigned og = xb_add(&bar[XB_TOP], 1u);
            const unsigned tg = og / nx;
            if (og + 1u == (tg + 1u) * nx) xb_add(&bar[XB_TOPGEN], 1u);
            else XB_SPIN(xb_ld(&bar[XB_TOPGEN]) == tg, bar);
            __builtin_amdgcn_fence(__ATOMIC_ACQUIRE, "agent");
            xb_add(&bar[XB_XGEN(b.x)], 1u);
            asm volatile("s_waitcnt vmcnt(0)" ::: "memory");
        } else {
            XB_SPIN(xb_ld(&bar[XB_XGEN(b.x)]) == gen, bar);
            __builtin_amdgcn_fence(__ATOMIC_ACQUIRE, "agent");
            asm volatile("s_waitcnt vmcnt(0)" ::: "memory");
        }
    }
    __syncthreads();
}

#ifndef PG8_SP2
#define PG8_SP2 true
#endif
#ifndef PG8_ALIGN
#define PG8_ALIGN true
#endif
namespace pg8 {
struct EpiResF32 {
    static constexpr bool PERM = false, AFTER_DRAIN = false;
    const float* base; float* C; int ldc;
    __device__ __forceinline__ void operator()(const f32x4 (&acc)[2][2][4][2], const Unit& u, int wr, int wc, int fr, int fq) const {
        const int row0 = u.pm * BM + wr * 64 + fr, col0 = u.pn * BM + wc * 32 + 4 * fq;
#pragma unroll
        for (int ai = 0; ai < 2; ++ai)
#pragma unroll
            for (int m = 0; m < 4; ++m) { const size_t off = (size_t)(row0 + ai * HALF + m * 16) * ldc + col0;
#pragma unroll
                for (int bj = 0; bj < 2; ++bj)
#pragma unroll
                    for (int n = 0; n < 2; ++n) { const f32x4 bs = *(const f32x4*)(base + off + bj * HALF + n * 16); *(f32x4*)(C + off + bj * HALF + n * 16) = bs + acc[ai][bj][m][n]; }
                asm volatile("" ::: "memory"); }
    }
};
struct EpiBiasBf16 {
    static constexpr bool PERM = true, AFTER_DRAIN = false;
    bf16_t* O; int ldc; const float* bias; int bstride;
    __device__ __forceinline__ void operator()(const f32x4 (&acc)[2][2][4][2], const Unit& u, int wr, int wc, int fr, int fq) const {
        const int row0 = u.pm * BM + wr * 64 + fr; const int col0 = u.pn * BM + wc * 32 + 8 * fq;
        const float* bp = bias ? bias + (size_t)u.e * bstride + col0 : nullptr;
        f32x4 bv[2][2];
#pragma unroll
        for (int bj = 0; bj < 2; ++bj)
#pragma unroll
            for (int n = 0; n < 2; ++n) bv[bj][n] = bias ? *(const f32x4*)(bp + bj * HALF + 4 * n) : (f32x4){0.f, 0.f, 0.f, 0.f};
#pragma unroll
        for (int ai = 0; ai < 2; ++ai)
#pragma unroll
            for (int m = 0; m < 4; ++m) { bf16_t* rowp = O + (size_t)(row0 + ai * HALF + m * 16) * ldc + col0;
#pragma unroll
                for (int bj = 0; bj < 2; ++bj) { const f32x4 v0 = acc[ai][bj][m][0] + bv[bj][0], v1 = acc[ai][bj][m][1] + bv[bj][1];
                    u32x4 w; w.x = cvt_pk_bf16(v0[0], v0[1]); w.y = cvt_pk_bf16(v0[2], v0[3]); w.z = cvt_pk_bf16(v1[0], v1[1]); w.w = cvt_pk_bf16(v1[2], v1[3]);
                    *(u32x4*)(rowp + bj * HALF) = w; } }
    }
};
struct EpiSwiGLU {
    static constexpr bool PERM = true, AFTER_DRAIN = false;
    bf16_t* O; int ldc; const float* bias;
    __device__ __forceinline__ void operator()(const f32x4 (&acc)[2][2][4][2], const Unit& u, int wr, int wc, int fr, int fq) const {
        const int row0 = u.pm * BM + wr * 64 + fr; const int ff0 = u.pn * HALF + wc * 32 + 8 * fq;
        const float* bp = bias + (size_t)u.e * 2048 + ff0;
        f32x4 bg[2], bu[2];
#pragma unroll
        for (int n = 0; n < 2; ++n) { bg[n] = *(const f32x4*)(bp + 4 * n); bu[n] = *(const f32x4*)(bp + 1024 + 4 * n); }
#pragma unroll
        for (int ai = 0; ai < 2; ++ai)
#pragma unroll
            for (int m = 0; m < 4; ++m) { bf16_t* rowp = O + (size_t)(row0 + ai * HALF + m * 16) * ldc + ff0;
                float o[8];
#pragma unroll
                for (int n = 0; n < 2; ++n) { const f32x4 g = acc[ai][0][m][n] + bg[n], up = acc[ai][1][m][n] + bu[n];
#pragma unroll
                    for (int j = 0; j < 4; ++j) { const float gg = fminf(g[j], 7.0f), uu = fminf(fmaxf(up[j], -7.0f), 7.0f);
                        const float sg = __builtin_amdgcn_rcpf(1.0f + __builtin_amdgcn_exp2f(-1.702f * 1.44269504089f * gg));
                        o[4 * n + j] = (uu + 1.0f) * (gg * sg); } }
                u32x4 w; w.x = cvt_pk_bf16(o[0], o[1]); w.y = cvt_pk_bf16(o[2], o[3]); w.z = cvt_pk_bf16(o[4], o[5]); w.w = cvt_pk_bf16(o[6], o[7]);
                *(u32x4*)rowp = w; }
    }
};
struct MoeOrder {
    const int* tile_e; int MT, nN, G, c;
    __device__ bool next(int i, Unit& u) const {
        const long L = (long)i * G + c; if (L >= (long)MT * nN) return false;
        const int mt = (int)(L / nN), pn = (int)(L % nN); const int e = __builtin_amdgcn_readfirstlane((int)__hip_atomic_load((const unsigned*)tile_e + mt, __ATOMIC_RELAXED, __HIP_MEMORY_SCOPE_AGENT));
        u.pm = mt; u.pn = pn; u.pb = e * nN + pn; u.e = e; return true;
    }
    __device__ __forceinline__ void a_ready(const Unit&) const {}
    __device__ __forceinline__ void done(const Unit&) const {}
};
}

constexpr int NWAVES = 8;
constexpr int BATCH = 4, SEQ = 8192, D = 1024, M = BATCH * SEQ;
constexpr int IN_COLS = 3328, CW = 512, RW = 512, NH = 8, HD = 64;
constexpr int NE = 32, TOPK = 4, FF = 1024;
constexpr int SLOT_ROWS = M * TOPK + NE * 256;
constexpr int MT_MAX = SLOT_ROWS / 256;
constexpr float NORM_EPS = 1e-5f, GN_EPS = 64e-5f;
#ifndef MK_N_LAUNCHES
#define MK_N_LAUNCHES 10
#endif
constexpr int NPHASE = 10;
constexpr int N_LAUNCHES = MK_N_LAUNCHES;

constexpr size_t MiB = 1u << 20;
constexpr size_t WS_CTL = 0, CTL_ZERO_BYTES = 1 * MiB;
constexpr size_t WS_WIN = 2 * MiB;
constexpr size_t WS_WOUT = 9 * MiB;
constexpr size_t WS_LORA = 11 * MiB;
constexpr size_t WS_TOKE = 12 * MiB, WS_TOKG = WS_TOKE + 512 * 1024, WS_TOKR = WS_TOKG + 512 * 1024, WS_DEST = WS_TOKR + 512 * 1024;
constexpr size_t WS_BDOT = 14 * MiB;
constexpr size_t WS_WGU = 16 * MiB;
constexpr size_t WS_WDN = 144 * MiB;
constexpr size_t WS_XN = 208 * MiB;
constexpr size_t WS_Y = 272 * MiB;
constexpr size_t WS_P = 336 * MiB;
constexpr size_t WS_SR = 544 * MiB, WS_SW = 608 * MiB, WS_SK = 672 * MiB, WS_SV = 736 * MiB, WS_SKK = 800 * MiB, WS_SB = 864 * MiB;
constexpr size_t WS_SG = 928 * MiB;
constexpr size_t WS_XIN = 272 * MiB;
constexpr size_t WS_YSLOT = WS_XIN;
constexpr size_t WS_ACT = 544 * MiB;
constexpr size_t WS_X1 = 816 * MiB;
constexpr size_t WS_END = 960 * MiB;
static_assert(WS_ACT + (size_t)SLOT_ROWS * 1024 * 2 <= WS_X1 && WS_X1 + (size_t)M * D * 4 <= WS_END && WS_XIN + (size_t)SLOT_ROWS * 1024 * 2 <= WS_ACT, "ws map");
constexpr int CW_BAR = 4096;
constexpr int CW_CNT = 8192;
constexpr int CW_MT = 8256;
constexpr int CW_TILE_E = 8320;
constexpr int RING_BYTES = 131072, LDSCTL_OFF = RING_BYTES, MISC_OFF = LDSCTL_OFF + 320, LDS_BYTES = 147456;

typedef unsigned u32x2 __attribute__((ext_vector_type(2)));
typedef float f32x2 __attribute__((ext_vector_type(2)));

__device__ __forceinline__ float wave_sum(float v) {
#pragma unroll
    for (int o = 1; o < 64; o <<= 1) v += __shfl_xor(v, o);
    return v;
}
__device__ __forceinline__ float bf_lo(unsigned w) { return __builtin_bit_cast(float, w << 16); }
__device__ __forceinline__ float bf_hi(unsigned w) { return __builtin_bit_cast(float, w & 0xffff0000u); }
__device__ __forceinline__ float fast_sigmoid(float x) { return __builtin_amdgcn_rcpf(1.0f + __builtin_amdgcn_exp2f(-1.44269504089f * x)); }
__device__ __forceinline__ float fast_tanh(float x) { const float xc = fminf(fmaxf(x, -15.f), 15.f); const float e = __builtin_amdgcn_exp2f(2.88539008178f * xc); return 1.0f - 2.0f * __builtin_amdgcn_rcpf(e + 1.0f); }

__device__ __forceinline__ void p0_transpose_item(const float* W, int K, int N, bf16* WT, int dst_row0, LAS float* scr, int k0, int n0, int lane) {
#pragma unroll 8
    for (int i = 0; i < 32; ++i) { const int kk = 2 * i + (lane >> 5); scr[kk * 33 + (lane & 31)] = W[(size_t)(k0 + kk) * N + n0 + (lane & 31)]; }
    LDS_WAIT(); asm volatile("" ::: "memory");
    const int c = lane & 7;
#pragma unroll
    for (int j = 0; j < 4; ++j) { const int n = (lane >> 3) + 8 * j; const LAS float* s = scr + (8 * c) * 33 + n;
        v4u o; o.x = pk2(s[0 * 33], s[1 * 33]); o.y = pk2(s[2 * 33], s[3 * 33]); o.z = pk2(s[4 * 33], s[5 * 33]); o.w = pk2(s[6 * 33], s[7 * 33]);
        *(GAS v4u*)(WT + (size_t)(dst_row0 + n) * K + k0 + 8 * c) = o; }
    LDS_WAIT(); asm volatile("" ::: "memory");
}

struct Args { const float* in[25]; float* out; unsigned char* ws; int ph_lo, ph_hi, li, pad; };

__global__ void __launch_bounds__(NWAVES * 64, 2) mk_fwd(Args args) {
    extern __shared__ __attribute__((aligned(16))) unsigned char lds_raw[];
    LAS unsigned char* lds = (LAS unsigned char*)lds_raw;
    volatile LAS unsigned* MISC = (volatile LAS unsigned*)(lds + MISC_OFF);
    const int tid = threadIdx.x, lane = tid & 63, wave = __builtin_amdgcn_readfirstlane(tid >> 6);
    const int G = gridDim.x; const int vcu = (G % 8 == 0) ? ((int)blockIdx.x % 8) * (G / 8) + (int)blockIdx.x / 8 : (int)blockIdx.x;
    const int gw = vcu * NWAVES + wave, NGW = G * NWAVES;
    unsigned char* ws = args.ws;
    unsigned* ctl = (unsigned*)(ws + WS_CTL);
    const float* x = args.in[0];
    bf16* WIN_T = (bf16*)(ws + WS_WIN); bf16* WOUT_T = (bf16*)(ws + WS_WOUT); bf16* WGU_T = (bf16*)(ws + WS_WGU); bf16* WDN_T = (bf16*)(ws + WS_WDN);
    bf16* WUP_T = (bf16*)(ws + WS_LORA); bf16* AUP_T = WUP_T + 512 * 64; bf16* GUP_T = AUP_T + 512 * 64;
    bf16* XN = (bf16*)(ws + WS_XN); bf16* Y = (bf16*)(ws + WS_Y); bf16* P = (bf16*)(ws + WS_P);
    float* SR = (float*)(ws + WS_SR); float* SW = (float*)(ws + WS_SW); float* SK = (float*)(ws + WS_SK); float* SV = (float*)(ws + WS_SV); float* SKK = (float*)(ws + WS_SKK); float* SB = (float*)(ws + WS_SB);
    bf16* SG = (bf16*)(ws + WS_SG); float* BDOT = (float*)(ws + WS_BDOT);
    float* X1 = (float*)(ws + WS_X1); bf16* XIN = (bf16*)(ws + WS_XIN); bf16* ACT = (bf16*)(ws + WS_ACT); bf16* YSLOT = (bf16*)(ws + WS_YSLOT);
    int* TOKE = (int*)(ws + WS_TOKE); float* TOKG = (float*)(ws + WS_TOKG); int* TOKR = (int*)(ws + WS_TOKR); int* DEST = (int*)(ws + WS_DEST);

    for (int u = tid; u < (LDS_BYTES - LDSCTL_OFF) / 4; u += NWAVES * 64) ((LAS unsigned*)(lds + LDSCTL_OFF))[u] = 0u;
    __syncthreads();
    XcdBarrier bar; bar.bar = ctl + CW_BAR; bar.x = 0; bar.st = nullptr;
    if (N_LAUNCHES == 1) bar = xcd_barrier_post(ctl + CW_BAR, MISC + 8);
#define GRID_BAR() do { if (N_LAUNCHES == 1) xcd_barrier(bar); } while (0)
    const int lo = args.ph_lo, hi = args.ph_hi;
#ifndef PHASE_MASK
#define PHASE_MASK 0x3ff
#endif
#define IN(k) (((PHASE_MASK >> (k)) & 1) && lo <= (k) && (k) < hi)
#define BOTH(k) (IN(k) && IN((k) + 1))

    if (IN(0)) {
        LAS float* scr = (LAS float*)(lds + wave * 16384);
        constexpr int I_IN = 16 * 104, I_OUT = 16 * 32, I_DN = 32 * 512, I_GU = 32 * 1024, I_WUP = 16, I_AUP = 16, I_GUP = 32;
        constexpr int NITEMS = I_IN + I_OUT + I_DN + I_GU + I_WUP + I_AUP + I_GUP;
        for (int it = gw; it < NITEMS; it += NGW) {
            int r = it;
            if (r < I_IN) { const int kb = r / 104, nb = r % 104; p0_transpose_item(args.in[1], 1024, IN_COLS, WIN_T, 32 * nb, scr, 64 * kb, 32 * nb, lane); continue; } r -= I_IN;
            if (r < I_OUT) { const int kb = r / 32, nb = r % 32; p0_transpose_item(args.in[15], 1024, 1024, WOUT_T, 32 * nb, scr, 64 * kb, 32 * nb, lane); continue; } r -= I_OUT;
            if (r < I_DN) { const int e = r / 512, q = r % 512, kb = q / 32, nb = q % 32; p0_transpose_item(args.in[22] + (size_t)e * 1024 * 1024, 1024, 1024, WDN_T + (size_t)e * 1024 * 1024, 32 * nb, scr, 64 * kb, 32 * nb, lane); continue; } r -= I_DN;
            if (r < I_GU) { const int e = r / 1024, q = r % 1024, kb = q / 64, nb = q % 64; const int n0 = 32 * nb, half = n0 >> 10, j = n0 & 1023;
                p0_transpose_item(args.in[20] + (size_t)e * 1024 * 2048, 1024, 2048, WGU_T + (size_t)e * 2048 * 1024, 256 * (j >> 7) + 128 * half + (j & 127), scr, 64 * kb, n0, lane); continue; } r -= I_GU;
            if (r < I_WUP) { p0_transpose_item(args.in[6], 64, 512, WUP_T, 32 * r, scr, 0, 32 * r, lane); continue; } r -= I_WUP;
            if (r < I_AUP) { p0_transpose_item(args.in[8], 64, 512, AUP_T, 32 * r, scr, 0, 32 * r, lane); continue; } r -= I_AUP;
            { const int kb = r / 16, nb = r % 16; p0_transpose_item(args.in[9], 128, 512, GUP_T, 32 * nb, scr, 64 * kb, 32 * nb, lane); }
        }
        const float* gm = args.in[16];
        for (int m = gw; m < M; m += NGW) {
            const GAS f32x4* xr = (const GAS f32x4*)(x + (size_t)m * D) + lane; f32x4 v[4]; float s = 0.f;
#pragma unroll
            for (int j = 0; j < 4; ++j) { v[j] = xr[64 * j]; s += (v[j].x * v[j].x + v[j].y * v[j].y) + (v[j].z * v[j].z + v[j].w * v[j].w); }
            const float rstd = 1.0f / sqrtf(wave_sum(s) * (1.f / D) + NORM_EPS);
            GAS unsigned long long* o8 = (GAS unsigned long long*)(XN + (size_t)m * D) + lane;
#pragma unroll
            for (int j = 0; j < 4; ++j) { const f32x4 g4 = ((const GAS f32x4*)gm)[lane + 64 * j];
                o8[64 * j] = (unsigned long long)pk2(v[j].x * rstd * g4.x, v[j].y * rstd * g4.y) | ((unsigned long long)pk2(v[j].z * rstd * g4.z, v[j].w * rstd * g4.w) << 32); }
        }
        if (BOTH(0)) GRID_BAR();
    }

    if (IN(1)) {
        pg8::Gemm g{XN, WIN_T, M, IN_COLS, D}; pg8::StaticOrder S; S.init(M, IN_COLS, G, (int)blockIdx.x);
        pg8::EpiBiasBf16 E{P, IN_COLS, nullptr, 0};
        pg8::gemm_phase<pg8::EpiBiasBf16, pg8::StaticOrder, PG8_ALIGN, PG8_SP2>(lds, g, S, E);
        if (BOTH(1)) GRID_BAR();
    }

    if (IN(2)) {
        const float* mu = args.in[4]; const float* w0 = args.in[5]; const float* a0 = args.in[7]; const float* k_k = args.in[10]; const float* k_a = args.in[11]; const float* r_k = args.in[12];
        const float* conv_w = args.in[2]; const float* conv_g = args.in[3];
        const int fr = lane & 15, fq = lane >> 4, h = wave;
        for (int tile = vcu; tile < M / 64; tile += G) {
            const int T0 = tile * 64;
            {
                const int c8 = (tid & 31) * 8, tr = tid >> 5;
                const f32x4 mu0 = *(const f32x4*)(mu + 1536 + c8), mu1 = *(const f32x4*)(mu + 1536 + c8 + 4);
                const float mm[8] = {mu0.x, mu0.y, mu0.z, mu0.w, mu1.x, mu1.y, mu1.z, mu1.w};
#pragma unroll
                for (int i = 0; i < 4; ++i) { const int tk = tr + 16 * i, t = T0 + tk;
                    const v4u cur = *(const v4u*)(P + (size_t)t * IN_COLS + 3072 + c8);
                    v4u prv = (v4u){0u, 0u, 0u, 0u}; if ((t % SEQ) != 0) prv = *(const v4u*)(P + (size_t)(t - 1) * IN_COLS + 3072 + c8);
                    const unsigned cw[4] = {cur.x, cur.y, cur.z, cur.w}, pw[4] = {prv.x, prv.y, prv.z, prv.w}; float f[8];
#pragma unroll
                    for (int j = 0; j < 4; ++j) { const float c0 = bf_lo(cw[j]), c1 = bf_hi(cw[j]), p0 = bf_lo(pw[j]), p1 = bf_hi(pw[j]);
                        const float q0 = c0 + (p0 - c0) * mm[2 * j], q1 = c1 + (p1 - c1) * mm[2 * j + 1];
                        f[2 * j] = (c8 < 64) ? fast_tanh(q0) : ((c8 < 128) ? q0 : fast_sigmoid(q0)); f[2 * j + 1] = (c8 < 64) ? fast_tanh(q1) : ((c8 < 128) ? q1 : fast_sigmoid(q1)); }
                    v4u o; o.x = pk2(f[0], f[1]); o.y = pk2(f[2], f[3]); o.z = pk2(f[4], f[5]); o.w = pk2(f[6], f[7]);
                    *(LAS v4u*)(lds + tk * 528 + c8 * 2) = o; }
            }
            __syncthreads();
            for (int tt = 0; tt < 4; ++tt) {
                const int tk = 16 * tt + fr, t = T0 + tk; const bool first = (t % SEQ) == 0;
                pg8::bf16x8 Lf[8];
#pragma unroll
                for (int ks = 0; ks < 8; ++ks) Lf[ks] = *(const LAS pg8::bf16x8*)(lds + tk * 528 + (ks * 32 + fq * 8) * 2);
                f32x4 aw[4], aa[4], ag[4];
#pragma unroll
                for (int m = 0; m < 4; ++m) { aw[m] = (f32x4){0.f, 0.f, 0.f, 0.f}; aa[m] = aw[m]; ag[m] = aw[m];
                    const int row = h * 64 + 16 * m + fr;
#pragma unroll
                    for (int ks = 0; ks < 2; ++ks) { const pg8::bf16x8 wf = *(const pg8::bf16x8*)(WUP_T + row * 64 + ks * 32 + fq * 8); aw[m] = __builtin_amdgcn_mfma_f32_16x16x32_bf16(wf, Lf[ks], aw[m], 0, 0, 0); }
#pragma unroll
                    for (int ks = 0; ks < 2; ++ks) { const pg8::bf16x8 wf = *(const pg8::bf16x8*)(AUP_T + row * 64 + ks * 32 + fq * 8); aa[m] = __builtin_amdgcn_mfma_f32_16x16x32_bf16(wf, Lf[2 + ks], aa[m], 0, 0, 0); }
#pragma unroll
                    for (int ks = 0; ks < 4; ++ks) { const pg8::bf16x8 wf = *(const pg8::bf16x8*)(GUP_T + row * 128 + ks * 32 + fq * 8); ag[m] = __builtin_amdgcn_mfma_f32_16x16x32_bf16(wf, Lf[4 + ks], ag[m], 0, 0, 0); }
                }
                const size_t prow = (size_t)t * IN_COLS + 1536 + h * 64 + 4 * fq; const size_t orow = (size_t)t * RW + h * 64 + 4 * fq;
                f32x4 av[4], kq[4]; float ss = 0.f;
#pragma unroll
                for (int m = 0; m < 4; ++m) { const int c = h * 64 + 16 * m + 4 * fq;
                    const f32x4 a0v = *(const f32x4*)(a0 + c), muk = *(const f32x4*)(mu + 512 + c), kkv = *(const f32x4*)(k_k + c);
                    const u32x2 cu = *(const u32x2*)(P + prow + 512 + 16 * m); u32x2 pu = (u32x2){0u, 0u}; if (!first) pu = *(const u32x2*)(P + prow - IN_COLS + 512 + 16 * m);
                    const f32x4 cf = (f32x4){bf_lo(cu.x), bf_hi(cu.x), bf_lo(cu.y), bf_hi(cu.y)}, pf = (f32x4){bf_lo(pu.x), bf_hi(pu.x), bf_lo(pu.y), bf_hi(pu.y)};
                    kq[m] = cf + (pf - cf) * muk;
#pragma unroll
                    for (int j = 0; j < 4; ++j) { av[m][j] = fast_sigmoid(a0v[j] + aa[m][j]); const float kr = kq[m][j] * kkv[j]; ss += kr * kr; }
                }
                ss += __shfl_xor(ss, 16); ss += __shfl_xor(ss, 32);
                const float inv = 1.0f / fmaxf(sqrtf(ss), 1e-12f);
                f32x4 km[4];
#pragma unroll
                for (int m = 0; m < 4; ++m) { const int c = h * 64 + 16 * m + 4 * fq; const f32x4 kkv = *(const f32x4*)(k_k + c), kav = *(const f32x4*)(k_a + c);
                    const f32x4 kk = kq[m] * kkv * inv; const f32x4 b = kk * av[m]; km[m] = kq[m] * (1.0f + (av[m] - 1.0f) * kav);
                    *(f32x4*)(SKK + orow + 16 * m) = kk; *(f32x4*)(SB + orow + 16 * m) = b; *(f32x4*)(SK + orow + 16 * m) = km[m]; }
                float bd = 0.f;
#pragma unroll
                for (int m = 0; m < 4; ++m) { const int c = h * 64 + 16 * m + 4 * fq; const f32x4 mur = *(const f32x4*)(mu + c), rkv = *(const f32x4*)(r_k + c);
                    const u32x2 cu = *(const u32x2*)(P + prow + 16 * m); u32x2 pu = (u32x2){0u, 0u}; if (!first) pu = *(const u32x2*)(P + prow - IN_COLS + 16 * m);
                    const f32x4 cf = (f32x4){bf_lo(cu.x), bf_hi(cu.x), bf_lo(cu.y), bf_hi(cu.y)}, pf = (f32x4){bf_lo(pu.x), bf_hi(pu.x), bf_lo(pu.y), bf_hi(pu.y)};
                    const f32x4 rq = cf + (pf - cf) * mur; *(f32x4*)(SR + orow + 16 * m) = rq;
                    const f32x4 pr = rq * km[m] * rkv; bd += (pr.x + pr.y) + (pr.z + pr.w); }
                bd += __shfl_xor(bd, 16); bd += __shfl_xor(bd, 32);
                if (fq == 0) BDOT[(size_t)t * NH + h] = bd;
#pragma unroll
                for (int m = 0; m < 4; ++m) { const int c = h * 64 + 16 * m + 4 * fq; const f32x4 muv = *(const f32x4*)(mu + 1024 + c), w0v = *(const f32x4*)(w0 + c);
                    const u32x2 cu = *(const u32x2*)(P + prow + 1024 + 16 * m); u32x2 pu = (u32x2){0u, 0u}; if (!first) pu = *(const u32x2*)(P + prow - IN_COLS + 1024 + 16 * m);
                    const f32x4 cf = (f32x4){bf_lo(cu.x), bf_hi(cu.x), bf_lo(cu.y), bf_hi(cu.y)}, pf = (f32x4){bf_lo(pu.x), bf_hi(pu.x), bf_lo(pu.y), bf_hi(pu.y)};
                    *(f32x4*)(SV + orow + 16 * m) = cf + (pf - cf) * muv;
                    f32x4 dec;
#pragma unroll
                    for (int j = 0; j < 4; ++j) { const float wl = w0v[j] + aw[m][j];
                        const float sp = fmaxf(-wl, 0.f) + __logf(1.0f + __expf(-fabsf(wl)));
                        dec[j] = __expf(-__expf(-sp - 0.5f)); }
                    *(f32x4*)(SW + orow + 16 * m) = dec;
                    u32x2 go; go.x = pk2(ag[m].x, ag[m].y); go.y = pk2(ag[m].z, ag[m].w); *(u32x2*)(SG + orow + 16 * m) = go; }
            }
            for (int i = 0; i < 8; ++i) { const int t = T0 + wave * 8 + i, tb = t % SEQ; const int c8 = lane * 8;
                float z[3][8], bgate[8];
#pragma unroll
                for (int d = 0; d < 3; ++d) {
                    const int back = 2 - d;
                    if (tb >= back) { const v4u uu = *(const v4u*)(P + (size_t)(t - back) * IN_COLS + c8), cc = *(const v4u*)(P + (size_t)(t - back) * IN_COLS + 1024 + c8);
                        const unsigned uw[4] = {uu.x, uu.y, uu.z, uu.w}, cw2[4] = {cc.x, cc.y, cc.z, cc.w};
#pragma unroll
                        for (int j = 0; j < 4; ++j) { z[d][2 * j] = bf_lo(uw[j]) * bf_lo(cw2[j]); z[d][2 * j + 1] = bf_hi(uw[j]) * bf_hi(cw2[j]); } }
                    else {
#pragma unroll
                        for (int j = 0; j < 8; ++j) z[d][j] = 0.f; }
                }
                { const v4u bb = *(const v4u*)(P + (size_t)t * IN_COLS + 512 + c8); const unsigned bw[4] = {bb.x, bb.y, bb.z, bb.w};
#pragma unroll
                  for (int j = 0; j < 4; ++j) { bgate[2 * j] = bf_lo(bw[j]); bgate[2 * j + 1] = bf_hi(bw[j]); } }
                float yv[8], ss = 0.f;
#pragma unroll
                for (int j = 0; j < 8; ++j) { const float cv = conv_w[c8 + j] * z[0][j] + conv_w[512 + c8 + j] * z[1][j] + conv_w[1024 + c8 + j] * z[2][j]; yv[j] = bgate[j] * cv; ss += yv[j] * yv[j]; }
                ss += __shfl_xor(ss, 1); ss += __shfl_xor(ss, 2); ss += __shfl_xor(ss, 4);
                const float rs = 1.0f / sqrtf(ss * (1.0f / 64.0f) + NORM_EPS);
                v4u o; o.x = pk2(yv[0] * rs * conv_g[c8], yv[1] * rs * conv_g[c8 + 1]); o.y = pk2(yv[2] * rs * conv_g[c8 + 2], yv[3] * rs * conv_g[c8 + 3]);
                o.z = pk2(yv[4] * rs * conv_g[c8 + 4], yv[5] * rs * conv_g[c8 + 5]); o.w = pk2(yv[6] * rs * conv_g[c8 + 6], yv[7] * rs * conv_g[c8 + 7]);
                *(v4u*)(Y + (size_t)t * D + c8) = o; }
            __syncthreads();
        }
        if (BOTH(2)) GRID_BAR();
    }

    if (IN(3)) {
        if (wave == 0 && (int)blockIdx.x < BATCH * NH) {
            const int b = (int)blockIdx.x / NH, h = (int)blockIdx.x % NH;
            typedef const __attribute__((address_space(4))) float* cfp;
            const float gnw = args.in[13][h * 64 + lane], gnb = args.in[14][h * 64 + lane];
            float S[64];
#pragma unroll
            for (int k = 0; k < 64; ++k) S[k] = 0.f;
            for (int t = 0; t < SEQ; ++t) {
                const size_t base = (size_t)(b * SEQ + t) * RW + h * 64;
                cfp kkp = (cfp)(SKK + base); cfp bp = (cfp)(SB + base); cfp wp = (cfp)(SW + base); cfp kp = (cfp)(SK + base); cfp rp = (cfp)(SR + base);
                const float vt = SV[base + lane];
                const float gt = bf_lo((unsigned)SG[base + lane]); const float bdt = BDOT[(size_t)(b * SEQ + t) * NH + h];
                float sa0 = 0.f, sa1 = 0.f, sa2 = 0.f, sa3 = 0.f;
#pragma unroll
                for (int k = 0; k < 64; k += 4) { sa0 += S[k] * kkp[k]; sa1 += S[k + 1] * kkp[k + 1]; sa2 += S[k + 2] * kkp[k + 2]; sa3 += S[k + 3] * kkp[k + 3]; }
                const float sa = -((sa0 + sa1) + (sa2 + sa3));
                float o0 = 0.f, o1 = 0.f, o2 = 0.f, o3 = 0.f;
#pragma unroll
                for (int k = 0; k < 64; k += 4) {
                    S[k] = S[k] * wp[k] + (sa * bp[k] + vt * kp[k]); S[k + 1] = S[k + 1] * wp[k + 1] + (sa * bp[k + 1] + vt * kp[k + 1]);
                    S[k + 2] = S[k + 2] * wp[k + 2] + (sa * bp[k + 2] + vt * kp[k + 2]); S[k + 3] = S[k + 3] * wp[k + 3] + (sa * bp[k + 3] + vt * kp[k + 3]);
                    o0 += S[k] * rp[k]; o1 += S[k + 1] * rp[k + 1]; o2 += S[k + 2] * rp[k + 2]; o3 += S[k + 3] * rp[k + 3]; }
                const float o = (o0 + o1) + (o2 + o3);
                const float mean = wave_sum(o) * (1.0f / 64.0f); const float dv = o - mean; const float var = wave_sum(dv * dv) * (1.0f / 64.0f);
                const float on = dv * (1.0f / sqrtf(var + GN_EPS));
                const float yv = (on * gnw + gnb + bdt * vt) * gt;
                Y[(size_t)(b * SEQ + t) * D + 512 + h * 64 + lane] = (bf16)f2bf(yv);
            }
        }
        if (BOTH(3)) GRID_BAR();
    }

    if (IN(4)) {
        pg8::Gemm g{Y, WOUT_T, M, D, D}; pg8::StaticOrder S; S.init(M, D, G, (int)blockIdx.x);
        pg8::EpiResF32 E{x, X1, D};
        pg8::gemm_phase<pg8::EpiResF32, pg8::StaticOrder, PG8_ALIGN, PG8_SP2>(lds, g, S, E);
        if (BOTH(4)) GRID_BAR();
    }

    if (IN(5)) {
        const float* gf = args.in[17]; const float* wr = args.in[18]; const float* br = args.in[19];
        LAS float* wrT = (LAS float*)lds;
        for (int i = tid; i < 1024 * 32; i += NWAVES * 64) { const int k = i >> 5, e = i & 31; wrT[e * 1024 + k] = wr[i] * gf[k]; }
        __syncthreads();
        for (int t = gw; t < M; t += NGW) {
            const GAS f32x4* xr = (const GAS f32x4*)(X1 + (size_t)t * D) + lane; f32x4 v[4]; float s = 0.f;
#pragma unroll
            for (int j = 0; j < 4; ++j) { v[j] = xr[64 * j]; s += (v[j].x * v[j].x + v[j].y * v[j].y) + (v[j].z * v[j].z + v[j].w * v[j].w); }
            const float rstd = 1.0f / sqrtf(wave_sum(s) * (1.f / D) + NORM_EPS);
            GAS unsigned long long* o8 = (GAS unsigned long long*)(XN + (size_t)t * D) + lane;
#pragma unroll
            for (int j = 0; j < 4; ++j) { const f32x4 g4 = ((const GAS f32x4*)gf)[lane + 64 * j];
                o8[64 * j] = (unsigned long long)pk2(v[j].x * rstd * g4.x, v[j].y * rstd * g4.y) | ((unsigned long long)pk2(v[j].z * rstd * g4.z, v[j].w * rstd * g4.w) << 32); }
            float mylg = -3.0e38f;
#pragma unroll 2
            for (int e = 0; e < 32; ++e) { float p = 0.f;
#pragma unroll
                for (int j = 0; j < 4; ++j) { const f32x4 w4 = *(const LAS f32x4*)(wrT + e * 1024 + 4 * lane + 256 * j); p += (v[j].x * w4.x + v[j].y * w4.y) + (v[j].z * w4.z + v[j].w * w4.w); }
                const float sfull = wave_sum(p) * rstd + br[e]; if (lane == e) mylg = sfull; }
            int te[4]; float tv[4];
#pragma unroll
            for (int r = 0; r < 4; ++r) { float mx = mylg;
#pragma unroll
                for (int o = 1; o < 64; o <<= 1) mx = fmaxf(mx, __shfl_xor(mx, o));
                const unsigned long long bm = __ballot(mylg == mx); const int bi = __builtin_amdgcn_readfirstlane((int)__builtin_ctzll(bm));
                te[r] = bi; tv[r] = mx; if (lane == bi) mylg = -3.0e38f; }
            const float e1 = __expf(tv[1] - tv[0]), e2 = __expf(tv[2] - tv[0]), e3 = __expf(tv[3] - tv[0]); const float inv = 1.0f / (1.0f + e1 + e2 + e3);
            if (lane < 4) { const int ee = lane == 0 ? te[0] : (lane == 1 ? te[1] : (lane == 2 ? te[2] : te[3])); const float gg = (lane == 0 ? 1.0f : (lane == 1 ? e1 : (lane == 2 ? e2 : e3))) * inv;
                const int rk = (int)__hip_atomic_fetch_add(ctl + CW_CNT + ee, 1u, __ATOMIC_RELAXED, __HIP_MEMORY_SCOPE_AGENT);
                TOKE[(size_t)t * 4 + lane] = ee; TOKG[(size_t)t * 4 + lane] = gg; TOKR[(size_t)t * 4 + lane] = rk; }
        }
        __syncthreads();
        if (BOTH(5)) GRID_BAR();
    }

    if (IN(6)) {
        unsigned cntv = 0u; if (lane < 32) cntv = __hip_atomic_load(ctl + CW_CNT + lane, __ATOMIC_RELAXED, __HIP_MEMORY_SCOPE_AGENT);
        const int padded = (int)((cntv + 255u) & ~255u); int incl = padded;
#pragma unroll
        for (int o = 1; o < 32; o <<= 1) { const int n = __shfl_up(incl, o); if (lane >= o) incl += n; }
        const int pstart = incl - padded;
        if (blockIdx.x == 0 && wave == 0) {
            if (lane < 32) { const int t0 = pstart >> 8, nt = padded >> 8; for (int i = 0; i < nt; ++i) ctl[CW_TILE_E + t0 + i] = (unsigned)lane; }
            if (lane == 31) ctl[CW_MT] = (unsigned)(incl >> 8);
        }
        for (int t = gw; t < M; t += NGW) {
            const int4 e4 = *(const int4*)(TOKE + (size_t)t * 4), r4 = *(const int4*)(TOKR + (size_t)t * 4);
            const int ee[4] = {e4.x, e4.y, e4.z, e4.w}, rr[4] = {r4.x, r4.y, r4.z, r4.w}; int sl[4];
            const v4u h0 = *(const v4u*)(XN + (size_t)t * D + lane * 8), h1 = *(const v4u*)(XN + (size_t)t * D + 512 + lane * 8);
#pragma unroll
            for (int j = 0; j < 4; ++j) { sl[j] = __shfl(pstart, ee[j]) + rr[j];
                *(v4u*)(XIN + (size_t)sl[j] * D + lane * 8) = h0; *(v4u*)(XIN + (size_t)sl[j] * D + 512 + lane * 8) = h1; }
            if (lane == 0) *(int4*)(DEST + (size_t)t * 4) = make_int4(sl[0], sl[1], sl[2], sl[3]);
        }
        if (BOTH(6)) GRID_BAR();
    }

    if (IN(7)) {
        const int MT = (int)__hip_atomic_load(ctl + CW_MT, __ATOMIC_RELAXED, __HIP_MEMORY_SCOPE_AGENT);
        pg8::Gemm g{XIN, WGU_T, SLOT_ROWS, 2048, D}; pg8::MoeOrder S{(const int*)(ctl + CW_TILE_E), MT, 8, G, (int)blockIdx.x};
        pg8::EpiSwiGLU E{ACT, FF, args.in[21]};
        pg8::gemm_phase<pg8::EpiSwiGLU, pg8::MoeOrder, PG8_ALIGN, PG8_SP2>(lds, g, S, E);
        if (BOTH(7)) GRID_BAR();
    }

    if (IN(8)) {
        const int MT = (int)__hip_atomic_load(ctl + CW_MT, __ATOMIC_RELAXED, __HIP_MEMORY_SCOPE_AGENT);
        pg8::Gemm g{ACT, WDN_T, SLOT_ROWS, 1024, FF}; pg8::MoeOrder S{(const int*)(ctl + CW_TILE_E), MT, 4, G, (int)blockIdx.x};
        pg8::EpiBiasBf16 E{YSLOT, D, args.in[23], 1024};
        pg8::gemm_phase<pg8::EpiBiasBf16, pg8::MoeOrder, PG8_ALIGN, PG8_SP2>(lds, g, S, E);
        if (BOTH(8)) GRID_BAR();
    }

    if (IN(9)) {
        const float* gfin = args.in[24];
        for (int t = gw; t < M; t += NGW) {
            const GAS f32x4* xr = (const GAS f32x4*)(X1 + (size_t)t * D) + lane; f32x4 v[4];
#pragma unroll
            for (int j = 0; j < 4; ++j) v[j] = xr[64 * j];
            const int4 d4 = *(const int4*)(DEST + (size_t)t * 4); const f32x4 g4 = *(const f32x4*)(TOKG + (size_t)t * 4);
            const int dd[4] = {d4.x, d4.y, d4.z, d4.w}; const float gg[4] = {g4.x, g4.y, g4.z, g4.w};
#pragma unroll
            for (int q = 0; q < 4; ++q) { const GAS u32x2* yr = (const GAS u32x2*)(YSLOT + (size_t)dd[q] * D) + lane;
#pragma unroll
                for (int j = 0; j < 4; ++j) { const u32x2 w = yr[64 * j]; v[j].x += gg[q] * bf_lo(w.x); v[j].y += gg[q] * bf_hi(w.x); v[j].z += gg[q] * bf_lo(w.y); v[j].w += gg[q] * bf_hi(w.y); } }
            float s = 0.f;
#pragma unroll
            for (int j = 0; j < 4; ++j) s += (v[j].x * v[j].x + v[j].y * v[j].y) + (v[j].z * v[j].z + v[j].w * v[j].w);
            const float rstd = 1.0f / sqrtf(wave_sum(s) * (1.f / D) + NORM_EPS);
            GAS f32x4* orow = (GAS f32x4*)(args.out + (size_t)t * D) + lane;
#pragma unroll
            for (int j = 0; j < 4; ++j) { const f32x4 gq = ((const GAS f32x4*)gfin)[lane + 64 * j]; orow[64 * j] = v[j] * rstd * gq; }
        }
    }
#undef IN
#undef BOTH
#undef GRID_BAR
}

extern "C" void kernel_launch(void* const* d_in, const int* in_sizes, int n_in, void* d_out, int out_size, void* d_ws, size_t ws_size, hipStream_t stream) {
    static int grid = 0;
    if (grid == 0) {
        if (n_in != 25 || in_sizes[0] != M * D || out_size != M * D || ws_size < WS_END) { fprintf(stderr, "kernel_launch: unexpected shapes / workspace (%d inputs, ws %zu)\n", n_in, ws_size); grid = -1; return; }
        int dev = 0, cus = 0, per_cu = 0;
        if (hipGetDevice(&dev) != hipSuccess || hipDeviceGetAttribute(&cus, hipDeviceAttributeMultiprocessorCount, dev) != hipSuccess) { grid = -1; return; }
        if (hipFuncSetAttribute((const void*)mk_fwd, hipFuncAttributeMaxDynamicSharedMemorySize, LDS_BYTES) != hipSuccess) { grid = -1; return; }
        if (hipOccupancyMaxActiveBlocksPerMultiprocessor(&per_cu, (const void*)mk_fwd, NWAVES * 64, LDS_BYTES) != hipSuccess || per_cu < 1) { fprintf(stderr, "kernel_launch: occupancy query says %d blocks per CU\n", per_cu); grid = -1; (void)hipGetLastError(); return; }
        (void)hipGetLastError();
        grid = cus;
    }
    if (grid < 0) return;
    if (hipMemsetAsync((char*)d_ws + WS_CTL, 0, CTL_ZERO_BYTES, stream) != hipSuccess) return;
    Args a{};
    for (int i = 0; i < 25; ++i) a.in[i] = (const float*)d_in[i];
    a.out = (float*)d_out; a.ws = (unsigned char*)d_ws;
    if (N_LAUNCHES == 1) { a.ph_lo = 0; a.ph_hi = NPHASE; a.li = 0; hipLaunchKernelGGL(mk_fwd, dim3(grid), dim3(NWAVES * 64), LDS_BYTES, stream, a); }
    else for (int li = 0; li < NPHASE; ++li) { a.ph_lo = li; a.ph_hi = li + 1; a.li = li; hipLaunchKernelGGL(mk_fwd, dim3(grid), dim3(NWAVES * 64), LDS_BYTES, stream, a); }
}
```

```cpp
#include <hip/hip_runtime.h>
#include <cstdio>
#include <cstdint>
namespace pg8 {
#define PG8_LAS __attribute__((address_space(3)))
typedef unsigned short bf16_t;
typedef short bf16x8 __attribute__((ext_vector_type(8)));
typedef float f32x4 __attribute__((ext_vector_type(4)));
typedef unsigned u32x4 __attribute__((ext_vector_type(4)));
constexpr int BM = 256, BK = 64, HALF = 128, HTB = HALF * BK * 2  , STAGE_BYTES = 8 * HTB, NXCD = 8, WGM = 8;

__host__ __device__ __forceinline__ int lds_byte(int r, int c) { const int st = (r >> 4) * 2 + (c >> 5), rr = r & 15, cc = c & 31, ob = rr * 64 + cc * 2; return st * 1024 + (ob ^ (((ob >> 9) & 1) << 5)); }
__host__ __device__ __forceinline__ void stage_rc(int b, int& R, int& C) { const int st = b / 1024, sb = b % 1024, swz = sb ^ (((sb >> 9) & 1) << 5); R = (st >> 1) * 16 + swz / 64; C = (st & 1) * 32 + (swz % 64) / 2; }
__host__ __device__ __forceinline__ int perm32(int rho) { const int n = rho >> 4, i = rho & 15; return 8 * (i >> 2) + 4 * n + (i & 3); }

struct Unit { int pm, pn, pb, e; };
struct Gemm { const bf16_t* A; const bf16_t* Bt; int M, N, K; int scl_w, scl_a; const PG8_LAS unsigned short* tokL; };

struct StaticOrder {
    int nM, nN, nwg, G, c;
    __host__ __device__ void init(int M, int N, int G_, int c_) { nM = M / BM; nN = N / BM; nwg = nM * nN; G = G_; c = c_; }
    __host__ __device__ bool next(int i, Unit& u) const {
        const long L = (long)i * G + c; if (L >= nwg) return false;
        int wgid = (int)L; { const int q = nwg / NXCD, r = nwg % NXCD, xcd = wgid % NXCD, off = wgid / NXCD; wgid = (xcd < r ? xcd * (q + 1) : r * (q + 1) + (xcd - r) * q) + off; }
        const int nig = WGM * nN, gid = wgid / nig, fm = gid * WGM, gsz = (nM - fm) < WGM ? (nM - fm) : WGM;
        u.pm = fm + ((wgid % nig) % gsz); u.pn = (wgid % nig) / gsz; u.pb = u.pn; u.e = 0; return true;
    }
    __device__ __forceinline__ void a_ready(const Unit&) const {}
    __device__ __forceinline__ void done(const Unit&) const {}
};

__device__ __forceinline__ unsigned cvt_pk_bf16(float lo, float hi) { unsigned r; asm volatile("v_cvt_pk_bf16_f32 %0, %1, %2" : "=v"(r) : "v"(lo), "v"(hi)); return r; }
typedef float f32x2 __attribute__((ext_vector_type(2)));
__device__ __forceinline__ f32x2 gelu_pk(f32x2 v) {
    const f32x2 av = __builtin_elementwise_abs(v), d = av * 0.2316418882f + 1.0f;
    f32x2 t; t.x = __builtin_amdgcn_rcpf(d.x); t.y = __builtin_amdgcn_rcpf(d.y);
    f32x2 q = t * 0.5307027145f + (-0.7265760135f); q = q * t + 0.7107068705f; q = q * t + (-0.142248368f); q = q * t + 0.127414796f; q = q * t;
    const f32x2 s = (v * v) * (-0.72134752044f);
    f32x2 e; e.x = __builtin_amdgcn_exp2f(s.x); e.y = __builtin_amdgcn_exp2f(s.y);
    const f32x2 m = v * (q * e), r = v - m;
    f32x2 o; o.x = v.x < 0.f ? m.x : r.x; o.y = v.y < 0.f ? m.y : r.y; return o;
}

template <int ACT  > struct EpiBf16 {
    static constexpr bool PERM = true, AFTER_DRAIN = false; static_assert(ACT == 0 || ACT == 1, "EpiBf16: ACT is 0 (none) or 1 (gelu_pk)");
    bf16_t* O; int ldc; const float* bias; int split_cols; size_t split_stride; float scale0;
    __device__ __forceinline__ void operator()(const f32x4 (&acc)[2][2][4][2], const Unit& u, int wr, int wc, int fr, int fq) const {
        const int row0 = u.pm * BM + wr * 64 + fr; int colt = u.pn * BM; bf16_t* base = O;
        float sc = 1.f; if (split_cols) { const int t = colt / split_cols; base += (size_t)t * split_stride; colt -= t * split_cols; if (t == 0) sc = scale0; }
        const int col0 = colt + wc * 32 + 8 * fq, bcol0 = u.pn * BM + wc * 32 + 8 * fq;
        f32x4 bv[2][2];
#pragma unroll
        for (int bj = 0; bj < 2; ++bj)
#pragma unroll
            for (int n = 0; n < 2; ++n) bv[bj][n] = bias ? *(const f32x4*)(bias + bcol0 + bj * HALF + 4 * n) : (f32x4){0.f, 0.f, 0.f, 0.f};
#pragma unroll
        for (int ai = 0; ai < 2; ++ai)
#pragma unroll
            for (int m = 0; m < 4; ++m) { bf16_t* rowp = base + (size_t)(row0 + ai * HALF + m * 16) * ldc + col0;
#pragma unroll
                for (int bj = 0; bj < 2; ++bj) { f32x4 v0 = acc[ai][bj][m][0] + bv[bj][0], v1 = acc[ai][bj][m][1] + bv[bj][1];
                    if (ACT == 1) { f32x2 a = gelu_pk((f32x2){v0[0], v0[1]}), b = gelu_pk((f32x2){v0[2], v0[3]}), c = gelu_pk((f32x2){v1[0], v1[1]}), d = gelu_pk((f32x2){v1[2], v1[3]});
                        v0 = (f32x4){a.x, a.y, b.x, b.y}; v1 = (f32x4){c.x, c.y, d.x, d.y}; }
                    v0 = v0 * sc; v1 = v1 * sc; u32x4 w; w.x = cvt_pk_bf16(v0[0], v0[1]); w.y = cvt_pk_bf16(v0[2], v0[3]); w.z = cvt_pk_bf16(v1[0], v1[1]); w.w = cvt_pk_bf16(v1[2], v1[3]);
                    *(u32x4*)(rowp + bj * HALF) = w; } }
    }
};

typedef int v8i_t __attribute__((ext_vector_type(8))); typedef int v4i_t __attribute__((ext_vector_type(4)));
__device__ __forceinline__ v8i_t cat8(bf16x8 lo, bf16x8 hi) { return __builtin_shufflevector(__builtin_bit_cast(v4i_t, lo), __builtin_bit_cast(v4i_t, hi), 0, 1, 2, 3, 4, 5, 6, 7); }
template <class Epi, class Sched, bool ALIGN_EPI = false, bool SP2 = false, bool FP8 = false, bool GATHER = false>
__device__ __forceinline__ void gemm_phase(PG8_LAS unsigned char* lds, const Gemm g, const Sched& S, const Epi& E) {
    const int tid = threadIdx.x, wid = __builtin_amdgcn_readfirstlane(tid >> 6), lane = tid & 63, wr = wid >> 2, wc = wid & 3, fr = lane & 15, fq = lane >> 4;
    const int K = g.K, nt = K / BK;
    unsigned voffA[2], voffB[2];
#pragma unroll
    for (int i = 0; i < 2; ++i) { int R, C; stage_rc(tid * 16 + i * 8192, R, C); const int Rb = Epi::PERM ? ((R & ~31) + perm32(R & 31)) : R;
        voffA[i] = (unsigned)(R * K + C) * 2u; voffB[i] = (unsigned)(Rb * K + C) * 2u; }
    unsigned voffAc[2][2] = {{0u, 0u}, {0u, 0u}}, voffAn[2][2] = {{0u, 0u}, {0u, 0u}}; int gRA[2] = {0, 0}; unsigned gCb[2] = {0u, 0u};
    if constexpr (GATHER) {
#pragma unroll
        for (int i = 0; i < 2; ++i) { int R, C; stage_rc(tid * 16 + i * 8192, R, C); gRA[i] = R; gCb[i] = (unsigned)C * 2u; } }
#define PG8_GVOFF(dst, uidx) do { _Pragma("unroll") for (int h_ = 0; h_ < 2; ++h_) _Pragma("unroll") for (int i_ = 0; i_ < 2; ++i_) dst[h_][i_] = (unsigned)g.tokL[(uidx) * 256 + 128 * h_ + gRA[i_]] * (unsigned)(K * 2) + gCb[i_]; } while (0)
    const size_t kstep = (size_t)(BK * 2);
    const size_t hstep = (size_t)HALF * K * 2;
    const size_t tstep = 2 * hstep;
    const unsigned ldsw = (unsigned)wid * 1024u;
    const int aoff = lds_byte(wr * 64 + fr, fq * 8), boff = lds_byte(wc * 32 + fr, fq * 8);
#define PG8_SA(b, h) (((b) * 2 + (h)) * HTB)
#define PG8_SB(b, h) ((4 + (b) * 2 + (h)) * HTB)
#define PG8_STAGE(bufoff, gbase, voff) do { _Pragma("unroll") for (int _i = 0; _i < 2; ++_i) \
        __builtin_amdgcn_global_load_lds((const unsigned*)((const char*)(gbase) + (voff)[_i]), (PG8_LAS unsigned*)(lds + (bufoff) + ldsw + _i * 8192), 16, 0, 0); } while (0)
#define PG8_STAGE_A(bufoff, gbase, half, nx) do { if constexpr (GATHER) { const unsigned v0_ = (nx) ? voffAn[half][0] : voffAc[half][0], v1_ = (nx) ? voffAn[half][1] : voffAc[half][1]; \
        __builtin_amdgcn_global_load_lds((const unsigned*)((const char*)(gbase) + v0_), (PG8_LAS unsigned*)(lds + (bufoff) + ldsw), 16, 0, 0); \
        __builtin_amdgcn_global_load_lds((const unsigned*)((const char*)(gbase) + v1_), (PG8_LAS unsigned*)(lds + (bufoff) + ldsw + 8192), 16, 0, 0); } \
        else { PG8_STAGE(bufoff, (gbase) + (half) * hstep, voffA); } } while (0)
#define PG8_LDA(dst, b, h) do { if constexpr (FP8) { _Pragma("unroll") for (int m = 0; m < 4; ++m) dst##8[m] = cat8(*(const PG8_LAS bf16x8*)(lds + PG8_SA(b, h) + aoff + m * 2048), *(const PG8_LAS bf16x8*)(lds + PG8_SA(b, h) + aoff + m * 2048 + 1024)); } \
        else { _Pragma("unroll") for (int m = 0; m < 4; ++m) _Pragma("unroll") for (int k = 0; k < 2; ++k) dst[m][k] = *(const PG8_LAS bf16x8*)(lds + PG8_SA(b, h) + aoff + m * 2048 + k * 1024); } } while (0)
#define PG8_LDB(dst, b, h) do { if constexpr (FP8) { _Pragma("unroll") for (int n = 0; n < 2; ++n) dst##8[n] = cat8(*(const PG8_LAS bf16x8*)(lds + PG8_SB(b, h) + boff + n * 2048), *(const PG8_LAS bf16x8*)(lds + PG8_SB(b, h) + boff + n * 2048 + 1024)); } \
        else { _Pragma("unroll") for (int n = 0; n < 2; ++n) _Pragma("unroll") for (int k = 0; k < 2; ++k) dst[n][k] = *(const PG8_LAS bf16x8*)(lds + PG8_SB(b, h) + boff + n * 2048 + k * 1024); } } while (0)
#define PG8_MMA(ai, bj, At, Bt) do { __builtin_amdgcn_s_setprio(1); if constexpr (FP8) { _Pragma("unroll") for (int m = 0; m < 4; ++m) _Pragma("unroll") for (int n = 0; n < 2; ++n) \
        acc[ai][bj][m][n] = __builtin_amdgcn_mfma_scale_f32_16x16x128_f8f6f4(Bt##8[n], At##8[m], acc[ai][bj][m][n], 0, 0, 0, g.scl_w, 0, g.scl_a); \
        _Pragma("unroll") for (int m = 0; m < 4; ++m) _Pragma("unroll") for (int n = 0; n < 2; ++n) asm volatile("" : "+v"(acc[ai][bj][m][n]));   } else { \
        _Pragma("unroll") for (int m = 0; m < 4; ++m) _Pragma("unroll") for (int n = 0; n < 2; ++n) _Pragma("unroll") for (int k = 0; k < 2; ++k) \
        acc[ai][bj][m][n] = __builtin_amdgcn_mfma_f32_16x16x32_bf16(Bt[n][k], At[m][k], acc[ai][bj][m][n], 0, 0, 0); } __builtin_amdgcn_s_setprio(0); } while (0)
#define PG8_WAIT_V(n) asm volatile("s_waitcnt vmcnt(" #n ")" ::: "memory")
#define PG8_WAIT_L(n) asm volatile("s_waitcnt lgkmcnt(" #n ")" ::: "memory")
#define PG8_BAR __builtin_amdgcn_s_barrier()
#define PG8_SCHED __builtin_amdgcn_sched_barrier(0)
    Unit cur, nxt; int ui = 0;
    if (!S.next(0, cur)) return;
    f32x4 acc[2][2][4][2];
#pragma unroll
    for (int a = 0; a < 2; ++a)
#pragma unroll
        for (int b = 0; b < 2; ++b)
#pragma unroll
            for (int m = 0; m < 4; ++m)
#pragma unroll
                for (int n = 0; n < 2; ++n) acc[a][b][m][n] = (f32x4){0.f, 0.f, 0.f, 0.f};
    bf16x8 At[4][2], B0[2][2], B1[2][2]; v8i_t At8[4], B08[2], B18[2];
    const char* cA = (const char*)g.A + (GATHER ? (size_t)0 : (size_t)cur.pm * tstep); const char* cB = (const char*)g.Bt + (size_t)cur.pb * tstep;
    if constexpr (GATHER) { PG8_GVOFF(voffAc, 0); }
    S.a_ready(cur);
    if constexpr (SP2) {
        PG8_STAGE(PG8_SB(0, 0), cB, voffB); PG8_STAGE(PG8_SB(0, 1), cB + hstep, voffB); PG8_STAGE_A(PG8_SA(0, 0), cA, 0, false); PG8_STAGE_A(PG8_SA(0, 1), cA, 1, false);
        if (wr == 1) PG8_BAR;
        PG8_WAIT_V(2); PG8_BAR;
        PG8_STAGE(PG8_SB(1, 0), cB + kstep, voffB); PG8_STAGE_A(PG8_SA(1, 0), cA + kstep, 0, false); PG8_STAGE(PG8_SB(1, 1), cB + hstep + kstep, voffB);
        PG8_WAIT_V(6); PG8_BAR;
    } else {
        PG8_STAGE(PG8_SB(0, 0), cB, voffB); PG8_STAGE_A(PG8_SA(0, 0), cA, 0, false); PG8_STAGE(PG8_SB(0, 1), cB + hstep, voffB); PG8_STAGE_A(PG8_SA(0, 1), cA, 1, false);
        if (wr == 1) PG8_BAR;
        PG8_WAIT_V(4); PG8_BAR;
        PG8_STAGE(PG8_SB(1, 0), cB + kstep, voffB); PG8_STAGE_A(PG8_SA(1, 0), cA + kstep, 0, false); PG8_STAGE(PG8_SB(1, 1), cB + hstep + kstep, voffB);
        PG8_WAIT_V(6); PG8_BAR;
    }
    for (;;) {
        const bool has_next = S.next(ui + 1, nxt);
        const char* nA = (has_next && !GATHER) ? (const char*)g.A + (size_t)nxt.pm * tstep : cA; const char* nB = has_next ? (const char*)g.Bt + (size_t)nxt.pb * tstep : cB;
        if constexpr (GATHER) { if (has_next) { PG8_GVOFF(voffAn, ui + 1); } else {
#pragma unroll
            for (int h_ = 0; h_ < 2; ++h_) { voffAn[h_][0] = voffAc[h_][0]; voffAn[h_][1] = voffAc[h_][1]; } } }
        for (int t = 0; t < nt; t += 2) {
            const bool last = (t == nt - 2);
            const char* a1 = cA + (size_t)(t + 1) * kstep;
            const char* a2 = last ? nA : cA + (size_t)(t + 2) * kstep; const char* b2 = last ? nB : cB + (size_t)(t + 2) * kstep;
            const char* a3 = a2 + kstep; const char* b3 = b2 + kstep;
            if (last && has_next) S.a_ready(nxt);
            if constexpr (SP2) {
            PG8_LDB(B0, 0, 0); PG8_LDB(B1, 0, 1); PG8_SCHED; PG8_LDA(At, 0, 0); PG8_STAGE_A(PG8_SA(1, 1), a1, 1, false);
            PG8_WAIT_V(8); PG8_WAIT_L(0); PG8_BAR; PG8_MMA(0, 0, At, B0); PG8_MMA(0, 1, At, B1); PG8_BAR; PG8_SCHED;
            PG8_LDA(At, 0, 1); PG8_STAGE(PG8_SB(0, 0), b2, voffB); PG8_STAGE(PG8_SB(0, 1), b2 + hstep, voffB); PG8_STAGE_A(PG8_SA(0, 0), a2, 0, last);
            PG8_WAIT_V(8); PG8_WAIT_L(0); PG8_BAR; PG8_MMA(1, 0, At, B0); PG8_MMA(1, 1, At, B1); PG8_BAR; PG8_SCHED;
            PG8_LDB(B0, 1, 0); PG8_LDB(B1, 1, 1); PG8_SCHED; PG8_LDA(At, 1, 0); PG8_STAGE_A(PG8_SA(0, 1), a2, 1, last);
            PG8_WAIT_V(8); PG8_WAIT_L(0); PG8_BAR; PG8_MMA(0, 0, At, B0); PG8_MMA(0, 1, At, B1); PG8_BAR; PG8_SCHED;
            PG8_LDA(At, 1, 1); PG8_STAGE(PG8_SB(1, 0), b3, voffB); PG8_STAGE(PG8_SB(1, 1), b3 + hstep, voffB); PG8_STAGE_A(PG8_SA(1, 0), a3, 0, last);
            PG8_WAIT_V(8); PG8_WAIT_L(0); PG8_BAR; PG8_MMA(1, 0, At, B0); PG8_MMA(1, 1, At, B1); PG8_BAR; PG8_SCHED;
            } else {
            PG8_LDB(B0, 0, 0); PG8_SCHED; PG8_LDA(At, 0, 0); PG8_STAGE_A(PG8_SA(1, 1), a1, 1, false);
            PG8_WAIT_L(8); PG8_BAR; PG8_WAIT_L(0); PG8_MMA(0, 0, At, B0); PG8_BAR; PG8_SCHED;
            PG8_LDB(B1, 0, 1); PG8_STAGE(PG8_SB(0, 0), b2, voffB);
            PG8_BAR; PG8_WAIT_L(0); PG8_MMA(0, 1, At, B1); PG8_BAR;
            PG8_LDA(At, 0, 1); PG8_STAGE_A(PG8_SA(0, 0), a2, 0, last);
            PG8_BAR; PG8_WAIT_L(0); PG8_MMA(1, 0, At, B0); PG8_BAR; PG8_SCHED;
            PG8_STAGE(PG8_SB(0, 1), b2 + hstep, voffB);
            PG8_WAIT_V(6); PG8_BAR; PG8_MMA(1, 1, At, B1); PG8_BAR;
            PG8_LDB(B0, 1, 0); PG8_SCHED; PG8_LDA(At, 1, 0); PG8_STAGE_A(PG8_SA(0, 1), a2, 1, last);
            PG8_WAIT_L(8); PG8_BAR; PG8_WAIT_L(0); PG8_MMA(0, 0, At, B0); PG8_BAR; PG8_SCHED;
            PG8_LDB(B1, 1, 1); PG8_STAGE(PG8_SB(1, 0), b3, voffB);
            PG8_BAR; PG8_WAIT_L(0); PG8_MMA(0, 1, At, B1); PG8_BAR;
            PG8_LDA(At, 1, 1); PG8_STAGE_A(PG8_SA(1, 0), a3, 0, last);
            PG8_BAR; PG8_WAIT_L(0); PG8_MMA(1, 0, At, B0); PG8_BAR; PG8_SCHED;
            PG8_STAGE(PG8_SB(1, 1), b3 + hstep, voffB);
            PG8_WAIT_V(6); PG8_BAR; PG8_MMA(1, 1, At, B1); PG8_BAR;
            }
        }
        if constexpr (ALIGN_EPI) { if (wr == 0) PG8_BAR; }
        if constexpr (!Epi::AFTER_DRAIN) { E(acc, cur, wr, wc, fr, fq); S.done(cur); }
        if (!has_next) break;
#pragma unroll
        for (int a = 0; a < 2; ++a)
#pragma unroll
            for (int b = 0; b < 2; ++b)
#pragma unroll
                for (int m = 0; m < 4; ++m)
#pragma unroll
                    for (int n = 0; n < 2; ++n) acc[a][b][m][n] = (f32x4){0.f, 0.f, 0.f, 0.f};
        cur = nxt; cA = nA; cB = nB; ++ui;
        if constexpr (GATHER) {
#pragma unroll
            for (int h_ = 0; h_ < 2; ++h_) { voffAc[h_][0] = voffAn[h_][0]; voffAc[h_][1] = voffAn[h_][1]; } }
        if constexpr (ALIGN_EPI) { if (wr == 1) PG8_BAR; }
    }
    PG8_WAIT_V(0);
    if constexpr (!ALIGN_EPI) { if (wr == 0) PG8_BAR; }
    PG8_BAR;
    if constexpr (Epi::AFTER_DRAIN) { E.fused(acc, cur, wr, wc, fr, fq, lds, wid, lane); S.done(cur); }
#undef PG8_SA
#undef PG8_SB
#undef PG8_STAGE
#undef PG8_STAGE_A
#undef PG8_GVOFF
#undef PG8_LDA
#undef PG8_LDB
#undef PG8_MMA
#undef PG8_WAIT_V
#undef PG8_WAIT_L
#undef PG8_BAR
#undef PG8_SCHED
}
}
#define GAS __attribute__((address_space(1)))
#define LAS __attribute__((address_space(3)))
typedef unsigned short bf16;
typedef unsigned v4u __attribute__((ext_vector_type(4)));
typedef float f32x4 __attribute__((ext_vector_type(4)));
typedef short bf16x8 __attribute__((ext_vector_type(8)));
typedef GAS unsigned gu32;
typedef GAS unsigned long long gu64;
#define RLX_AGENT __ATOMIC_RELAXED, __HIP_MEMORY_SCOPE_AGENT
#define LDS_WAIT() asm volatile("s_waitcnt lgkmcnt(0)" ::: "memory")
#define VM_WAIT() asm volatile("s_waitcnt vmcnt(0)" ::: "memory")
__device__ __forceinline__ unsigned long long rt() { return __builtin_amdgcn_s_memrealtime(); }
__device__ __forceinline__ unsigned f2bf(float f) { unsigned u = __builtin_bit_cast(unsigned, f); return (u + 0x7fffu + ((u >> 16) & 1u)) >> 16; }
__device__ __forceinline__ unsigned pk2(float lo, float hi) { return f2bf(lo) | (f2bf(hi) << 16); }

#define XB_TMO      128
#define XB_XCNT(j)  (256  + 64 * (j))
#define XB_XSUB(j)  (1280 + 64 * (j))
#define XB_XGEN(j)  (2304 + 64 * (j))
#define XB_TOP      3328
#define XB_TOPGEN   3392
#define XCD_BAR_WORDS 3456
#define XB_SPIN_CAP (1u << 22)

__device__ __forceinline__ unsigned xb_ld(unsigned* p)              { return __hip_atomic_load(p, __ATOMIC_RELAXED, __HIP_MEMORY_SCOPE_AGENT); }
__device__ __forceinline__ unsigned xb_add(unsigned* p, unsigned v) { return __hip_atomic_fetch_add(p, v, __ATOMIC_RELAXED, __HIP_MEMORY_SCOPE_AGENT); }
__device__ __forceinline__ unsigned xb_xcc_id() { return (unsigned)__builtin_amdgcn_s_getreg((3 << 11) | 20) & 0xFu; }
#define XB_SPIN(cond, bar) do { unsigned _sp = 0; while (cond) { __builtin_amdgcn_s_sleep(1); \
    if ((++_sp & 255u) == 0u) { if (xb_ld(&(bar)[XB_TMO])) break; if (_sp > XB_SPIN_CAP) { atomicAdd(&(bar)[XB_TMO], 1u); break; } } } } while (0)

struct XcdBarrier {
    unsigned* bar; unsigned x;
    volatile LAS unsigned* st;
};

__device__ __forceinline__ XcdBarrier xcd_barrier_post(unsigned* bar, volatile LAS unsigned* st) {
    XcdBarrier b; b.bar = bar; b.x = xb_xcc_id(); b.st = st;
    if (threadIdx.x == 0) (void)xb_add(&bar[XB_XCNT(b.x)], 1u);
    return b;
}
__device__ __forceinline__ void xcd_barrier_complete(unsigned* bar, unsigned x, unsigned& nloc, unsigned& nx) {
    const unsigned G = gridDim.x * gridDim.y * gridDim.z;
    unsigned sum, cnt, mine, sp = 0u;
    for (;;) {
        sum = 0u; cnt = 0u; mine = 0u;
#pragma unroll
        for (unsigned j = 0; j < 16; ++j) { const unsigned c = xb_ld(&bar[XB_XCNT(j)]); sum += c; cnt += (c > 0u) ? 1u : 0u; mine = (j == x) ? c : mine; }
        if (sum == G) break;
        __builtin_amdgcn_s_sleep(1);
        if ((++sp & 255u) == 0u) { if (xb_ld(&bar[XB_TMO])) break; if (sp > XB_SPIN_CAP) { atomicAdd(&bar[XB_TMO], 1u); break; } }
    }
    nloc = mine > 0u ? mine : 1u; nx = cnt > 0u ? cnt : 1u;
}

__device__ __forceinline__ void xcd_barrier(const XcdBarrier& b) {
    asm volatile("s_waitcnt vmcnt(0)" ::: "memory");
    __syncthreads();
    if (threadIdx.x == 0) {
        unsigned* bar = b.bar;
        __builtin_amdgcn_s_waitcnt(0);
        unsigned nloc = b.st[0], nx = b.st[1];
        if (nloc == 0u) { xcd_barrier_complete(bar, b.x, nloc, nx); b.st[0] = nloc; b.st[1] = nx; }
        const unsigned old = xb_add(&bar[XB_XSUB(b.x)], 1u);
        const unsigned gen = old / nloc;
        if (old + 1u == (gen + 1u) * nloc) {
            __builtin_amdgcn_fence(__ATOMIC_RELEASE, "agent");
            asm volatile("s_waitcnt vmcnt(0)" ::: "memory");
            const unsigned og = xb_add(&bar[XB_TOP], 1u);
            const unsigned tg = og / nx;
            if (og + 1u == (tg + 1u) * nx) xb_add(&bar[XB_TOPGEN], 1u);
            else XB_SPIN(xb_ld(&bar[XB_TOPGEN]) == tg, bar);
            __builtin_amdgcn_fence(__ATOMIC_ACQUIRE, "agent");
            xb_add(&bar[XB_XGEN(b.x)], 1u);
            asm volatile("s_waitcnt vmcnt(0)" ::: "memory");
        } else {
            XB_SPIN(xb_ld(&bar[XB_XGEN(b.x)]) == gen, bar);
            __builtin_amdgcn_fence(__ATOMIC_ACQUIRE, "agent");
            asm volatile("s_waitcnt vmcnt(0)" ::: "memory");
        }
    }
    __syncthreads();
}

#ifndef PG8_SP2
#define PG8_SP2 true
#endif
#ifndef PG8_ALIGN
#define PG8_ALIGN true
#endif
namespace pg8 {
struct EpiResF32 {
    static constexpr bool PERM = false, AFTER_DRAIN = false;
    const float* base; float* C; int ldc;
    __device__ __forceinline__ void operator()(const f32x4 (&acc)[2][2][4][2], const Unit& u, int wr, int wc, int fr, int fq) const {
        const int row0 = u.pm * BM + wr * 64 + fr, col0 = u.pn * BM + wc * 32 + 4 * fq;
#pragma unroll
        for (int ai = 0; ai < 2; ++ai)
#pragma unroll
            for (int m = 0; m < 4; ++m) { const size_t off = (size_t)(row0 + ai * HALF + m * 16) * ldc + col0;
#pragma unroll
                for (int bj = 0; bj < 2; ++bj)
#pragma unroll
                    for (int n = 0; n < 2; ++n) { const f32x4 bs = *(const f32x4*)(base + off + bj * HALF + n * 16); *(f32x4*)(C + off + bj * HALF + n * 16) = bs + acc[ai][bj][m][n]; }
                asm volatile("" ::: "memory"); }
    }
};
struct EpiResXn {
    static constexpr bool PERM = true, AFTER_DRAIN = false;
    const bf16_t* XN; const float* rms; bf16_t* O; int ldc;
    __device__ __forceinline__ void operator()(const f32x4 (&acc)[2][2][4][2], const Unit& u, int wr, int wc, int fr, int fq) const {
        const int row0 = u.pm * BM + wr * 64 + fr, col0 = u.pn * BM + wc * 32 + 8 * fq;
#pragma unroll
        for (int ai = 0; ai < 2; ++ai)
#pragma unroll
            for (int m = 0; m < 4; ++m) { const int row = row0 + ai * HALF + m * 16; const size_t off = (size_t)row * ldc + col0; const float rs = rms[row];
#pragma unroll
                for (int bj = 0; bj < 2; ++bj) { const u32x4 xw = *(const u32x4*)(XN + off + bj * HALF);
                    const f32x4 b0 = (f32x4){__builtin_bit_cast(float, xw.x << 16), __builtin_bit_cast(float, xw.x & 0xffff0000u), __builtin_bit_cast(float, xw.y << 16), __builtin_bit_cast(float, xw.y & 0xffff0000u)};
                    const f32x4 b1 = (f32x4){__builtin_bit_cast(float, xw.z << 16), __builtin_bit_cast(float, xw.z & 0xffff0000u), __builtin_bit_cast(float, xw.w << 16), __builtin_bit_cast(float, xw.w & 0xffff0000u)};
                    const f32x4 v0 = acc[ai][bj][m][0] + b0 * rs, v1 = acc[ai][bj][m][1] + b1 * rs;
                    u32x4 w; w.x = cvt_pk_bf16(v0[0], v0[1]); w.y = cvt_pk_bf16(v0[2], v0[3]); w.z = cvt_pk_bf16(v1[0], v1[1]); w.w = cvt_pk_bf16(v1[2], v1[3]);
                    *(u32x4*)(O + off + bj * HALF) = w; }
                asm volatile("" ::: "memory"); }
    }
};
struct EpiResBf16 {
    static constexpr bool PERM = true, AFTER_DRAIN = false;
    const float* base; bf16_t* O; int ldc;
    __device__ __forceinline__ void operator()(const f32x4 (&acc)[2][2][4][2], const Unit& u, int wr, int wc, int fr, int fq) const {
        const int row0 = u.pm * BM + wr * 64 + fr, col0 = u.pn * BM + wc * 32 + 8 * fq;
#pragma unroll
        for (int ai = 0; ai < 2; ++ai)
#pragma unroll
            for (int m = 0; m < 4; ++m) { const size_t off = (size_t)(row0 + ai * HALF + m * 16) * ldc + col0;
#pragma unroll
                for (int bj = 0; bj < 2; ++bj) { const f32x4 b0 = *(const f32x4*)(base + off + bj * HALF), b1 = *(const f32x4*)(base + off + bj * HALF + 4);
                    const f32x4 v0 = acc[ai][bj][m][0] + b0, v1 = acc[ai][bj][m][1] + b1;
                    u32x4 w; w.x = cvt_pk_bf16(v0[0], v0[1]); w.y = cvt_pk_bf16(v0[2], v0[3]); w.z = cvt_pk_bf16(v1[0], v1[1]); w.w = cvt_pk_bf16(v1[2], v1[3]);
                    *(u32x4*)(O + off + bj * HALF) = w; }
                asm volatile("" ::: "memory"); }
    }
};
struct EpiBiasBf16 {
    static constexpr bool PERM = true, AFTER_DRAIN = false;
    bf16_t* O; int ldc; const float* bias; int bstride;
    __device__ __forceinline__ void operator()(const f32x4 (&acc)[2][2][4][2], const Unit& u, int wr, int wc, int fr, int fq) const {
        const int row0 = u.pm * BM + wr * 64 + fr; const int col0 = u.pn * BM + wc * 32 + 8 * fq;
        const float* bp = bias ? bias + (size_t)u.e * bstride + col0 : nullptr;
        f32x4 bv[2][2];
#pragma unroll
        for (int bj = 0; bj < 2; ++bj)
#pragma unroll
            for (int n = 0; n < 2; ++n) bv[bj][n] = bias ? *(const f32x4*)(bp + bj * HALF + 4 * n) : (f32x4){0.f, 0.f, 0.f, 0.f};
#pragma unroll
        for (int ai = 0; ai < 2; ++ai)
#pragma unroll
            for (int m = 0; m < 4; ++m) { bf16_t* rowp = O + (size_t)(row0 + ai * HALF + m * 16) * ldc + col0;
#pragma unroll
                for (int bj = 0; bj < 2; ++bj) { const f32x4 v0 = acc[ai][bj][m][0] + bv[bj][0], v1 = acc[ai][bj][m][1] + bv[bj][1];
                    u32x4 w; w.x = cvt_pk_bf16(v0[0], v0[1]); w.y = cvt_pk_bf16(v0[2], v0[3]); w.z = cvt_pk_bf16(v1[0], v1[1]); w.w = cvt_pk_bf16(v1[2], v1[3]);
                    *(u32x4*)(rowp + bj * HALF) = w; } }
    }
};
__device__ __forceinline__ unsigned pk4_fp8e(float a, float b, float c, float d) {
    int w = 0; w = __builtin_amdgcn_cvt_pk_fp8_f32(a * 8.f, b * 8.f, w, false); w = __builtin_amdgcn_cvt_pk_fp8_f32(c * 8.f, d * 8.f, w, true); return (unsigned)w; }
typedef unsigned u32x2v __attribute__((ext_vector_type(2)));
__device__ __forceinline__ unsigned pk4_fp8c(float a, float b, float c, float d) {
    a = fminf(fmaxf(a * 8.f, -448.f), 448.f); b = fminf(fmaxf(b * 8.f, -448.f), 448.f); c = fminf(fmaxf(c * 8.f, -448.f), 448.f); d = fminf(fmaxf(d * 8.f, -448.f), 448.f);
    int w = 0; w = __builtin_amdgcn_cvt_pk_fp8_f32(a, b, w, false); w = __builtin_amdgcn_cvt_pk_fp8_f32(c, d, w, true); return (unsigned)w; }
struct EpiBiasLdsBf16 {
    static constexpr bool PERM = true, AFTER_DRAIN = false;
    bf16_t* O; int ldc; const PG8_LAS unsigned short* biasL;
    __device__ __forceinline__ void operator()(const f32x4 (&acc)[2][2][4][2], const Unit& u, int wr, int wc, int fr, int fq) const {
        const int row0 = u.pm * BM + wr * 64 + fr; const int col0 = u.pn * BM + wc * 32 + 8 * fq;
        f32x4 bv[2][2];
#pragma unroll
        for (int bj = 0; bj < 2; ++bj) { const u32x4 w = *(const PG8_LAS u32x4*)(biasL + u.e * 256 + bj * HALF + wc * 32 + 8 * fq);
            bv[bj][0] = (f32x4){__builtin_bit_cast(float, w.x << 16), __builtin_bit_cast(float, w.x & 0xffff0000u), __builtin_bit_cast(float, w.y << 16), __builtin_bit_cast(float, w.y & 0xffff0000u)};
            bv[bj][1] = (f32x4){__builtin_bit_cast(float, w.z << 16), __builtin_bit_cast(float, w.z & 0xffff0000u), __builtin_bit_cast(float, w.w << 16), __builtin_bit_cast(float, w.w & 0xffff0000u)}; }
#pragma unroll
        for (int ai = 0; ai < 2; ++ai)
#pragma unroll
            for (int m = 0; m < 4; ++m) { unsigned char* rowp = (unsigned char*)O + (size_t)(row0 + ai * HALF + m * 16) * ldc + col0;
#pragma unroll
                for (int bj = 0; bj < 2; ++bj) { const f32x4 v0 = acc[ai][bj][m][0] + bv[bj][0], v1 = acc[ai][bj][m][1] + bv[bj][1];
                    u32x2v w; w.x = pk4_fp8c(v0[0], v0[1], v0[2], v0[3]); w.y = pk4_fp8c(v1[0], v1[1], v1[2], v1[3]);
                    *(u32x2v*)(rowp + bj * HALF) = w; } }
    }
};
struct EpiSwiGLU {
    static constexpr bool PERM = true, AFTER_DRAIN = false;
    bf16_t* O; int ldc; const PG8_LAS unsigned short* biasL;
    __device__ __forceinline__ void operator()(const f32x4 (&acc)[2][2][4][2], const Unit& u, int wr, int wc, int fr, int fq) const {
        const int row0 = u.pm * BM + wr * 64 + fr; const int ff0 = u.pn * HALF + wc * 32 + 8 * fq;
        f32x4 bg[2], bu[2];
        { const PG8_LAS unsigned short* bp = biasL + u.e * 256 + wc * 32 + 8 * fq;
          const u32x4 wg = *(const PG8_LAS u32x4*)bp, wu = *(const PG8_LAS u32x4*)(bp + 128);
          bg[0] = (f32x4){__builtin_bit_cast(float, wg.x << 16), __builtin_bit_cast(float, wg.x & 0xffff0000u), __builtin_bit_cast(float, wg.y << 16), __builtin_bit_cast(float, wg.y & 0xffff0000u)};
          bg[1] = (f32x4){__builtin_bit_cast(float, wg.z << 16), __builtin_bit_cast(float, wg.z & 0xffff0000u), __builtin_bit_cast(float, wg.w << 16), __builtin_bit_cast(float, wg.w & 0xffff0000u)};
          bu[0] = (f32x4){__builtin_bit_cast(float, wu.x << 16), __builtin_bit_cast(float, wu.x & 0xffff0000u), __builtin_bit_cast(float, wu.y << 16), __builtin_bit_cast(float, wu.y & 0xffff0000u)};
          bu[1] = (f32x4){__builtin_bit_cast(float, wu.z << 16), __builtin_bit_cast(float, wu.z & 0xffff0000u), __builtin_bit_cast(float, wu.w << 16), __builtin_bit_cast(float, wu.w & 0xffff0000u)}; }
#pragma unroll
        for (int ai = 0; ai < 2; ++ai)
#pragma unroll
            for (int m = 0; m < 4; ++m) { unsigned char* rowp = (unsigned char*)O + (size_t)(row0 + ai * HALF + m * 16) * ldc + ff0;
                float o[8];
#pragma unroll
                for (int n = 0; n < 2; ++n) { const f32x4 g = acc[ai][0][m][n] + bg[n], up = acc[ai][1][m][n] + bu[n];
#pragma unroll
                    for (int j = 0; j < 4; ++j) { const float gg = fminf(g[j], 7.0f), uu = fminf(fmaxf(up[j], -7.0f), 7.0f);
                        const float sg = __builtin_amdgcn_rcpf(1.0f + __builtin_amdgcn_exp2f(-1.702f * 1.44269504089f * gg));
                        o[4 * n + j] = (uu + 1.0f) * (gg * sg); } }
                u32x2v w; w.x = pk4_fp8e(o[0], o[1], o[2], o[3]); w.y = pk4_fp8e(o[4], o[5], o[6], o[7]);
                *(u32x2v*)rowp = w; }
    }
};
struct MoeOrder {
    const PG8_LAS int* tile_e; int MT, nN, G, c;
    __device__ bool next(int i, Unit& u) const {
        const int per_round = G / nN, mpx = per_round / 8; int mt, pn;
        if (G % (8 * nN) == 0) { const int xcd = c & 7, loc = c >> 3; mt = i * per_round + xcd * mpx + loc / nN; pn = loc % nN; }
        else { const long L = (long)i * G + c; mt = (int)(L / nN); pn = (int)(L % nN); }
        if (mt >= MT) return false; const int e = __builtin_amdgcn_readfirstlane(tile_e[mt]);
        u.pm = mt; u.pn = pn; u.pb = e * nN + pn; u.e = e; return true;
    }
    __device__ __forceinline__ void a_ready(const Unit&) const {}
    __device__ __forceinline__ void done(const Unit&) const {}
};
}

constexpr int NWAVES = 8;
constexpr int BATCH = 4, SEQ = 8192, D = 1024, M = BATCH * SEQ;
constexpr int IN_COLS = 3328, CW = 512, RW = 512, NH = 8, HD = 64;
constexpr int NE = 32, TOPK = 4, FF = 1024;
constexpr int SLOT_ROWS = M * TOPK + NE * 256;
constexpr int MT_MAX = SLOT_ROWS / 256;
constexpr float NORM_EPS = 1e-5f, GN_EPS = 64e-5f;
#ifndef MK_N_LAUNCHES
#define MK_N_LAUNCHES 1
#endif
constexpr int NPHASE = 10;
constexpr int N_LAUNCHES = MK_N_LAUNCHES;

constexpr size_t MiB = 1u << 20;
constexpr size_t WS_CTL = 0, CTL_ZERO_BYTES = 1 * MiB;
constexpr size_t WS_WIN = 2 * MiB;
constexpr size_t WS_WOUT = 9 * MiB;
constexpr size_t WS_LORA = 11 * MiB;
constexpr size_t WS_TOKE = 12 * MiB, WS_TOKG = WS_TOKE + 512 * 1024, WS_TOKR = WS_TOKG + 512 * 1024, WS_DEST = WS_TOKR + 512 * 1024;
constexpr size_t WS_BDOT = 14 * MiB;
constexpr size_t WS_WGU = 16 * MiB;
constexpr size_t WS_WDN = 144 * MiB;
constexpr size_t WS_XN = 208 * MiB;
constexpr size_t WS_Y = 272 * MiB;
constexpr size_t WS_P = 336 * MiB;
constexpr size_t WS_FR = 544 * MiB;
constexpr size_t WS_SR = 544 * MiB, WS_SW = 608 * MiB, WS_SK = 672 * MiB, WS_SV = 864 * MiB, WS_SKK = 800 * MiB, WS_SB = 864 * MiB;
constexpr size_t WS_SG = 928 * MiB;
constexpr size_t WS_XIN = 272 * MiB;
constexpr size_t WS_YSLOT = WS_XIN;
constexpr size_t WS_ACT = 544 * MiB;
constexpr size_t WS_X1 = 816 * MiB;
constexpr size_t WS_END = 960 * MiB;
constexpr int CHK = 32, NCH = SEQ / CHK, NCHH = BATCH * NH * NCH;
constexpr size_t WS_SF = WS_P;
constexpr size_t WS_RMS = 15 * MiB;
constexpr size_t WS_QF = 736 * MiB;
constexpr size_t WS_O1 = 768 * MiB;
constexpr size_t WS_GF = 608 * MiB;
constexpr size_t WS_HF = 672 * MiB;
constexpr size_t WS_PC = 800 * MiB;
static_assert(WS_ACT + (size_t)SLOT_ROWS * 1024 * 2 <= WS_X1 && WS_X1 + (size_t)M * D * 4 <= WS_END && WS_XIN + (size_t)SLOT_ROWS * 1024 * 2 <= WS_ACT, "ws map");
constexpr int CW_BAR = 4096;
constexpr int CW_CNT = 8192;
constexpr int CW_MT = 8256;
constexpr int CW_TILE_E = 8320;
constexpr int RING_BYTES = 131072, LDS_BYTES = 163840, LDSCTL_OFF = LDS_BYTES - 512, MISC_OFF = LDSCTL_OFF + 320;

constexpr int MOE_TOK_OFF = RING_BYTES + 2304 + 32 * 256 * 2, MOE_MAXU = 18;
constexpr size_t WS_LIST = 240 * MiB;
constexpr int MOE_TAB_OFF = RING_BYTES, MOE_BIAS_OFF = RING_BYTES + 2304;
static_assert(MOE_TOK_OFF + MOE_MAXU * 512 + 512 <= LDSCTL_OFF, "MoE LDS tables fit");
typedef unsigned u32x2 __attribute__((ext_vector_type(2)));
typedef float f32x2 __attribute__((ext_vector_type(2)));

typedef float f32x2_t __attribute__((ext_vector_type(2))); typedef __bf16 bf16x2_t __attribute__((ext_vector_type(2)));
__device__ __forceinline__ unsigned cvtpk_s(float lo, float hi) { f32x2_t v = {lo, hi}; bf16x2_t b = __builtin_convertvector(v, bf16x2_t); return __builtin_bit_cast(unsigned, b); }
__device__ __forceinline__ float wave_sum(float v) {
#pragma unroll
    for (int o = 1; o < 64; o <<= 1) v += __shfl_xor(v, o);
    return v;
}
__device__ __forceinline__ float bf_lo(unsigned w) { return __builtin_bit_cast(float, w << 16); }
__device__ __forceinline__ float bf_hi(unsigned w) { return __builtin_bit_cast(float, w & 0xffff0000u); }
__device__ __forceinline__ float fast_sigmoid(float x) { return __builtin_amdgcn_rcpf(1.0f + __builtin_amdgcn_exp2f(-1.44269504089f * x)); }
__device__ __forceinline__ float fast_tanh(float x) { const float xc = fminf(fmaxf(x, -15.f), 15.f); const float e = __builtin_amdgcn_exp2f(2.88539008178f * xc); return 1.0f - 2.0f * __builtin_amdgcn_rcpf(e + 1.0f); }

__device__ __forceinline__ void p0_transpose_item(const float* W, int K, int N, bf16* WT, int dst_row0, LAS float* scr, int k0, int n0, int lane) {
#pragma unroll
    for (int i = 0; i < 8; ++i) { const int kk = 8 * i + (lane >> 3), c4 = (lane & 7) * 4; const f32x4 v = *(const f32x4*)(W + (size_t)(k0 + kk) * N + n0 + c4);
        scr[kk * 33 + c4] = v.x; scr[kk * 33 + c4 + 1] = v.y; scr[kk * 33 + c4 + 2] = v.z; scr[kk * 33 + c4 + 3] = v.w; }
    LDS_WAIT(); asm volatile("" ::: "memory");
    const int c = lane & 7;
#pragma unroll
    for (int j = 0; j < 4; ++j) { const int n = (lane >> 3) + 8 * j; const LAS float* s = scr + (8 * c) * 33 + n;
        v4u o; o.x = pk2(s[0 * 33], s[1 * 33]); o.y = pk2(s[2 * 33], s[3 * 33]); o.z = pk2(s[4 * 33], s[5 * 33]); o.w = pk2(s[6 * 33], s[7 * 33]);
        *(GAS v4u*)(WT + (size_t)(dst_row0 + n) * K + k0 + 8 * c) = o; }
    LDS_WAIT(); asm volatile("" ::: "memory");
}

__device__ __forceinline__ void p0_transpose_item_g(const float* W, int K, int N, bf16* WT, int dst_row0, LAS float* scr, int k0, int n0, int lane, const float* gk) {
#pragma unroll
    for (int i = 0; i < 8; ++i) { const int kk = 8 * i + (lane >> 3), c4 = (lane & 7) * 4; const f32x4 v = *(const f32x4*)(W + (size_t)(k0 + kk) * N + n0 + c4);
        scr[kk * 33 + c4] = v.x; scr[kk * 33 + c4 + 1] = v.y; scr[kk * 33 + c4 + 2] = v.z; scr[kk * 33 + c4 + 3] = v.w; }
    const int c = lane & 7;
    const f32x4 ga = *(const f32x4*)(gk + k0 + 8 * c), gb = *(const f32x4*)(gk + k0 + 8 * c + 4);
    LDS_WAIT(); asm volatile("" ::: "memory");
#pragma unroll
    for (int j = 0; j < 4; ++j) { const int n = (lane >> 3) + 8 * j; const LAS float* s = scr + (8 * c) * 33 + n;
        v4u o; o.x = pk2(s[0 * 33] * ga.x, s[1 * 33] * ga.y); o.y = pk2(s[2 * 33] * ga.z, s[3 * 33] * ga.w); o.z = pk2(s[4 * 33] * gb.x, s[5 * 33] * gb.y); o.w = pk2(s[6 * 33] * gb.z, s[7 * 33] * gb.w);
        *(GAS v4u*)(WT + (size_t)(dst_row0 + n) * K + k0 + 8 * c) = o; }
    LDS_WAIT(); asm volatile("" ::: "memory");
}

__device__ __forceinline__ unsigned pk4_fp8(float a, float b, float c, float d, float s) {
    a = fminf(fmaxf(a * s, -448.f), 448.f); b = fminf(fmaxf(b * s, -448.f), 448.f); c = fminf(fmaxf(c * s, -448.f), 448.f); d = fminf(fmaxf(d * s, -448.f), 448.f);
    int w = 0; w = __builtin_amdgcn_cvt_pk_fp8_f32(a, b, w, false); w = __builtin_amdgcn_cvt_pk_fp8_f32(c, d, w, true); return (unsigned)w; }
constexpr float F8_W_SCALE = 1024.f, F8_H_SCALE = 32.f, F8_ACT_SCALE = 8.f;
constexpr int F8_W_BYTE = 0x75757575, F8_H_BYTE = 0x7a7a7a7a, F8_ACT_BYTE = 0x7c7c7c7c;
struct F8Item { f32x4 v[8]; };
__device__ __forceinline__ void f8_item_load(F8Item& it, const float* W, int N, int k0, int n0, int lane) {
#pragma unroll
    for (int i = 0; i < 8; ++i) { const int kk = 8 * i + (lane >> 3), c4 = (lane & 7) * 4; it.v[i] = *(const f32x4*)(W + (size_t)(k0 + kk) * N + n0 + c4); }
}
__device__ __forceinline__ void f8_item_finish(const F8Item& it, int K, unsigned char* WT, int dst_row0, LAS float* scr, int k0, int lane) {
#pragma unroll
    for (int i = 0; i < 8; ++i) { const int kk = 8 * i + (lane >> 3), c4 = (lane & 7) * 4; scr[kk * 33 + c4] = it.v[i].x; scr[kk * 33 + c4 + 1] = it.v[i].y; scr[kk * 33 + c4 + 2] = it.v[i].z; scr[kk * 33 + c4 + 3] = it.v[i].w; }
    LDS_WAIT(); asm volatile("" ::: "memory");
    const int c = lane & 7;
#pragma unroll
    for (int j = 0; j < 4; ++j) { const int n = (lane >> 3) + 8 * j; const LAS float* s = scr + (8 * c) * 33 + n;
        u32x2 o; o.x = pk4_fp8(s[0 * 33], s[1 * 33], s[2 * 33], s[3 * 33], F8_W_SCALE); o.y = pk4_fp8(s[4 * 33], s[5 * 33], s[6 * 33], s[7 * 33], F8_W_SCALE);
        *(GAS u32x2*)(WT + (size_t)(dst_row0 + n) * K + k0 + 8 * c) = o; }
    LDS_WAIT(); asm volatile("" ::: "memory");
}
__device__ __forceinline__ void p0_transpose_item_f8(const float* W, int K, int N, unsigned char* WT, int dst_row0, LAS float* scr, int k0, int n0, int lane) {
#pragma unroll
    for (int i = 0; i < 8; ++i) { const int kk = 8 * i + (lane >> 3), c4 = (lane & 7) * 4; const f32x4 v = *(const f32x4*)(W + (size_t)(k0 + kk) * N + n0 + c4);
        scr[kk * 33 + c4] = v.x; scr[kk * 33 + c4 + 1] = v.y; scr[kk * 33 + c4 + 2] = v.z; scr[kk * 33 + c4 + 3] = v.w; }
    LDS_WAIT(); asm volatile("" ::: "memory");
    const int c = lane & 7;
#pragma unroll
    for (int j = 0; j < 4; ++j) { const int n = (lane >> 3) + 8 * j; const LAS float* s = scr + (8 * c) * 33 + n;
        u32x2 o; o.x = pk4_fp8(s[0 * 33], s[1 * 33], s[2 * 33], s[3 * 33], F8_W_SCALE); o.y = pk4_fp8(s[4 * 33], s[5 * 33], s[6 * 33], s[7 * 33], F8_W_SCALE);
        *(GAS u32x2*)(WT + (size_t)(dst_row0 + n) * K + k0 + 8 * c) = o; }
    LDS_WAIT(); asm volatile("" ::: "memory");
}

constexpr int MOE_I_DN = 32 * 512, MOE_I_GU = 32 * 1024, MOE_NIT = MOE_I_DN + MOE_I_GU, MOE_P1_ITEMS = 28672;
__device__ __forceinline__ void moe_convert_items(const float* wdn, const float* wgu, unsigned char* WDN8, unsigned char* WGU8, LAS float* scr, int first, int limit, int stride, int lane) {
#define MOE_ITEM(it_, W_, N_, WT_, DR_, K0_, N0_) do { int r_ = (it_); if (r_ < MOE_I_DN) { const int e_ = r_ / 512, q_ = r_ % 512, kb_ = q_ / 32, nb_ = q_ % 32; W_ = wdn + (size_t)e_ * 1024 * 1024; N_ = 1024; \
            WT_ = WDN8 + (size_t)e_ * 1024 * 1024; DR_ = 32 * nb_; K0_ = 64 * kb_; N0_ = 32 * nb_; } \
        else { r_ -= MOE_I_DN; const int e_ = r_ / 1024, q_ = r_ % 1024, kb_ = q_ / 64, nb_ = q_ % 64; const int n0_ = 32 * nb_, half_ = n0_ >> 10, j_ = n0_ & 1023; W_ = wgu + (size_t)e_ * 1024 * 2048; N_ = 2048; \
            WT_ = WGU8 + (size_t)e_ * 2048 * 1024; DR_ = 256 * (j_ >> 7) + 128 * half_ + (j_ & 127); K0_ = 64 * kb_; N0_ = n0_; } } while (0)
    F8Item q0, q1, q2, q3; const float* Wq[4]; int Nq[4], DRq[4], K0q[4], N0q[4]; unsigned char* WTq[4];
#define MOE_PREF(Q_, slot_, it_) do { if ((it_) < limit) { MOE_ITEM((it_), Wq[slot_], Nq[slot_], WTq[slot_], DRq[slot_], K0q[slot_], N0q[slot_]); f8_item_load(Q_, Wq[slot_], Nq[slot_], K0q[slot_], N0q[slot_], lane); } } while (0)
    MOE_PREF(q0, 0, first); MOE_PREF(q1, 1, first + stride); MOE_PREF(q2, 2, first + 2 * stride);
    for (int it = first; it < limit; it += 4 * stride) {
        MOE_PREF(q3, 3, it + 3 * stride); f8_item_finish(q0, 1024, WTq[0], DRq[0], scr, K0q[0], lane);
        if (it + stride < limit) { MOE_PREF(q0, 0, it + 4 * stride); f8_item_finish(q1, 1024, WTq[1], DRq[1], scr, K0q[1], lane); }
        if (it + 2 * stride < limit) { MOE_PREF(q1, 1, it + 5 * stride); f8_item_finish(q2, 1024, WTq[2], DRq[2], scr, K0q[2], lane); }
        if (it + 3 * stride < limit) { MOE_PREF(q2, 2, it + 6 * stride); f8_item_finish(q3, 1024, WTq[3], DRq[3], scr, K0q[3], lane); }
    }
#undef MOE_PREF
#undef MOE_ITEM
}

struct Args { const float* in[25]; float* out; unsigned char* ws; int ph_lo, ph_hi, li, pad; };

__global__ void __launch_bounds__(NWAVES * 64, 2) mk_fwd(Args args) {
    extern __shared__ __attribute__((aligned(16))) unsigned char lds_raw[];
    LAS unsigned char* lds = (LAS unsigned char*)lds_raw;
    volatile LAS unsigned* MISC = (volatile LAS unsigned*)(lds + MISC_OFF);
    const int tid = threadIdx.x, lane = tid & 63, wave = __builtin_amdgcn_readfirstlane(tid >> 6);
    const int G = gridDim.x; const int vcu = (G % 8 == 0) ? ((int)blockIdx.x % 8) * (G / 8) + (int)blockIdx.x / 8 : (int)blockIdx.x;
    const int gw = vcu * NWAVES + wave, NGW = G * NWAVES;
    unsigned char* ws = args.ws;
    unsigned* ctl = (unsigned*)(ws + WS_CTL);
    const float* x = args.in[0];
    bf16* WIN_T = (bf16*)(ws + WS_WIN); bf16* WOUT_T = (bf16*)(ws + WS_WOUT); bf16* WGU_T = (bf16*)(ws + WS_WGU); bf16* WDN_T = (bf16*)(ws + WS_WDN);
    bf16* WUP_T = (bf16*)(ws + WS_LORA); bf16* AUP_T = WUP_T + 512 * 64; bf16* GUP_T = AUP_T + 512 * 64;
    bf16* XN = (bf16*)(ws + WS_XN); bf16* Y = (bf16*)(ws + WS_Y); bf16* P = (bf16*)(ws + WS_P);
    float* SR = (float*)(ws + WS_SR); float* SW = (float*)(ws + WS_SW); float* SK = (float*)(ws + WS_SK); float* SV = (float*)(ws + WS_SV); float* SKK = (float*)(ws + WS_SKK); float* SB = (float*)(ws + WS_SB);
    bf16* SG = (bf16*)(ws + WS_SG); float* BDOT = (float*)(ws + WS_BDOT);
    bf16* X1 = (bf16*)(ws + WS_X1); bf16* XIN = (bf16*)(ws + WS_XIN); bf16* ACT = (bf16*)(ws + WS_ACT); bf16* YSLOT = (bf16*)(ws + WS_YSLOT);
    int* TOKE = (int*)(ws + WS_TOKE); float* TOKG = (float*)(ws + WS_TOKG); int* TOKR = (int*)(ws + WS_TOKR); int* DEST = (int*)(ws + WS_DEST);

    for (int u = tid; u < (LDS_BYTES - LDSCTL_OFF) / 4; u += NWAVES * 64) ((LAS unsigned*)(lds + LDSCTL_OFF))[u] = 0u;
    __syncthreads();
    XcdBarrier bar; bar.bar = ctl + CW_BAR; bar.x = 0; bar.st = nullptr;
    if (N_LAUNCHES == 1) bar = xcd_barrier_post(ctl + CW_BAR, MISC + 8);
#define GRID_BAR() do { if (N_LAUNCHES == 1) xcd_barrier(bar); } while (0)
    const int lo = args.ph_lo, hi = args.ph_hi;
#ifndef PHASE_MASK
#define PHASE_MASK 0x3ff
#endif
#define IN(k) (((PHASE_MASK >> (k)) & 1) && lo <= (k) && (k) < hi)
#define BOTH(k) (IN(k) && IN((k) + 1))

    if (IN(0)) {
        LAS float* scr = (LAS float*)(lds + wave * 16384);
        constexpr int I_IN = 16 * 104, I_OUT = 16 * 32, I_WUP = 16, I_AUP = 16, I_GUP = 32;
        constexpr int NITEMS = I_IN + I_OUT + I_WUP + I_AUP + I_GUP;
        for (int it = gw; it < NITEMS; it += NGW) {
            int r = it;
            if (r < I_IN) { const int kb = r / 104, nb = r % 104; p0_transpose_item_g(args.in[1], 1024, IN_COLS, WIN_T, 32 * nb, scr, 64 * kb, 32 * nb, lane, args.in[16]); continue; } r -= I_IN;
            if (r < I_OUT) { const int kb = r / 32, nb = r % 32; p0_transpose_item(args.in[15], 1024, 1024, WOUT_T, 32 * nb, scr, 64 * kb, 32 * nb, lane); continue; } r -= I_OUT;
            if (r < I_WUP) { p0_transpose_item(args.in[6], 64, 512, WUP_T, 32 * r, scr, 0, 32 * r, lane); continue; } r -= I_WUP;
            if (r < I_AUP) { p0_transpose_item(args.in[8], 64, 512, AUP_T, 32 * r, scr, 0, 32 * r, lane); continue; } r -= I_AUP;
            { const int kb = r / 16, nb = r % 16; p0_transpose_item(args.in[9], 128, 512, GUP_T, 32 * nb, scr, 64 * kb, 32 * nb, lane); }
        }
        float* RMS = (float*)(ws + WS_RMS);
        for (int m = gw; m < M; m += NGW) {
            const GAS f32x4* xr = (const GAS f32x4*)(x + (size_t)m * D) + lane; f32x4 v[4]; float s = 0.f;
#pragma unroll
            for (int j = 0; j < 4; ++j) { v[j] = xr[64 * j]; s += (v[j].x * v[j].x + v[j].y * v[j].y) + (v[j].z * v[j].z + v[j].w * v[j].w); }
            const float ms = wave_sum(s) * (1.f / D) + NORM_EPS; const float rstd = 1.0f / sqrtf(ms);
            if (lane == 0) RMS[m] = sqrtf(ms);
            GAS unsigned long long* o8 = (GAS unsigned long long*)(XN + (size_t)m * D) + lane;
#pragma unroll
            for (int j = 0; j < 4; ++j)
                o8[64 * j] = (unsigned long long)pk2(v[j].x * rstd, v[j].y * rstd) | ((unsigned long long)pk2(v[j].z * rstd, v[j].w * rstd) << 32);
        }
        if (BOTH(0)) GRID_BAR();
    }

    if (IN(1)) {
        constexpr int P1_GEMM_WGS = 208;
        const bool split = (G == 256);
        if (!split || (int)blockIdx.x < P1_GEMM_WGS) {
            pg8::Gemm g{XN, WIN_T, M, IN_COLS, D, 0, 0, nullptr}; pg8::StaticOrder S; S.init(M, IN_COLS, split ? P1_GEMM_WGS : G, (int)blockIdx.x);
            pg8::EpiBiasBf16 E{P, IN_COLS, nullptr, 0};
            pg8::gemm_phase<pg8::EpiBiasBf16, pg8::StaticOrder, PG8_ALIGN, PG8_SP2>(lds, g, S, E);
        } else {
            moe_convert_items(args.in[22], args.in[20], (unsigned char*)WDN_T, (unsigned char*)WGU_T, (LAS float*)(lds + wave * 16384), ((int)blockIdx.x - P1_GEMM_WGS) * NWAVES + wave, MOE_P1_ITEMS, (G - P1_GEMM_WGS) * NWAVES, lane);
        }
        if (BOTH(1)) GRID_BAR();
    }

    if (IN(2)) {
        const float* mu = args.in[4]; const float* w0 = args.in[5]; const float* a0 = args.in[7]; const float* k_k = args.in[10]; const float* k_a = args.in[11]; const float* r_k = args.in[12];
        const float* conv_w = args.in[2]; const float* conv_g = args.in[3];
        v4u* QF = (v4u*)(ws + WS_QF); u32x2* O1F = (u32x2*)(ws + WS_O1); v4u* GF = (v4u*)(ws + WS_GF); v4u* HF = (v4u*)(ws + WS_HF); float* PCG = (float*)(ws + WS_PC);
        v4u* FRG = (v4u*)(ws + WS_FR);
#define PACK8(lo, hi) __builtin_bit_cast(pg8::bf16x8, (v4u){cvtpk_s((lo)[0], (lo)[1]), cvtpk_s((lo)[2], (lo)[3]), cvtpk_s((hi)[0], (hi)[1]), cvtpk_s((hi)[2], (hi)[3])})
#define MFMA16(a, b, c) __builtin_amdgcn_mfma_f32_16x16x32_bf16((a), (b), (c), 0, 0, 0)
        const f32x4 Z4 = (f32x4){0.f, 0.f, 0.f, 0.f};
        const int h = wave;
        {
            LAS float* cst0 = (LAS float*)(lds + 16896 + wave * 16128 + 12288);
            cst0[0 * 64 + lane] = mu[h * 64 + lane]; cst0[1 * 64 + lane] = mu[512 + h * 64 + lane]; cst0[2 * 64 + lane] = mu[1024 + h * 64 + lane]; cst0[3 * 64 + lane] = k_k[h * 64 + lane];
            cst0[4 * 64 + lane] = k_a[h * 64 + lane]; cst0[5 * 64 + lane] = a0[h * 64 + lane]; cst0[6 * 64 + lane] = w0[h * 64 + lane]; cst0[7 * 64 + lane] = r_k[h * 64 + lane];
            LDS_WAIT(); }
        for (int ck = vcu; ck < M / CHK; ck += G) {
            int tid_ = tid; asm volatile("" : "+v"(tid_)); const int lane_ = tid_ & 63;
            const int fr = lane_ & 15, fq = lane_ >> 4;
            LAS unsigned char* wl = lds + 16896 + wave * 16128;
            LAS bf16* TB = (LAS bf16*)wl;
            LAS float* Amat = (LAS float*)(wl + 5120);
            LAS bf16* Tm = (LAS bf16*)(wl + 9728);
            const LAS float* cst = (const LAS float*)(wl + 12288);
            const int T0 = ck * CHK; const int bb = T0 / SEQ, n = (T0 % SEQ) / CHK; const int chh = (bb * NH + h) * NCH + n;
            {
                const int c8 = (tid_ & 31) * 8, tr = tid_ >> 5;
                const f32x4 mu0 = *(const f32x4*)(mu + 1536 + c8), mu1 = *(const f32x4*)(mu + 1536 + c8 + 4);
                const float mm[8] = {mu0.x, mu0.y, mu0.z, mu0.w, mu1.x, mu1.y, mu1.z, mu1.w};
#pragma unroll
                for (int i = 0; i < 2; ++i) { const int tk = tr + 16 * i, t = T0 + tk;
                    const v4u cur = __builtin_nontemporal_load((const v4u*)(P + (size_t)t * IN_COLS + 3072 + c8));
                    v4u prv = (v4u){0u, 0u, 0u, 0u}; if ((t % SEQ) != 0) prv = __builtin_nontemporal_load((const v4u*)(P + (size_t)(t - 1) * IN_COLS + 3072 + c8));
                    const unsigned cw[4] = {cur.x, cur.y, cur.z, cur.w}, pw[4] = {prv.x, prv.y, prv.z, prv.w}; float f[8];
#pragma unroll
                    for (int j = 0; j < 4; ++j) { const float c0 = bf_lo(cw[j]), c1 = bf_hi(cw[j]), p0 = bf_lo(pw[j]), p1 = bf_hi(pw[j]);
                        const float q0 = c0 + (p0 - c0) * mm[2 * j], q1 = c1 + (p1 - c1) * mm[2 * j + 1];
                        f[2 * j] = (c8 < 64) ? fast_tanh(q0) : ((c8 < 128) ? q0 : fast_sigmoid(q0)); f[2 * j + 1] = (c8 < 64) ? fast_tanh(q1) : ((c8 < 128) ? q1 : fast_sigmoid(q1)); }
                    v4u o; o.x = pk2(f[0], f[1]); o.y = pk2(f[2], f[3]); o.z = pk2(f[4], f[5]); o.w = pk2(f[6], f[7]);
                    *(LAS v4u*)(lds + tk * 528 + c8 * 2) = o; }
            }
            __syncthreads();
#define TB_WRITE_T(X_, tt_) do { _Pragma("unroll") for (int m_ = 0; m_ < 4; ++m_) _Pragma("unroll") for (int j_ = 0; j_ < 4; ++j_) \
                TB[(16 * m_ + 4 * fq + j_) * 40 + 16 * (tt_) + fr] = (bf16)(cvtpk_s(X_[m_][j_], 0.f) & 0xffffu); } while (0)
#define TB_READ(fbase_) do { LDS_WAIT(); asm volatile("" ::: "memory"); _Pragma("unroll") for (int q_ = 0; q_ < 4; ++q_) { const u32x2 lo_ = *(const LAS u32x2*)(TB + (16 * q_ + fr) * 40 + 4 * fq), hi_ = *(const LAS u32x2*)(TB + (16 * q_ + fr) * 40 + 16 + 4 * fq); \
                frw[((fbase_) + q_) * 64] = (v4u){lo_.x, lo_.y, hi_.x, hi_.y}; } LDS_WAIT(); asm volatile("" ::: "memory"); } while (0)
#define UNPK(w_) ((f32x4){bf_lo((w_).x), bf_hi((w_).x), bf_lo((w_).y), bf_hi((w_).y)})
            const size_t prow0 = (size_t)T0 * IN_COLS + 1536 + h * 64 + 4 * fq;
            f32x4 ev[2][4]; u32x2 avp[2][4]; u32x2 kkp[2][4] = {}, b0p[2][4] = {}, kmp[2][4] = {};
#pragma unroll
            for (int m = 0; m < 4; ++m) { const int row = h * 64 + 16 * m + fr; const int cl = 16 * m + 4 * fq;
                pg8::bf16x8 ww[2], wa[2], wg[4];
#pragma unroll
                for (int ks = 0; ks < 2; ++ks) { ww[ks] = *(const pg8::bf16x8*)(WUP_T + row * 64 + ks * 32 + fq * 8); wa[ks] = *(const pg8::bf16x8*)(AUP_T + row * 64 + ks * 32 + fq * 8); }
#pragma unroll
                for (int ks = 0; ks < 4; ++ks) wg[ks] = *(const pg8::bf16x8*)(GUP_T + row * 128 + ks * 32 + fq * 8);
                const f32x4 a0v = *(const LAS f32x4*)(cst + 5 * 64 + cl), w0v = *(const LAS f32x4*)(cst + 6 * 64 + cl);
#pragma unroll
                for (int tt = 0; tt < 2; ++tt) { const LAS unsigned char* lrow = lds + (16 * tt + fr) * 528 + fq * 16; f32x4 aw = Z4, aa = Z4, ag = Z4;
#pragma unroll
                    for (int ks = 0; ks < 2; ++ks) { aw = MFMA16(ww[ks], *(const LAS pg8::bf16x8*)(lrow + ks * 64), aw); aa = MFMA16(wa[ks], *(const LAS pg8::bf16x8*)(lrow + (2 + ks) * 64), aa); }
#pragma unroll
                    for (int ks = 0; ks < 4; ++ks) ag = MFMA16(wg[ks], *(const LAS pg8::bf16x8*)(lrow + (4 + ks) * 64), ag);
                    f32x4 avv;
#pragma unroll
                    for (int j = 0; j < 4; ++j) { avv[j] = fast_sigmoid(a0v[j] + aa[j]); const float wlin = w0v[j] + aw[j];
                        const float sp = fmaxf(-wlin, 0.f) + 0.69314718056f * __builtin_amdgcn_logf(1.0f + __builtin_amdgcn_exp2f(-1.44269504089f * fabsf(wlin))); ev[tt][m][j] = __builtin_amdgcn_exp2f(-1.44269504089f * (sp + 0.5f)); }
                    avp[tt][m] = (u32x2){cvtpk_s(avv[0], avv[1]), cvtpk_s(avv[2], avv[3])};
                    u32x2 go; go.x = cvtpk_s(ag[0], ag[1]); go.y = cvtpk_s(ag[2], ag[3]); *(u32x2*)(SG + (size_t)(T0 + 16 * tt + fr) * RW + h * 64 + cl) = go; }
                __builtin_amdgcn_sched_barrier(0); }
#pragma unroll 1
            for (int tt = 0; tt < 2; ++tt) { u32x2 kkt[4], b0t[4], kmt[4]; int frl = fr, fql = fq; asm volatile("" : "+v"(frl), "+v"(fql)); const int PFR = frl; const int tk = 16 * tt + frl; const size_t tok = (size_t)(T0 + tk); const bool first = (tok % SEQ) == 0; const size_t prow = (size_t)T0 * IN_COLS + 1536 + h * 64 + 4 * fql + (size_t)tk * IN_COLS;
                f32x4 kq[4]; float ss = 0.f;
#pragma unroll
                for (int m = 0; m < 4; ++m) { const int cl = 16 * m + 4 * fql; const f32x4 muk = *(const LAS f32x4*)(cst + 1 * 64 + cl), kkv = *(const LAS f32x4*)(cst + 3 * 64 + cl);
                    const u32x2 cu = *(const u32x2*)(P + prow + 512 + 16 * m); u32x2 pu = (u32x2){0u, 0u}; if (!first && PFR == 0) pu = *(const u32x2*)(P + prow - IN_COLS + 512 + 16 * m); pu.x = (unsigned)__builtin_amdgcn_update_dpp((int)pu.x, (int)cu.x, 0x111, 0xf, 0xf, false); pu.y = (unsigned)__builtin_amdgcn_update_dpp((int)pu.y, (int)cu.y, 0x111, 0xf, 0xf, false);
                    const f32x4 cf = UNPK(cu), pf = UNPK(pu); kq[m] = cf + (pf - cf) * muk;
#pragma unroll
                    for (int j = 0; j < 4; ++j) { const float kr = kq[m][j] * kkv[j]; ss += kr * kr; } }
                ss += __shfl_xor(ss, 16); ss += __shfl_xor(ss, 32); const float inv = 1.0f / fmaxf(sqrtf(ss), 1e-12f);
#pragma unroll
                for (int m = 0; m < 4; ++m) { const int cl = 16 * m + 4 * fql; const f32x4 kkv = *(const LAS f32x4*)(cst + 3 * 64 + cl), kav = *(const LAS f32x4*)(cst + 4 * 64 + cl);
                    const u32x2 avq = (tt == 0) ? avp[0][m] : avp[1][m]; const f32x4 av = UNPK(avq);
                    const f32x4 kk = kq[m] * kkv * inv, bq = kk * av, kmv = kq[m] * (1.0f + (av - 1.0f) * kav);
                    kkt[m] = (u32x2){cvtpk_s(kk[0], kk[1]), cvtpk_s(kk[2], kk[3])}; b0t[m] = (u32x2){cvtpk_s(bq[0], bq[1]), cvtpk_s(bq[2], bq[3])}; kmt[m] = (u32x2){cvtpk_s(kmv[0], kmv[1]), cvtpk_s(kmv[2], kmv[3])}; }
#pragma unroll
                for (int m = 0; m < 4; ++m) { if (tt == 0) { kkp[0][m] = kkt[m]; b0p[0][m] = b0t[m]; kmp[0][m] = kmt[m]; } else { kkp[1][m] = kkt[m]; b0p[1][m] = b0t[m]; kmp[1][m] = kmt[m]; } }
                asm volatile("" ::: "memory"); __builtin_amdgcn_sched_barrier(0); }
            LAS float* pcl = (LAS float*)(wl + 14336);
#pragma unroll
            for (int m = 0; m < 4; ++m)
#pragma unroll
                for (int j = 0; j < 4; ++j) { float x0 = ev[0][m][j], x1 = ev[1][m][j];
#define DPP_SHR(v_, n_) __builtin_bit_cast(float, __builtin_amdgcn_update_dpp(0, __builtin_bit_cast(int, (v_)), 0x110 + (n_), 0xf, 0xf, false))
                    x0 += DPP_SHR(x0, 1); x1 += DPP_SHR(x1, 1); x0 += DPP_SHR(x0, 2); x1 += DPP_SHR(x1, 2); x0 += DPP_SHR(x0, 4); x1 += DPP_SHR(x1, 4); x0 += DPP_SHR(x0, 8); x1 += DPP_SHR(x1, 8);
                    const float tot0 = __shfl(x0, 15, 16); x1 += tot0; ev[0][m][j] = x0; ev[1][m][j] = x1; }
#define cum ev
            if (fr == 15) {
#pragma unroll
                for (int m = 0; m < 4; ++m) { *(LAS f32x4*)(pcl + 16 * m + 4 * fq) = cum[1][m]; f32x4 pcv;
#pragma unroll
                    for (int j = 0; j < 4; ++j) pcv[j] = __expf(-cum[1][m][j]);
                    *(f32x4*)(PCG + (size_t)chh * 64 + 16 * m + 4 * fq) = pcv; } }
            LDS_WAIT(); asm volatile("" ::: "memory");
            v4u* frw = FRG + (size_t)gw * 32 * 64 + lane_;
#define FR_ST(f_, val_) (frw[(f_) * 64] = __builtin_bit_cast(v4u, (val_)))
            {
                f32x4 em0[4];
#pragma unroll
                for (int tt = 0; tt < 2; ++tt) { f32x4 x1[4];
#pragma unroll
                    for (int m = 0; m < 4; ++m) { const f32x4 kk = UNPK(kkp[tt][m]);
#pragma unroll
                        for (int j = 0; j < 4; ++j) { const float em = __expf(-cum[tt][m][j]); float pv = DPP_SHR(em, 1);
                            if (tt == 0) { em0[m][j] = em; if (fr == 0) pv = 1.0f; } else { const float last0 = __shfl(em0[m][j], 15, 16); if (fr == 0) pv = last0; }
                            x1[m][j] = -kk[j] * pv; } }
#pragma unroll
                    for (int ks = 0; ks < 2; ++ks) FR_ST(0 + 2 * tt + ks, PACK8(x1[2 * ks], x1[2 * ks + 1]));
                    TB_WRITE_T(x1, tt); }
            }
            TB_READ(16);
#pragma unroll
            for (int tt = 0; tt < 2; ++tt) {
                f32x4 x1[4], x2[4];
#pragma unroll
                for (int m = 0; m < 4; ++m) { const f32x4 bq = UNPK(b0p[tt][m]); const f32x4 cC = *(const LAS f32x4*)(pcl + 16 * m + 4 * fq);
#pragma unroll
                    for (int j = 0; j < 4; ++j) { x1[m][j] = bq[j] * __expf(cum[tt][m][j] - cC[j]); x2[m][j] = bq[j] * __expf(cum[tt][m][j]); } }
#pragma unroll
                for (int ks = 0; ks < 2; ++ks) FR_ST(4 + 2 * tt + ks, PACK8(x2[2 * ks], x2[2 * ks + 1]));
                TB_WRITE_T(x1, tt); }
            TB_READ(20);
#pragma unroll
            for (int tt = 0; tt < 2; ++tt) {
                f32x4 x1[4], x2[4];
#pragma unroll
                for (int m = 0; m < 4; ++m) { const f32x4 kmv = UNPK(kmp[tt][m]); const f32x4 cC = *(const LAS f32x4*)(pcl + 16 * m + 4 * fq);
#pragma unroll
                    for (int j = 0; j < 4; ++j) { x1[m][j] = kmv[j] * __expf(cum[tt][m][j] - cC[j]); x2[m][j] = kmv[j] * __expf(cum[tt][m][j]); } }
#pragma unroll
                for (int ks = 0; ks < 2; ++ks) FR_ST(8 + 2 * tt + ks, PACK8(x2[2 * ks], x2[2 * ks + 1]));
                TB_WRITE_T(x1, tt); }
            TB_READ(24);
#pragma unroll
            for (int tt = 0; tt < 2; ++tt) {
                f32x4 x1[4]; const int PFR = fr; const int tk = 16 * tt + fr; const bool first = ((T0 + tk) % SEQ) == 0; const size_t prow = prow0 + (size_t)tk * IN_COLS; float bd = 0.f;
#pragma unroll
                for (int m = 0; m < 4; ++m) { const int c = h * 64 + 16 * m + 4 * fq; const f32x4 mur = *(const LAS f32x4*)(cst + 0 * 64 + 16 * m + 4 * fq), rkv = *(const LAS f32x4*)(cst + 7 * 64 + 16 * m + 4 * fq);
                    const u32x2 cu = *(const u32x2*)(P + prow + 16 * m); u32x2 pu = (u32x2){0u, 0u}; if (!first && PFR == 0) pu = *(const u32x2*)(P + prow - IN_COLS + 16 * m); pu.x = (unsigned)__builtin_amdgcn_update_dpp((int)pu.x, (int)cu.x, 0x111, 0xf, 0xf, false); pu.y = (unsigned)__builtin_amdgcn_update_dpp((int)pu.y, (int)cu.y, 0x111, 0xf, 0xf, false);
                    const f32x4 cf = UNPK(cu), pf = UNPK(pu); const f32x4 rq = cf + (pf - cf) * mur; const f32x4 pr = rq * UNPK(kmp[tt][m]) * rkv; bd += (pr.x + pr.y) + (pr.z + pr.w);
#pragma unroll
                    for (int j = 0; j < 4; ++j) x1[m][j] = rq[j] * __expf(-cum[tt][m][j]); }
                bd += __shfl_xor(bd, 16); bd += __shfl_xor(bd, 32);
                if (fq == 0) BDOT[(size_t)(T0 + tk) * NH + h] = bd;
#pragma unroll
                for (int ks = 0; ks < 2; ++ks) FR_ST(12 + 2 * tt + ks, PACK8(x1[2 * ks], x1[2 * ks + 1])); }
#pragma unroll
            for (int tt = 0; tt < 2; ++tt) {
                f32x4 x1[4]; const int PFR = fr; const int tk = 16 * tt + fr; const bool first = ((T0 + tk) % SEQ) == 0; const size_t prow = prow0 + (size_t)tk * IN_COLS;
#pragma unroll
                for (int m = 0; m < 4; ++m) { const int c = h * 64 + 16 * m + 4 * fq; const f32x4 muv = *(const LAS f32x4*)(cst + 2 * 64 + 16 * m + 4 * fq);
                    const u32x2 cu = *(const u32x2*)(P + prow + 1024 + 16 * m); u32x2 pu = (u32x2){0u, 0u}; if (!first && PFR == 0) pu = *(const u32x2*)(P + prow - IN_COLS + 1024 + 16 * m); pu.x = (unsigned)__builtin_amdgcn_update_dpp((int)pu.x, (int)cu.x, 0x111, 0xf, 0xf, false); pu.y = (unsigned)__builtin_amdgcn_update_dpp((int)pu.y, (int)cu.y, 0x111, 0xf, 0xf, false);
                    const f32x4 cf = UNPK(cu), pf = UNPK(pu); x1[m] = cf + (pf - cf) * muv; *(u32x2*)((bf16*)SV + (size_t)(T0 + tk) * RW + c) = (u32x2){cvtpk_s(x1[m][0], x1[m][1]), cvtpk_s(x1[m][2], x1[m][3])}; }
                TB_WRITE_T(x1, tt); }
            TB_READ(28);
            asm volatile("s_waitcnt vmcnt(0)" ::: "memory");
#define FR_LD(f_) __builtin_bit_cast(pg8::bf16x8, __builtin_nontemporal_load(frw + (f_) * 64))
            pg8::bf16x8 Aak[2], Arb[2], Ark[2], Rt[2][2];
            {
                pg8::bf16x8 At[2][2], Bt[2][2], Kt[2][2];
#pragma unroll
                for (int tt = 0; tt < 2; ++tt)
#pragma unroll
                    for (int ks = 0; ks < 2; ++ks) { At[tt][ks] = FR_LD(0 + 2 * tt + ks); Bt[tt][ks] = FR_LD(4 + 2 * tt + ks); Kt[tt][ks] = FR_LD(8 + 2 * tt + ks); Rt[tt][ks] = FR_LD(12 + 2 * tt + ks); }
                f32x4 Dab[2][2], Dak[2][2], Drb[2][2], Drk[2][2];
#pragma unroll
                for (int jt = 0; jt < 2; ++jt)
#pragma unroll
                    for (int tt = 0; tt < 2; ++tt) { Dab[jt][tt] = Z4; Dak[jt][tt] = Z4; Drb[jt][tt] = Z4; Drk[jt][tt] = Z4;
#pragma unroll
                        for (int ks = 0; ks < 2; ++ks) { Dab[jt][tt] = MFMA16(Bt[jt][ks], At[tt][ks], Dab[jt][tt]); Dak[jt][tt] = MFMA16(Kt[jt][ks], At[tt][ks], Dak[jt][tt]);
                            Drb[jt][tt] = MFMA16(Bt[jt][ks], Rt[tt][ks], Drb[jt][tt]); Drk[jt][tt] = MFMA16(Kt[jt][ks], Rt[tt][ks], Drk[jt][tt]); }
#pragma unroll
                        for (int jj = 0; jj < 4; ++jj) { const int j = 16 * jt + 4 * fq + jj, t = 16 * tt + fr;
                            if (!(j < t)) { Dab[jt][tt][jj] = 0.f; Dak[jt][tt][jj] = 0.f; }
                            if (!(j <= t)) { Drb[jt][tt][jj] = 0.f; Drk[jt][tt][jj] = 0.f; } }
                        *(LAS f32x4*)(Amat + (16 * tt + fr) * 36 + 16 * jt + 4 * fq) = Dab[jt][tt]; }
#pragma unroll
                for (int tt = 0; tt < 2; ++tt) { Aak[tt] = PACK8(Dak[0][tt], Dak[1][tt]); Arb[tt] = PACK8(Drb[0][tt], Drb[1][tt]); Ark[tt] = PACK8(Drk[0][tt], Drk[1][tt]); }
            }
            LDS_WAIT(); asm volatile("" ::: "memory");
            {
                const int col = lane_ & 31; float xs[32];
#pragma unroll
                for (int t = 0; t < 32; ++t) { float s0 = (t == col) ? 1.0f : 0.0f, s1 = 0.f;
#pragma unroll
                    for (int j4 = 0; j4 < (t + 3) / 4; ++j4) { const f32x4 a4 = *(const LAS f32x4*)(Amat + t * 36 + 4 * j4);
                        if (4 * j4 + 0 < t) s0 += a4[0] * xs[4 * j4 + 0]; if (4 * j4 + 1 < t) s1 += a4[1] * xs[4 * j4 + 1];
                        if (4 * j4 + 2 < t) s0 += a4[2] * xs[4 * j4 + 2]; if (4 * j4 + 3 < t) s1 += a4[3] * xs[4 * j4 + 3]; }
                    xs[t] = s0 + s1; }
                if (lane_ < 32) {
#pragma unroll
                    for (int t = 0; t < 32; ++t) Tm[t * 40 + col] = (bf16)f2bf(xs[t]); }
            }
            LDS_WAIT(); asm volatile("" ::: "memory");
            pg8::bf16x8 Tf[2];
#pragma unroll
            for (int tt = 0; tt < 2; ++tt) { const u32x2 lo = *(const LAS u32x2*)(Tm + (16 * tt + fr) * 40 + 4 * fq), hi = *(const LAS u32x2*)(Tm + (16 * tt + fr) * 40 + 16 + 4 * fq);
                Tf[tt] = __builtin_bit_cast(pg8::bf16x8, (v4u){lo.x, lo.y, hi.x, hi.y}); }
            pg8::bf16x8 Wp[4], U0p[4], Vf[4];
#pragma unroll
            for (int q = 0; q < 4; ++q) Vf[q] = FR_LD(28 + q);
            {
                pg8::bf16x8 Y2p[4], Af[4];
#pragma unroll
                for (int q = 0; q < 4; ++q) Af[q] = FR_LD(16 + q);
#pragma unroll
                for (int vt = 0; vt < 4; ++vt) { const f32x4 y0 = MFMA16(Aak[0], Vf[vt], Z4), y1 = MFMA16(Aak[1], Vf[vt], Z4); Y2p[vt] = PACK8(y0, y1); }
#pragma unroll
                for (int q = 0; q < 4; ++q) { const f32x4 wa = MFMA16(Tf[0], Af[q], Z4), wb = MFMA16(Tf[1], Af[q], Z4); Wp[q] = PACK8(wa, wb);
                    const f32x4 u0 = MFMA16(Tf[0], Y2p[q], Z4), u1 = MFMA16(Tf[1], Y2p[q], Z4); U0p[q] = PACK8(u0, u1); }
            }
#pragma unroll
            for (int tt = 0; tt < 2; ++tt) {
                f32x4 qt[4];
#pragma unroll
                for (int ct = 0; ct < 4; ++ct) { const v4u rw = __builtin_bit_cast(v4u, Rt[tt][ct >> 1]); const unsigned r0 = (ct & 1) ? rw.z : rw.x, r1 = (ct & 1) ? rw.w : rw.y;
                    qt[ct] = MFMA16(Wp[ct], Arb[tt], ((f32x4){bf_lo(r0), bf_hi(r0), bf_lo(r1), bf_hi(r1)})); }
#pragma unroll
                for (int ks = 0; ks < 2; ++ks) __builtin_nontemporal_store(__builtin_bit_cast(v4u, PACK8(qt[2 * ks], qt[2 * ks + 1])), QF + (((size_t)chh * 2 + tt) * 2 + ks) * 64 + lane_);
#pragma unroll
                for (int vt = 0; vt < 4; ++vt) { f32x4 o = MFMA16(U0p[vt], Arb[tt], Z4); o = MFMA16(Vf[vt], Ark[tt], o);
                    u32x2 w; w.x = cvtpk_s(o[0], o[1]); w.y = cvtpk_s(o[2], o[3]); __builtin_nontemporal_store(w, O1F + (((size_t)chh * 4 + vt) * 2 + tt) * 64 + lane_); } }
            pg8::bf16x8 Bh[4], Kh[4];
#pragma unroll
            for (int q = 0; q < 4; ++q) { Bh[q] = FR_LD(20 + q); Kh[q] = FR_LD(24 + q); }
#pragma unroll
            for (int m = 0; m < 4; ++m) { f32x4 gt[4];
#pragma unroll
                for (int ct = 0; ct < 4; ++ct) gt[ct] = MFMA16(Wp[ct], Bh[m], Z4);
#pragma unroll
                for (int ks = 0; ks < 2; ++ks) __builtin_nontemporal_store(__builtin_bit_cast(v4u, PACK8(gt[2 * ks], gt[2 * ks + 1])), GF + (((size_t)chh * 4 + m) * 2 + ks) * 64 + lane_); }
#pragma unroll
            for (int mp = 0; mp < 2; ++mp)
#pragma unroll
                for (int vt = 0; vt < 4; ++vt) { f32x4 ha = MFMA16(Bh[2 * mp], U0p[vt], Z4); ha = MFMA16(Kh[2 * mp], Vf[vt], ha); f32x4 hb2 = MFMA16(Bh[2 * mp + 1], U0p[vt], Z4); hb2 = MFMA16(Kh[2 * mp + 1], Vf[vt], hb2);
                    __builtin_nontemporal_store(__builtin_bit_cast(v4u, PACK8(ha, hb2)), HF + (((size_t)chh * 4 + vt) * 2 + mp) * 64 + lane_); }
            {
                const int t0 = T0 + wave * 4, tb0 = t0 % SEQ; const int c8 = lane_ * 8;
                v4u ur[6], cr[6], br[4];
#pragma unroll
                for (int d = 0; d < 6; ++d) { const bool ok = (tb0 + d - 2) >= 0; const size_t ro = (size_t)(t0 + d - 2) * IN_COLS;
                    ur[d] = (v4u){0u, 0u, 0u, 0u}; cr[d] = ur[d]; if (ok) { ur[d] = __builtin_nontemporal_load((const v4u*)(P + ro + c8)); cr[d] = __builtin_nontemporal_load((const v4u*)(P + ro + 1024 + c8)); } }
#pragma unroll
                for (int i = 0; i < 4; ++i) br[i] = __builtin_nontemporal_load((const v4u*)(P + (size_t)(t0 + i) * IN_COLS + 512 + c8));
                float cw0[8], cw1[8], cw2[8], cg[8];
#pragma unroll
                for (int j = 0; j < 8; ++j) { cw0[j] = conv_w[c8 + j]; cw1[j] = conv_w[512 + c8 + j]; cw2[j] = conv_w[1024 + c8 + j]; cg[j] = conv_g[c8 + j]; }
                float z[6][8];
#pragma unroll
                for (int d = 0; d < 6; ++d) { const unsigned uw[4] = {ur[d].x, ur[d].y, ur[d].z, ur[d].w}, cw[4] = {cr[d].x, cr[d].y, cr[d].z, cr[d].w};
#pragma unroll
                    for (int j = 0; j < 4; ++j) { z[d][2 * j] = bf_lo(uw[j]) * bf_lo(cw[j]); z[d][2 * j + 1] = bf_hi(uw[j]) * bf_hi(cw[j]); } }
#pragma unroll
                for (int i = 0; i < 4; ++i) { const unsigned bw[4] = {br[i].x, br[i].y, br[i].z, br[i].w}; float yv[8], ss = 0.f;
#pragma unroll
                    for (int j = 0; j < 8; ++j) { const float bg = (j & 1) ? bf_hi(bw[j >> 1]) : bf_lo(bw[j >> 1]); const float cv = cw0[j] * z[i][j] + cw1[j] * z[i + 1][j] + cw2[j] * z[i + 2][j]; yv[j] = bg * cv; ss += yv[j] * yv[j]; }
                    ss += __shfl_xor(ss, 1); ss += __shfl_xor(ss, 2); ss += __shfl_xor(ss, 4);
                    const float rs = 1.0f / sqrtf(ss * (1.0f / 64.0f) + NORM_EPS);
                    v4u o; o.x = pk2(yv[0] * rs * cg[0], yv[1] * rs * cg[1]); o.y = pk2(yv[2] * rs * cg[2], yv[3] * rs * cg[3]); o.z = pk2(yv[4] * rs * cg[4], yv[5] * rs * cg[5]); o.w = pk2(yv[6] * rs * cg[6], yv[7] * rs * cg[7]);
                    *(v4u*)(Y + (size_t)(t0 + i) * D + c8) = o; }
            }
            LDS_WAIT();
            __syncthreads();
        }
#undef TB_WRITE_T
#undef DPP_SHR
#undef FR_ST
#undef FR_LD
#undef cum
#undef TB_READ
#undef UNPK
#undef PACK8
#undef MFMA16
        if (BOTH(2)) GRID_BAR();
    }

#define PACK8(lo, hi) __builtin_bit_cast(pg8::bf16x8, (v4u){cvtpk_s((lo)[0], (lo)[1]), cvtpk_s((lo)[2], (lo)[3]), cvtpk_s((hi)[0], (hi)[1]), cvtpk_s((hi)[2], (hi)[3])})
#define MFMA16(a, b, c) __builtin_amdgcn_mfma_f32_16x16x32_bf16((a), (b), (c), 0, 0, 0)
    if (IN(3)) {
        constexpr int RSLOT = 10752, RING_R = 15, RING_D = 13, NSCAN = BATCH * NH * 4;
        static_assert(RSLOT * RING_R <= LDSCTL_OFF && NCH % 2 == 0, "scan ring fits");
        if ((int)blockIdx.x < NSCAN) {
            const int fr = lane & 15, fq = lane >> 4; const int bxs = (int)blockIdx.x; const int vt = (bxs >> 3) & 3, bh = (bxs & 7) + 8 * (bxs >> 5); const bool ldr = wave < 4, act = wave == 0;
            const v4u* GF = (const v4u*)(ws + WS_GF); const v4u* HF = (const v4u*)(ws + WS_HF); const float* PCG = (const float*)(ws + WS_PC); v4u* SF = (v4u*)(ws + WS_SF);
            const int ch0 = bh * NCH;
            f32x4 acc[4];
#pragma unroll
            for (int m = 0; m < 4; ++m) acc[m] = (f32x4){0.f, 0.f, 0.f, 0.f};
#define P3B_ISSUE(step_) do { const int cn_ = ch0 + ((step_) < NCH ? (step_) : NCH - 1); LAS unsigned char* sl_ = lds + ((step_) % RING_R) * RSLOT; \
                __builtin_amdgcn_global_load_lds((const unsigned*)(GF + (((size_t)cn_ * 4 + wave) * 2 + 0) * 64 + lane), (LAS unsigned*)(sl_ + (wave * 2 + 0) * 1024), 16, 0, 0); \
                __builtin_amdgcn_global_load_lds((const unsigned*)(GF + (((size_t)cn_ * 4 + wave) * 2 + 1) * 64 + lane), (LAS unsigned*)(sl_ + (wave * 2 + 1) * 1024), 16, 0, 0); \
                if (wave == 1) { __builtin_amdgcn_global_load_lds((const unsigned*)(HF + (((size_t)cn_ * 4 + vt) * 2 + 0) * 64 + lane), (LAS unsigned*)(sl_ + 8192), 16, 0, 0); \
                                 __builtin_amdgcn_global_load_lds((const unsigned*)(HF + (((size_t)cn_ * 4 + vt) * 2 + 1) * 64 + lane), (LAS unsigned*)(sl_ + 9216), 16, 0, 0); } \
                if (wave == 2) __builtin_amdgcn_global_load_lds((const unsigned*)(PCG + (size_t)cn_ * 64 + lane), (LAS unsigned*)(sl_ + 10240), 4, 0, 0); } while (0)
#define P3B_READ(G_, H_, P_, step_) do { const LAS unsigned char* sl_ = lds + ((step_) % RING_R) * RSLOT; _Pragma("unroll") for (int m = 0; m < 4; ++m) { \
                G_[m][0] = *(const LAS pg8::bf16x8*)(sl_ + (m * 2 + 0) * 1024 + lane * 16); G_[m][1] = *(const LAS pg8::bf16x8*)(sl_ + (m * 2 + 1) * 1024 + lane * 16); \
                P_[m] = *(const LAS f32x4*)(sl_ + 10240 + (16 * m + 4 * fq) * 4); } \
                H_[0] = *(const LAS pg8::bf16x8*)(sl_ + 8192 + lane * 16); H_[1] = *(const LAS pg8::bf16x8*)(sl_ + 9216 + lane * 16); } while (0)
#define P3B_STEP(G_, H_, P_, n_) do { pg8::bf16x8 sb_[2]; _Pragma("unroll") for (int ks = 0; ks < 2; ++ks) { sb_[ks] = PACK8(acc[2 * ks], acc[2 * ks + 1]); __builtin_nontemporal_store(__builtin_bit_cast(v4u, sb_[ks]), SF + (((size_t)(ch0 + (n_)) * 4 + vt) * 2 + ks) * 64 + lane); } \
                _Pragma("unroll") for (int m = 0; m < 4; ++m) { const v4u hw_ = __builtin_bit_cast(v4u, H_[m >> 1]); const unsigned h0w_ = (m & 1) ? hw_.z : hw_.x, h1w_ = (m & 1) ? hw_.w : hw_.y; \
                    f32x4 nw_ = P_[m] * acc[m] + (f32x4){bf_lo(h0w_), bf_hi(h0w_), bf_lo(h1w_), bf_hi(h1w_)}; \
                    nw_ = MFMA16(G_[m][0], sb_[0], nw_); nw_ = MFMA16(G_[m][1], sb_[1], nw_); acc[m] = nw_; } } while (0)
            if (ldr) {
#pragma unroll 1
                for (int s0 = 0; s0 < RING_D; ++s0) P3B_ISSUE(s0);
            }
            for (int n = 0; n < NCH; n += 2) {
                if (wave == 1) asm volatile("s_waitcnt vmcnt(44)" ::: "memory"); else if (wave == 2) asm volatile("s_waitcnt vmcnt(33)" ::: "memory"); else if (ldr) asm volatile("s_waitcnt vmcnt(22)" ::: "memory");
                __builtin_amdgcn_s_barrier(); asm volatile("" ::: "memory");
                if (act) {
                    pg8::bf16x8 gA[4][2], hA[2], gB[4][2], hB[2]; f32x4 pA[4], pB[4];
                    P3B_READ(gA, hA, pA, n); P3B_READ(gB, hB, pB, n + 1);
                    asm volatile("s_waitcnt lgkmcnt(0)" ::: "memory"); __builtin_amdgcn_sched_barrier(0);
                    P3B_STEP(gA, hA, pA, n);
                    P3B_STEP(gB, hB, pB, n + 1);
                }
                if (ldr) { P3B_ISSUE(n + RING_D); P3B_ISSUE(n + RING_D + 1); }
            }
            if (ldr) asm volatile("s_waitcnt vmcnt(0)" ::: "memory");
            __builtin_amdgcn_s_barrier(); asm volatile("" ::: "memory");
#undef P3B_READ
#undef P3B_STEP
#undef P3B_ISSUE
        }
        {
            LAS float* scr = (LAS float*)(lds + wave * 16384);
            const int p1i = (G == 256) ? MOE_P1_ITEMS : 0; const int NSPLIT = p1i + (int)((MOE_NIT - p1i) * 0.74f);
            const bool scanwg = (int)blockIdx.x < NSCAN && G > NSCAN;
            const int nw = scanwg ? NSCAN * NWAVES : (G > NSCAN ? (G - NSCAN) * NWAVES : G * NWAVES);
            const int widx = scanwg ? NSPLIT + (int)blockIdx.x * NWAVES + wave : p1i + (G > NSCAN ? ((int)blockIdx.x - NSCAN) * NWAVES + wave : gw);
            const int ilim = scanwg ? MOE_NIT : (G > NSCAN ? NSPLIT : MOE_NIT);
            moe_convert_items(args.in[22], args.in[20], (unsigned char*)WDN_T, (unsigned char*)WGU_T, scr, widx, ilim, nw, lane);
        }
        if (BOTH(3)) GRID_BAR();
    }

    if (IN(4)) {
        const int fr = lane & 15, fq = lane >> 4;
        const v4u* QF = (const v4u*)(ws + WS_QF); const u32x2* O1F = (const u32x2*)(ws + WS_O1); const v4u* SF = (const v4u*)(ws + WS_SF);
        const float* gnw = args.in[13]; const float* gnb = args.in[14];
        for (int chh = gw; chh < NCHH; chh += NGW) {
            const int n = chh & (NCH - 1), bh = chh >> 8, b = bh >> 3, h = bh & 7;
            const size_t tok0 = (size_t)b * SEQ + (size_t)n * CHK;
            pg8::bf16x8 Sf[4][2], Qf[2][2];
#pragma unroll
            for (int vt = 0; vt < 4; ++vt)
#pragma unroll
                for (int ks = 0; ks < 2; ++ks) Sf[vt][ks] = __builtin_bit_cast(pg8::bf16x8, __builtin_nontemporal_load(SF + (((size_t)chh * 4 + vt) * 2 + ks) * 64 + lane));
#pragma unroll
            for (int tt = 0; tt < 2; ++tt)
#pragma unroll
                for (int ks = 0; ks < 2; ++ks) Qf[tt][ks] = __builtin_bit_cast(pg8::bf16x8, __builtin_nontemporal_load(QF + (((size_t)chh * 2 + tt) * 2 + ks) * 64 + lane));
#pragma unroll
            for (int tt = 0; tt < 2; ++tt) { const size_t tok = tok0 + 16 * tt + fr;
                f32x4 o[4]; float s = 0.f;
#pragma unroll
                for (int vt = 0; vt < 4; ++vt) { const u32x2 w = __builtin_nontemporal_load(O1F + (((size_t)chh * 4 + vt) * 2 + tt) * 64 + lane); o[vt] = (f32x4){bf_lo(w.x), bf_hi(w.x), bf_lo(w.y), bf_hi(w.y)};
                    o[vt] = MFMA16(Sf[vt][0], Qf[tt][0], o[vt]); o[vt] = MFMA16(Sf[vt][1], Qf[tt][1], o[vt]); s += (o[vt][0] + o[vt][1]) + (o[vt][2] + o[vt][3]); }
                s += __shfl_xor(s, 16); s += __shfl_xor(s, 32);
                const float mean = s * (1.0f / 64.0f); float q = 0.f;
#pragma unroll
                for (int vt = 0; vt < 4; ++vt) { o[vt] = o[vt] - mean; q += (o[vt][0] * o[vt][0] + o[vt][1] * o[vt][1]) + (o[vt][2] * o[vt][2] + o[vt][3] * o[vt][3]); }
                q += __shfl_xor(q, 16); q += __shfl_xor(q, 32);
                const float rs = 1.0f / sqrtf(q * (1.0f / 64.0f) + GN_EPS); const float bd = BDOT[tok * NH + h];
#pragma unroll
                for (int vt = 0; vt < 4; ++vt) { const int c = h * 64 + 16 * vt + 4 * fq; const f32x4 gw4 = *(const f32x4*)(gnw + c), gb4 = *(const f32x4*)(gnb + c), vv = ({ const u32x2 vw_ = *(const u32x2*)((const bf16*)SV + tok * RW + c); (f32x4){bf_lo(vw_.x), bf_hi(vw_.x), bf_lo(vw_.y), bf_hi(vw_.y)}; });
                    const u32x2 gg = *(const u32x2*)(SG + tok * RW + c); const f32x4 g4 = (f32x4){bf_lo(gg.x), bf_hi(gg.x), bf_lo(gg.y), bf_hi(gg.y)};
                    const f32x4 yv = (o[vt] * rs * gw4 + gb4 + bd * vv) * g4;
                    u32x2 w; w.x = cvtpk_s(yv[0], yv[1]); w.y = cvtpk_s(yv[2], yv[3]); *(u32x2*)(Y + tok * D + 512 + c) = w; } }
        }
#undef PACK8
#undef MFMA16
        if (BOTH(4)) GRID_BAR();
    }

    if (IN(5)) {
        pg8::Gemm g{Y, WOUT_T, M, D, D, 0, 0, nullptr}; pg8::StaticOrder S; S.init(M, D, G, (int)blockIdx.x);
        pg8::EpiResXn E{(const pg8::bf16_t*)XN, (const float*)(ws + WS_RMS), (pg8::bf16_t*)X1, D};
        pg8::gemm_phase<pg8::EpiResXn, pg8::StaticOrder, PG8_ALIGN, PG8_SP2>(lds, g, S, E);
        if (BOTH(5)) GRID_BAR();
    }

    if (IN(6)) {
        const float* gf = args.in[17]; const float* wr = args.in[18]; const float* br = args.in[19]; int* LISTG = (int*)(ws + WS_LIST);
        constexpr int WRS2 = 1032;
        LAS unsigned short* wH = (LAS unsigned short*)lds;
        LAS unsigned short* wL = wH + 32 * WRS2;
#pragma unroll
        for (int q = 0; q < 8; ++q) { const int i4 = tid + q * NWAVES * 64, kp = i4 >> 3, e0 = (i4 & 7) * 4;
            const f32x4 wa = *(const f32x4*)(wr + (2 * kp) * 32 + e0), wb = *(const f32x4*)(wr + (2 * kp + 1) * 32 + e0); const float ga = gf[2 * kp], gb = gf[2 * kp + 1];
#pragma unroll
            for (int j = 0; j < 4; ++j) { const float va = wa[j] * ga, vb = wb[j] * gb; const unsigned ha = f2bf(va), hb = f2bf(vb);
                const unsigned la = f2bf(va - __uint_as_float(ha << 16)), lb = f2bf(vb - __uint_as_float(hb << 16));
                ((LAS unsigned*)(wH + (e0 + j) * WRS2))[kp] = ha | (hb << 16); ((LAS unsigned*)(wL + (e0 + j) * WRS2))[kp] = la | (lb << 16); } }
        __syncthreads();
        const int fr = lane & 15, fq = lane >> 4;
        LAS unsigned* lcnt = (LAS unsigned*)(lds + 2 * 32 * WRS2 * 2);
        for (int it = 0; it < (M / 16 + NGW - 1) / NGW; ++it) {
            int tile = gw + it * NGW; const bool live = tile < M / 16; if (!live) tile = M / 16 - 1;
            if (tid < 64) lcnt[tid] = 0u;
            __syncthreads();
            const int t = tile * 16 + fr;
            const bf16* xrow = X1 + (size_t)t * D + 8 * fq;
            const LAS unsigned short* h0p = wH + fr * WRS2 + 8 * fq; const LAS unsigned short* h1p = wH + (16 + fr) * WRS2 + 8 * fq;
            const LAS unsigned short* l0p = wL + fr * WRS2 + 8 * fq; const LAS unsigned short* l1p = wL + (16 + fr) * WRS2 + 8 * fq;
            f32x4 acc0 = (f32x4){0.f, 0.f, 0.f, 0.f}, acc1 = acc0; float ss = 0.f;
#pragma unroll 4
            for (int sp = 0; sp < 32; ++sp) {
                const pg8::u32x4 xw = *(const pg8::u32x4*)(xrow + 32 * sp); const pg8::bf16x8 xb = __builtin_bit_cast(pg8::bf16x8, xw);
                const pg8::bf16x8 h0 = *(const LAS pg8::bf16x8*)(h0p + 32 * sp), h1 = *(const LAS pg8::bf16x8*)(h1p + 32 * sp), l0 = *(const LAS pg8::bf16x8*)(l0p + 32 * sp), l1 = *(const LAS pg8::bf16x8*)(l1p + 32 * sp);
                const f32x4 x0 = (f32x4){__uint_as_float(xw.x << 16), __uint_as_float(xw.x & 0xffff0000u), __uint_as_float(xw.y << 16), __uint_as_float(xw.y & 0xffff0000u)};
                const f32x4 x1 = (f32x4){__uint_as_float(xw.z << 16), __uint_as_float(xw.z & 0xffff0000u), __uint_as_float(xw.w << 16), __uint_as_float(xw.w & 0xffff0000u)};
                ss += ((x0[0] * x0[0] + x0[1] * x0[1]) + (x0[2] * x0[2] + x0[3] * x0[3])) + ((x1[0] * x1[0] + x1[1] * x1[1]) + (x1[2] * x1[2] + x1[3] * x1[3]));
                acc0 = __builtin_amdgcn_mfma_f32_16x16x32_bf16(l0, xb, acc0, 0, 0, 0); acc1 = __builtin_amdgcn_mfma_f32_16x16x32_bf16(l1, xb, acc1, 0, 0, 0);
                acc0 = __builtin_amdgcn_mfma_f32_16x16x32_bf16(h0, xb, acc0, 0, 0, 0); acc1 = __builtin_amdgcn_mfma_f32_16x16x32_bf16(h1, xb, acc1, 0, 0, 0);
            }
            ss += __shfl_xor(ss, 16); ss += __shfl_xor(ss, 32);
            const float rstd = 1.0f / sqrtf(ss * (1.f / D) + NORM_EPS);
            float lg[8]; const f32x4 b0 = *(const f32x4*)(br + 4 * fq), b1 = *(const f32x4*)(br + 16 + 4 * fq);
#pragma unroll
            for (int j = 0; j < 4; ++j) { lg[j] = acc0[j] * rstd + b0[j]; lg[4 + j] = acc1[j] * rstd + b1[j]; }
            int te[4]; float tv[4];
#pragma unroll
            for (int r = 0; r < 4; ++r) { float bv = lg[0]; int bi = 4 * fq;
#pragma unroll
                for (int j = 1; j < 8; ++j) { const int ei = (j < 4) ? 4 * fq + j : 16 + 4 * fq + (j - 4); if (lg[j] > bv) { bv = lg[j]; bi = ei; } }
#pragma unroll
                for (int o = 16; o <= 32; o <<= 1) { const float ov = __shfl_xor(bv, o); const int oi = __shfl_xor(bi, o); if (ov > bv || (ov == bv && oi < bi)) { bv = ov; bi = oi; } }
                te[r] = bi; tv[r] = bv;
#pragma unroll
                for (int j = 0; j < 8; ++j) { const int ei = (j < 4) ? 4 * fq + j : 16 + 4 * fq + (j - 4); if (ei == bi) lg[j] = -3.0e38f; } }
            const float e1 = __expf(tv[1] - tv[0]), e2 = __expf(tv[2] - tv[0]), e3 = __expf(tv[3] - tv[0]); const float inv = 1.0f / (1.0f + e1 + e2 + e3);
            int rk[4] = {0, 0, 0, 0};
            if (fq == 0 && live) {
#pragma unroll
                for (int r = 0; r < 4; ++r) rk[r] = (int)__hip_atomic_fetch_add(lcnt + te[r], 1u, __ATOMIC_RELAXED, __HIP_MEMORY_SCOPE_WORKGROUP); }
            __syncthreads();
            if (tid < 32) { const unsigned c = lcnt[tid]; lcnt[32 + tid] = c ? __hip_atomic_fetch_add(ctl + CW_CNT + tid, c, __ATOMIC_RELAXED, __HIP_MEMORY_SCOPE_AGENT) : 0u; }
            __syncthreads();
            if (fq == 0 && live) {
#pragma unroll
                for (int r = 0; r < 4; ++r) rk[r] += (int)lcnt[32 + te[r]];
                *(int4*)(TOKE + (size_t)t * 4) = make_int4(te[0], te[1], te[2], te[3]); *(f32x4*)(TOKG + (size_t)t * 4) = (f32x4){inv, e1 * inv, e2 * inv, e3 * inv}; *(int4*)(TOKR + (size_t)t * 4) = make_int4(rk[0], rk[1], rk[2], rk[3]);
#pragma unroll
                for (int r = 0; r < 4; ++r) LISTG[(size_t)te[r] * M + rk[r]] = t; }
            if (live)
#pragma unroll 4
            for (int r = 0; r < 16; ++r) { const float rs = __shfl(rstd, r); const size_t row = (size_t)(tile * 16 + r) * D;
                GAS u32x2* o8 = (GAS u32x2*)((unsigned char*)XN + row) + lane;
#pragma unroll
                for (int j = 0; j < 2; ++j) { const pg8::u32x4 xw = ((const GAS pg8::u32x4*)(X1 + row))[lane + 64 * j]; const f32x4 g0 = ((const GAS f32x4*)gf)[2 * (lane + 64 * j)], g1 = ((const GAS f32x4*)gf)[2 * (lane + 64 * j) + 1];
                    u32x2 w;
                    w.x = pk4_fp8(__uint_as_float(xw.x << 16) * rs * g0.x, __uint_as_float(xw.x & 0xffff0000u) * rs * g0.y, __uint_as_float(xw.y << 16) * rs * g0.z, __uint_as_float(xw.y & 0xffff0000u) * rs * g0.w, F8_H_SCALE);
                    w.y = pk4_fp8(__uint_as_float(xw.z << 16) * rs * g1.x, __uint_as_float(xw.z & 0xffff0000u) * rs * g1.y, __uint_as_float(xw.w << 16) * rs * g1.z, __uint_as_float(xw.w & 0xffff0000u) * rs * g1.w, F8_H_SCALE);
                    o8[64 * j] = w; } }
        }
        __syncthreads();
        if (BOTH(6)) GRID_BAR();
    }

#define MOE_BUILD_TABLES() \
        LAS int* tabL = (LAS int*)(lds + MOE_TAB_OFF); LAS bf16* biasL = (LAS bf16*)(lds + MOE_BIAS_OFF); LAS int* metaL = (LAS int*)(lds + MOE_TOK_OFF + MOE_MAXU * 512);     \
        if (wave == 0) { unsigned cntv = 0u; if (lane < 32) cntv = __hip_atomic_load(ctl + CW_CNT + lane, __ATOMIC_RELAXED, __HIP_MEMORY_SCOPE_AGENT); \
            const int ntile = (int)((cntv + 255u) >> 8); int incl = ntile; \
            _Pragma("unroll") for (int o = 1; o < 32; o <<= 1) { const int nn = __shfl_up(incl, o); if (lane >= o) incl += nn; } \
            const int tst = incl - ntile; \
            if (lane < 32) { metaL[lane] = tst; metaL[32 + lane] = (int)cntv; for (int i = 0; i < ntile; ++i) tabL[tst + i] = lane; } \
            if (lane == 31) metaL[64] = incl; } \
        LDS_WAIT(); __syncthreads(); \
        const int MT = metaL[64];
    if (IN(7)) {
        MOE_BUILD_TABLES();
        LAS unsigned short* tokL = (LAS unsigned short*)(lds + MOE_TOK_OFF);
        { const int pnw = ((int)blockIdx.x >> 3) % 8;
          const float* bgu = args.in[21];
          for (int i = tid; i < 32 * 256; i += NWAVES * 64) { const int e = i >> 8, j = i & 255; biasL[i] = (bf16)f2bf(bgu[e * 2048 + (j >> 7) * 1024 + pnw * 128 + (j & 127)]); }
          const int* LISTG = (const int*)(ws + WS_LIST); const int per_round = G / 8, mpx = per_round / 8, xcd = (int)blockIdx.x & 7, loc = (int)blockIdx.x >> 3;
          int tokv[MOE_MAXU * 256 / (NWAVES * 64)];
#pragma unroll
          for (int q = 0; q < MOE_MAXU * 256 / (NWAVES * 64); ++q) { const int idx = tid + q * NWAVES * 64, u = idx >> 8, r = idx & 255; const int mt = u * per_round + xcd * mpx + loc / 8; tokv[q] = 0;
              if (mt < MT) { const int e = tabL[mt]; const int lr = (mt - metaL[e]) * 256 + r; if (lr < metaL[32 + e]) tokv[q] = LISTG[(size_t)e * M + lr]; } }
#pragma unroll
          for (int q = 0; q < MOE_MAXU * 256 / (NWAVES * 64); ++q) tokL[tid + q * NWAVES * 64] = (unsigned short)tokv[q];
          LDS_WAIT(); __syncthreads(); }
        pg8::Gemm g{XN, WGU_T, SLOT_ROWS, 2048, D / 2, F8_W_BYTE, F8_H_BYTE, (const LAS unsigned short*)tokL};         pg8::MoeOrder S{(const LAS int*)tabL, MT, 8, G, (int)blockIdx.x};
        pg8::EpiSwiGLU E{ACT, FF, (const LAS unsigned short*)biasL};
        pg8::gemm_phase<pg8::EpiSwiGLU, pg8::MoeOrder, PG8_ALIGN, PG8_SP2, true, true>(lds, g, S, E);
        if (BOTH(7)) GRID_BAR();
    }

    if (IN(8)) {
        MOE_BUILD_TABLES();
        { const int pnw = ((int)blockIdx.x >> 3) % 4;
          const float* bdn = args.in[23];
          for (int i = tid; i < 32 * 256; i += NWAVES * 64) { const int e = i >> 8, j = i & 255; biasL[i] = (bf16)f2bf(bdn[e * 1024 + pnw * 256 + j]); }
          LDS_WAIT(); __syncthreads(); }
        pg8::Gemm g{ACT, WDN_T, SLOT_ROWS, 1024, FF / 2, F8_W_BYTE, F8_ACT_BYTE}; pg8::MoeOrder S{(const LAS int*)tabL, MT, 4, G, (int)blockIdx.x};
        pg8::EpiBiasLdsBf16 E{YSLOT, D, (const LAS unsigned short*)biasL};
        pg8::gemm_phase<pg8::EpiBiasLdsBf16, pg8::MoeOrder, PG8_ALIGN, PG8_SP2, true>(lds, g, S, E);
        if (BOTH(8)) GRID_BAR();
    }

    if (IN(9)) {
        const float* gfin = args.in[24];
        unsigned cntv = 0u; if (lane < 32) cntv = __hip_atomic_load(ctl + CW_CNT + lane, __ATOMIC_RELAXED, __HIP_MEMORY_SCOPE_AGENT);
        const int padded = (int)((cntv + 255u) & ~255u); int incl = padded;
#pragma unroll
        for (int o = 1; o < 32; o <<= 1) { const int nn = __shfl_up(incl, o); if (lane >= o) incl += nn; }
        const int pstart = incl - padded;
        for (int t = gw; t < M; t += NGW) {
            const GAS u32x2* xr = (const GAS u32x2*)(X1 + (size_t)t * D) + lane; f32x4 v[4];
#pragma unroll
            for (int j = 0; j < 4; ++j) { const u32x2 xw = xr[64 * j]; v[j] = (f32x4){__uint_as_float(xw.x << 16), __uint_as_float(xw.x & 0xffff0000u), __uint_as_float(xw.y << 16), __uint_as_float(xw.y & 0xffff0000u)}; }
            const int4 e4 = *(const int4*)(TOKE + (size_t)t * 4), r4 = *(const int4*)(TOKR + (size_t)t * 4); const f32x4 g4 = *(const f32x4*)(TOKG + (size_t)t * 4);
            const int dd[4] = {__shfl(pstart, e4.x) + r4.x, __shfl(pstart, e4.y) + r4.y, __shfl(pstart, e4.z) + r4.z, __shfl(pstart, e4.w) + r4.w}; const float gg[4] = {g4.x, g4.y, g4.z, g4.w};
#pragma unroll
            for (int q = 0; q < 4; ++q) { const GAS unsigned* yr = (const GAS unsigned*)((const unsigned char*)YSLOT + (size_t)dd[q] * D) + lane; const float gq8 = gg[q] * 0.125f;
#pragma unroll
                for (int j = 0; j < 4; ++j) { const unsigned w = yr[64 * j]; const f32x2_t lo = __builtin_amdgcn_cvt_pk_f32_fp8((int)w, false), hi = __builtin_amdgcn_cvt_pk_f32_fp8((int)w, true);
                    v[j].x += gq8 * lo.x; v[j].y += gq8 * lo.y; v[j].z += gq8 * hi.x; v[j].w += gq8 * hi.y; } }
            float s = 0.f;
#pragma unroll
            for (int j = 0; j < 4; ++j) s += (v[j].x * v[j].x + v[j].y * v[j].y) + (v[j].z * v[j].z + v[j].w * v[j].w);
            const float rstd = 1.0f / sqrtf(wave_sum(s) * (1.f / D) + NORM_EPS);
            GAS f32x4* orow = (GAS f32x4*)(args.out + (size_t)t * D) + lane;
#pragma unroll
            for (int j = 0; j < 4; ++j) { const f32x4 gq = ((const GAS f32x4*)gfin)[lane + 64 * j]; __builtin_nontemporal_store(v[j] * rstd * gq, orow + 64 * j); }
        }
    }
#undef IN
#undef BOTH
#undef GRID_BAR
}

extern "C" void kernel_launch(void* const* d_in, const int* in_sizes, int n_in, void* d_out, int out_size, void* d_ws, size_t ws_size, hipStream_t stream) {
    static int grid = 0;
    if (grid == 0) {
        if (n_in != 25 || in_sizes[0] != M * D || out_size != M * D || ws_size < WS_END) { fprintf(stderr, "kernel_launch: unexpected shapes / workspace (%d inputs, ws %zu)\n", n_in, ws_size); grid = -1; return; }
        int dev = 0, cus = 0, per_cu = 0;
        if (hipGetDevice(&dev) != hipSuccess || hipDeviceGetAttribute(&cus, hipDeviceAttributeMultiprocessorCount, dev) != hipSuccess) { grid = -1; return; }
        if (hipFuncSetAttribute((const void*)mk_fwd, hipFuncAttributeMaxDynamicSharedMemorySize, LDS_BYTES) != hipSuccess) { grid = -1; return; }
        if (hipOccupancyMaxActiveBlocksPerMultiprocessor(&per_cu, (const void*)mk_fwd, NWAVES * 64, LDS_BYTES) != hipSuccess || per_cu < 1) { fprintf(stderr, "kernel_launch: occupancy query says %d blocks per CU\n", per_cu); grid = -1; (void)hipGetLastError(); return; }
        (void)hipGetLastError();
        grid = cus;
    }
    if (grid < 0) return;
    if (hipMemsetAsync((char*)d_ws + WS_CTL, 0, CTL_ZERO_BYTES, stream) != hipSuccess) return;
    Args a{};
    for (int i = 0; i < 25; ++i) a.in[i] = (const float*)d_in[i];
    a.out = (float*)d_out; a.ws = (unsigned char*)d_ws;
    if (N_LAUNCHES == 1) { a.ph_lo = 0; a.ph_hi = NPHASE; a.li = 0; hipLaunchKernelGGL(mk_fwd, dim3(grid), dim3(NWAVES * 64), LDS_BYTES, stream, a); }
    else for (int li = 0; li < NPHASE; ++li) { a.ph_lo = li; a.ph_hi = li + 1; a.li = li; hipLaunchKernelGGL(mk_fwd, dim3(grid), dim3(NWAVES * 64), LDS_BYTES, stream, a); }
}
```

```cpp
#include <hip/hip_runtime.h>
#include <cstdio>
#include <cstdint>
namespace pg8 {
#define PG8_LAS __attribute__((address_space(3)))
typedef unsigned short bf16_t;
typedef short bf16x8 __attribute__((ext_vector_type(8)));
typedef float f32x4 __attribute__((ext_vector_type(4)));
typedef unsigned u32x4 __attribute__((ext_vector_type(4)));
constexpr int BM = 256, BK = 64, HALF = 128, HTB = HALF * BK * 2  , STAGE_BYTES = 8 * HTB, NXCD = 8, WGM = 8;

__host__ __device__ __forceinline__ int lds_byte(int r, int c) { const int st = (r >> 4) * 2 + (c >> 5), rr = r & 15, cc = c & 31, ob = rr * 64 + cc * 2; return st * 1024 + (ob ^ (((ob >> 9) & 1) << 5)); }
__host__ __device__ __forceinline__ void stage_rc(int b, int& R, int& C) { const int st = b / 1024, sb = b % 1024, swz = sb ^ (((sb >> 9) & 1) << 5); R = (st >> 1) * 16 + swz / 64; C = (st & 1) * 32 + (swz % 64) / 2; }
__host__ __device__ __forceinline__ int perm32(int rho) { const int n = rho >> 4, i = rho & 15; return 8 * (i >> 2) + 4 * n + (i & 3); }

struct Unit { int pm, pn, pb, e; };
struct Gemm { const bf16_t* A; const bf16_t* Bt; int M, N, K; int scl_w, scl_a; const PG8_LAS unsigned short* tokL; };

struct StaticOrder {
    int nM, nN, nwg, G, c;
    __host__ __device__ void init(int M, int N, int G_, int c_) { nM = M / BM; nN = N / BM; nwg = nM * nN; G = G_; c = c_; }
    __host__ __device__ bool next(int i, Unit& u) const {
        const long L = (long)i * G + c; if (L >= nwg) return false;
        int wgid = (int)L; { const int q = nwg / NXCD, r = nwg % NXCD, xcd = wgid % NXCD, off = wgid / NXCD; wgid = (xcd < r ? xcd * (q + 1) : r * (q + 1) + (xcd - r) * q) + off; }
        const int nig = WGM * nN, gid = wgid / nig, fm = gid * WGM, gsz = (nM - fm) < WGM ? (nM - fm) : WGM;
        u.pm = fm + ((wgid % nig) % gsz); u.pn = (wgid % nig) / gsz; u.pb = u.pn; u.e = 0; return true;
    }
    __device__ __forceinline__ void a_ready(const Unit&) const {}
    __device__ __forceinline__ void done(const Unit&) const {}
};

__device__ __forceinline__ unsigned cvt_pk_bf16(float lo, float hi) { unsigned r; asm volatile("v_cvt_pk_bf16_f32 %0, %1, %2" : "=v"(r) : "v"(lo), "v"(hi)); return r; }
typedef float f32x2 __attribute__((ext_vector_type(2)));
__device__ __forceinline__ f32x2 gelu_pk(f32x2 v) {
    const f32x2 av = __builtin_elementwise_abs(v), d = av * 0.2316418882f + 1.0f;
    f32x2 t; t.x = __builtin_amdgcn_rcpf(d.x); t.y = __builtin_amdgcn_rcpf(d.y);
    f32x2 q = t * 0.5307027145f + (-0.7265760135f); q = q * t + 0.7107068705f; q = q * t + (-0.142248368f); q = q * t + 0.127414796f; q = q * t;
    const f32x2 s = (v * v) * (-0.72134752044f);
    f32x2 e; e.x = __builtin_amdgcn_exp2f(s.x); e.y = __builtin_amdgcn_exp2f(s.y);
    const f32x2 m = v * (q * e), r = v - m;
    f32x2 o; o.x = v.x < 0.f ? m.x : r.x; o.y = v.y < 0.f ? m.y : r.y; return o;
}

template <int ACT  > struct EpiBf16 {
    static constexpr bool PERM = true, AFTER_DRAIN = false; static_assert(ACT == 0 || ACT == 1, "EpiBf16: ACT is 0 (none) or 1 (gelu_pk)");
    bf16_t* O; int ldc; const float* bias; int split_cols; size_t split_stride; float scale0;
    __device__ __forceinline__ void operator()(const f32x4 (&acc)[2][2][4][2], const Unit& u, int wr, int wc, int fr, int fq) const {
        const int row0 = u.pm * BM + wr * 64 + fr; int colt = u.pn * BM; bf16_t* base = O;
        float sc = 1.f; if (split_cols) { const int t = colt / split_cols; base += (size_t)t * split_stride; colt -= t * split_cols; if (t == 0) sc = scale0; }
        const int col0 = colt + wc * 32 + 8 * fq, bcol0 = u.pn * BM + wc * 32 + 8 * fq;
        f32x4 bv[2][2];
#pragma unroll
        for (int bj = 0; bj < 2; ++bj)
#pragma unroll
            for (int n = 0; n < 2; ++n) bv[bj][n] = bias ? *(const f32x4*)(bias + bcol0 + bj * HALF + 4 * n) : (f32x4){0.f, 0.f, 0.f, 0.f};
#pragma unroll
        for (int ai = 0; ai < 2; ++ai)
#pragma unroll
            for (int m = 0; m < 4; ++m) { bf16_t* rowp = base + (size_t)(row0 + ai * HALF + m * 16) * ldc + col0;
#pragma unroll
                for (int bj = 0; bj < 2; ++bj) { f32x4 v0 = acc[ai][bj][m][0] + bv[bj][0], v1 = acc[ai][bj][m][1] + bv[bj][1];
                    if (ACT == 1) { f32x2 a = gelu_pk((f32x2){v0[0], v0[1]}), b = gelu_pk((f32x2){v0[2], v0[3]}), c = gelu_pk((f32x2){v1[0], v1[1]}), d = gelu_pk((f32x2){v1[2], v1[3]});
                        v0 = (f32x4){a.x, a.y, b.x, b.y}; v1 = (f32x4){c.x, c.y, d.x, d.y}; }
                    v0 = v0 * sc; v1 = v1 * sc; u32x4 w; w.x = cvt_pk_bf16(v0[0], v0[1]); w.y = cvt_pk_bf16(v0[2], v0[3]); w.z = cvt_pk_bf16(v1[0], v1[1]); w.w = cvt_pk_bf16(v1[2], v1[3]);
                    *(u32x4*)(rowp + bj * HALF) = w; } }
    }
};

typedef int v8i_t __attribute__((ext_vector_type(8))); typedef int v4i_t __attribute__((ext_vector_type(4)));
__device__ __forceinline__ v8i_t cat8(bf16x8 lo, bf16x8 hi) { return __builtin_shufflevector(__builtin_bit_cast(v4i_t, lo), __builtin_bit_cast(v4i_t, hi), 0, 1, 2, 3, 4, 5, 6, 7); }
template <class Epi, class Sched, bool ALIGN_EPI = false, bool SP2 = false, bool FP8 = false, bool GATHER = false>
__device__ __forceinline__ void gemm_phase(PG8_LAS unsigned char* lds, const Gemm g, const Sched& S, const Epi& E) {
    const int tid = threadIdx.x, wid = __builtin_amdgcn_readfirstlane(tid >> 6), lane = tid & 63, wr = wid >> 2, wc = wid & 3, fr = lane & 15, fq = lane >> 4;
    const int K = g.K, nt = K / BK;
    unsigned voffA[2], voffB[2];
#pragma unroll
    for (int i = 0; i < 2; ++i) { int R, C; stage_rc(tid * 16 + i * 8192, R, C); const int Rb = Epi::PERM ? ((R & ~31) + perm32(R & 31)) : R;
        voffA[i] = (unsigned)(R * K + C) * 2u; voffB[i] = (unsigned)(Rb * K + C) * 2u; }
    unsigned voffAc[2][2] = {{0u, 0u}, {0u, 0u}}, voffAn[2][2] = {{0u, 0u}, {0u, 0u}}; int gRA[2] = {0, 0}; unsigned gCb[2] = {0u, 0u};
    if constexpr (GATHER) {
#pragma unroll
        for (int i = 0; i < 2; ++i) { int R, C; stage_rc(tid * 16 + i * 8192, R, C); gRA[i] = R; gCb[i] = (unsigned)C * 2u; } }
#define PG8_GVOFF(dst, uidx) do { _Pragma("unroll") for (int h_ = 0; h_ < 2; ++h_) _Pragma("unroll") for (int i_ = 0; i_ < 2; ++i_) dst[h_][i_] = (unsigned)g.tokL[(uidx) * 256 + 128 * h_ + gRA[i_]] * (unsigned)(K * 2) + gCb[i_]; } while (0)
    const size_t kstep = (size_t)(BK * 2);
    const size_t hstep = (size_t)HALF * K * 2;
    const size_t tstep = 2 * hstep;
    const unsigned ldsw = (unsigned)wid * 1024u;
    const int aoff = lds_byte(wr * 64 + fr, fq * 8), boff = lds_byte(wc * 32 + fr, fq * 8);
#define PG8_SA(b, h) (((b) * 2 + (h)) * HTB)
#define PG8_SB(b, h) ((4 + (b) * 2 + (h)) * HTB)
#define PG8_STAGE(bufoff, gbase, voff) do { _Pragma("unroll") for (int _i = 0; _i < 2; ++_i) \
        __builtin_amdgcn_global_load_lds((const unsigned*)((const char*)(gbase) + (voff)[_i]), (PG8_LAS unsigned*)(lds + (bufoff) + ldsw + _i * 8192), 16, 0, 0); } while (0)
#define PG8_STAGE_A(bufoff, gbase, half, nx) do { if constexpr (GATHER) { const unsigned v0_ = (nx) ? voffAn[half][0] : voffAc[half][0], v1_ = (nx) ? voffAn[half][1] : voffAc[half][1]; \
        __builtin_amdgcn_global_load_lds((const unsigned*)((const char*)(gbase) + v0_), (PG8_LAS unsigned*)(lds + (bufoff) + ldsw), 16, 0, 0); \
        __builtin_amdgcn_global_load_lds((const unsigned*)((const char*)(gbase) + v1_), (PG8_LAS unsigned*)(lds + (bufoff) + ldsw + 8192), 16, 0, 0); } \
        else { PG8_STAGE(bufoff, (gbase) + (half) * hstep, voffA); } } while (0)
#define PG8_LDA(dst, b, h) do { if constexpr (FP8) { _Pragma("unroll") for (int m = 0; m < 4; ++m) dst##8[m] = cat8(*(const PG8_LAS bf16x8*)(lds + PG8_SA(b, h) + aoff + m * 2048), *(const PG8_LAS bf16x8*)(lds + PG8_SA(b, h) + aoff + m * 2048 + 1024)); } \
        else { _Pragma("unroll") for (int m = 0; m < 4; ++m) _Pragma("unroll") for (int k = 0; k < 2; ++k) dst[m][k] = *(const PG8_LAS bf16x8*)(lds + PG8_SA(b, h) + aoff + m * 2048 + k * 1024); } } while (0)
#define PG8_LDB(dst, b, h) do { if constexpr (FP8) { _Pragma("unroll") for (int n = 0; n < 2; ++n) dst##8[n] = cat8(*(const PG8_LAS bf16x8*)(lds + PG8_SB(b, h) + boff + n * 2048), *(const PG8_LAS bf16x8*)(lds + PG8_SB(b, h) + boff + n * 2048 + 1024)); } \
        else { _Pragma("unroll") for (int n = 0; n < 2; ++n) _Pragma("unroll") for (int k = 0; k < 2; ++k) dst[n][k] = *(const PG8_LAS bf16x8*)(lds + PG8_SB(b, h) + boff + n * 2048 + k * 1024); } } while (0)
#define PG8_MMA(ai, bj, At, Bt) do { __builtin_amdgcn_s_setprio(1); if constexpr (FP8) { _Pragma("unroll") for (int m = 0; m < 4; ++m) _Pragma("unroll") for (int n = 0; n < 2; ++n) \
        acc[ai][bj][m][n] = __builtin_amdgcn_mfma_scale_f32_16x16x128_f8f6f4(Bt##8[n], At##8[m], acc[ai][bj][m][n], 0, 0, 0, g.scl_w, 0, g.scl_a); \
        _Pragma("unroll") for (int m = 0; m < 4; ++m) _Pragma("unroll") for (int n = 0; n < 2; ++n) asm volatile("" : "+v"(acc[ai][bj][m][n]));   } else { \
        _Pragma("unroll") for (int m = 0; m < 4; ++m) _Pragma("unroll") for (int n = 0; n < 2; ++n) _Pragma("unroll") for (int k = 0; k < 2; ++k) \
        acc[ai][bj][m][n] = __builtin_amdgcn_mfma_f32_16x16x32_bf16(Bt[n][k], At[m][k], acc[ai][bj][m][n], 0, 0, 0); } __builtin_amdgcn_s_setprio(0); } while (0)
#define PG8_WAIT_V(n) asm volatile("s_waitcnt vmcnt(" #n ")" ::: "memory")
#define PG8_WAIT_L(n) asm volatile("s_waitcnt lgkmcnt(" #n ")" ::: "memory")
#define PG8_BAR __builtin_amdgcn_s_barrier()
#define PG8_SCHED __builtin_amdgcn_sched_barrier(0)
    Unit cur, nxt; int ui = 0;
    if (!S.next(0, cur)) return;
    f32x4 acc[2][2][4][2];
#pragma unroll
    for (int a = 0; a < 2; ++a)
#pragma unroll
        for (int b = 0; b < 2; ++b)
#pragma unroll
            for (int m = 0; m < 4; ++m)
#pragma unroll
                for (int n = 0; n < 2; ++n) acc[a][b][m][n] = (f32x4){0.f, 0.f, 0.f, 0.f};
    bf16x8 At[4][2], B0[2][2], B1[2][2]; v8i_t At8[4], B08[2], B18[2];
    const char* cA = (const char*)g.A + (GATHER ? (size_t)0 : (size_t)cur.pm * tstep); const char* cB = (const char*)g.Bt + (size_t)cur.pb * tstep;
    if constexpr (GATHER) { PG8_GVOFF(voffAc, 0); }
    S.a_ready(cur);
    if constexpr (SP2) {
        PG8_STAGE(PG8_SB(0, 0), cB, voffB); PG8_STAGE(PG8_SB(0, 1), cB + hstep, voffB); PG8_STAGE_A(PG8_SA(0, 0), cA, 0, false); PG8_STAGE_A(PG8_SA(0, 1), cA, 1, false);
        if (wr == 1) PG8_BAR;
        PG8_WAIT_V(2); PG8_BAR;
        PG8_STAGE(PG8_SB(1, 0), cB + kstep, voffB); PG8_STAGE_A(PG8_SA(1, 0), cA + kstep, 0, false); PG8_STAGE(PG8_SB(1, 1), cB + hstep + kstep, voffB);
        PG8_WAIT_V(6); PG8_BAR;
    } else {
        PG8_STAGE(PG8_SB(0, 0), cB, voffB); PG8_STAGE_A(PG8_SA(0, 0), cA, 0, false); PG8_STAGE(PG8_SB(0, 1), cB + hstep, voffB); PG8_STAGE_A(PG8_SA(0, 1), cA, 1, false);
        if (wr == 1) PG8_BAR;
        PG8_WAIT_V(4); PG8_BAR;
        PG8_STAGE(PG8_SB(1, 0), cB + kstep, voffB); PG8_STAGE_A(PG8_SA(1, 0), cA + kstep, 0, false); PG8_STAGE(PG8_SB(1, 1), cB + hstep + kstep, voffB);
        PG8_WAIT_V(6); PG8_BAR;
    }
    for (;;) {
        const bool has_next = S.next(ui + 1, nxt);
        const char* nA = (has_next && !GATHER) ? (const char*)g.A + (size_t)nxt.pm * tstep : cA; const char* nB = has_next ? (const char*)g.Bt + (size_t)nxt.pb * tstep : cB;
        if constexpr (GATHER) { if (has_next) { PG8_GVOFF(voffAn, ui + 1); } else {
#pragma unroll
            for (int h_ = 0; h_ < 2; ++h_) { voffAn[h_][0] = voffAc[h_][0]; voffAn[h_][1] = voffAc[h_][1]; } } }
        for (int t = 0; t < nt; t += 2) {
            const bool last = (t == nt - 2);
            const char* a1 = cA + (size_t)(t + 1) * kstep;
            const char* a2 = last ? nA : cA + (size_t)(t + 2) * kstep; const char* b2 = last ? nB : cB + (size_t)(t + 2) * kstep;
            const char* a3 = a2 + kstep; const char* b3 = b2 + kstep;
            if (last && has_next) S.a_ready(nxt);
            if constexpr (SP2) {
            PG8_LDB(B0, 0, 0); PG8_LDB(B1, 0, 1); PG8_SCHED; PG8_LDA(At, 0, 0); PG8_STAGE_A(PG8_SA(1, 1), a1, 1, false);
            PG8_WAIT_V(8); PG8_WAIT_L(0); PG8_BAR; PG8_MMA(0, 0, At, B0); PG8_MMA(0, 1, At, B1); PG8_BAR; PG8_SCHED;
            PG8_LDA(At, 0, 1); PG8_STAGE(PG8_SB(0, 0), b2, voffB); PG8_STAGE(PG8_SB(0, 1), b2 + hstep, voffB); PG8_STAGE_A(PG8_SA(0, 0), a2, 0, last);
            PG8_WAIT_V(8); PG8_WAIT_L(0); PG8_BAR; PG8_MMA(1, 0, At, B0); PG8_MMA(1, 1, At, B1); PG8_BAR; PG8_SCHED;
            PG8_LDB(B0, 1, 0); PG8_LDB(B1, 1, 1); PG8_SCHED; PG8_LDA(At, 1, 0); PG8_STAGE_A(PG8_SA(0, 1), a2, 1, last);
            PG8_WAIT_V(8); PG8_WAIT_L(0); PG8_BAR; PG8_MMA(0, 0, At, B0); PG8_MMA(0, 1, At, B1); PG8_BAR; PG8_SCHED;
            PG8_LDA(At, 1, 1); PG8_STAGE(PG8_SB(1, 0), b3, voffB); PG8_STAGE(PG8_SB(1, 1), b3 + hstep, voffB); PG8_STAGE_A(PG8_SA(1, 0), a3, 0, last);
            PG8_WAIT_V(8); PG8_WAIT_L(0); PG8_BAR; PG8_MMA(1, 0, At, B0); PG8_MMA(1, 1, At, B1); PG8_BAR; PG8_SCHED;
            } else {
            PG8_LDB(B0, 0, 0); PG8_SCHED; PG8_LDA(At, 0, 0); PG8_STAGE_A(PG8_SA(1, 1), a1, 1, false);
            PG8_WAIT_L(8); PG8_BAR; PG8_WAIT_L(0); PG8_MMA(0, 0, At, B0); PG8_BAR; PG8_SCHED;
            PG8_LDB(B1, 0, 1); PG8_STAGE(PG8_SB(0, 0), b2, voffB);
            PG8_BAR; PG8_WAIT_L(0); PG8_MMA(0, 1, At, B1); PG8_BAR;
            PG8_LDA(At, 0, 1); PG8_STAGE_A(PG8_SA(0, 0), a2, 0, last);
            PG8_BAR; PG8_WAIT_L(0); PG8_MMA(1, 0, At, B0); PG8_BAR; PG8_SCHED;
            PG8_STAGE(PG8_SB(0, 1), b2 + hstep, voffB);
            PG8_WAIT_V(6); PG8_BAR; PG8_MMA(1, 1, At, B1); PG8_BAR;
            PG8_LDB(B0, 1, 0); PG8_SCHED; PG8_LDA(At, 1, 0); PG8_STAGE_A(PG8_SA(0, 1), a2, 1, last);
            PG8_WAIT_L(8); PG8_BAR; PG8_WAIT_L(0); PG8_MMA(0, 0, At, B0); PG8_BAR; PG8_SCHED;
            PG8_LDB(B1, 1, 1); PG8_STAGE(PG8_SB(1, 0), b3, voffB);
            PG8_BAR; PG8_WAIT_L(0); PG8_MMA(0, 1, At, B1); PG8_BAR;
            PG8_LDA(At, 1, 1); PG8_STAGE_A(PG8_SA(1, 0), a3, 0, last);
            PG8_BAR; PG8_WAIT_L(0); PG8_MMA(1, 0, At, B0); PG8_BAR; PG8_SCHED;
            PG8_STAGE(PG8_SB(1, 1), b3 + hstep, voffB);
            PG8_WAIT_V(6); PG8_BAR; PG8_MMA(1, 1, At, B1); PG8_BAR;
            }
        }
        if constexpr (ALIGN_EPI) { if (wr == 0) PG8_BAR; }
        if constexpr (!Epi::AFTER_DRAIN) { E(acc, cur, wr, wc, fr, fq); S.done(cur); }
        if (!has_next) break;
#pragma unroll
        for (int a = 0; a < 2; ++a)
#pragma unroll
            for (int b = 0; b < 2; ++b)
#pragma unroll
                for (int m = 0; m < 4; ++m)
#pragma unroll
                    for (int n = 0; n < 2; ++n) acc[a][b][m][n] = (f32x4){0.f, 0.f, 0.f, 0.f};
        cur = nxt; cA = nA; cB = nB; ++ui;
        if constexpr (GATHER) {
#pragma unroll
            for (int h_ = 0; h_ < 2; ++h_) { voffAc[h_][0] = voffAn[h_][0]; voffAc[h_][1] = voffAn[h_][1]; } }
        if constexpr (ALIGN_EPI) { if (wr == 1) PG8_BAR; }
    }
    PG8_WAIT_V(0);
    if constexpr (!ALIGN_EPI) { if (wr == 0) PG8_BAR; }
    PG8_BAR;
    if constexpr (Epi::AFTER_DRAIN) { E.fused(acc, cur, wr, wc, fr, fq, lds, wid, lane); S.done(cur); }
#undef PG8_SA
#undef PG8_SB
#undef PG8_STAGE
#undef PG8_STAGE_A
#undef PG8_GVOFF
#undef PG8_LDA
#undef PG8_LDB
#undef PG8_MMA
#undef PG8_WAIT_V
#undef PG8_WAIT_L
#undef PG8_BAR
#undef PG8_SCHED
}
}
#define GAS __attribute__((address_space(1)))
#define LAS __attribute__((address_space(3)))
typedef unsigned short bf16;
typedef unsigned v4u __attribute__((ext_vector_type(4)));
typedef float f32x4 __attribute__((ext_vector_type(4)));
typedef short bf16x8 __attribute__((ext_vector_type(8)));
typedef GAS unsigned gu32;
typedef GAS unsigned long long gu64;
#define RLX_AGENT __ATOMIC_RELAXED, __HIP_MEMORY_SCOPE_AGENT
#define LDS_WAIT() asm volatile("s_waitcnt lgkmcnt(0)" ::: "memory")
#define VM_WAIT() asm volatile("s_waitcnt vmcnt(0)" ::: "memory")
__device__ __forceinline__ unsigned long long rt() { return __builtin_amdgcn_s_memrealtime(); }
__device__ __forceinline__ unsigned f2bf(float f) { unsigned u = __builtin_bit_cast(unsigned, f); return (u + 0x7fffu + ((u >> 16) & 1u)) >> 16; }
__device__ __forceinline__ unsigned pk2(float lo, float hi) { return f2bf(lo) | (f2bf(hi) << 16); }

#define XB_TMO      128
#define XB_XCNT(j)  (256  + 64 * (j))
#define XB_XSUB(j)  (1280 + 64 * (j))
#define XB_XGEN(j)  (2304 + 64 * (j))
#define XB_TOP      3328
#define XB_TOPGEN   3392
#define XCD_BAR_WORDS 3456
#define XB_SPIN_CAP (1u << 22)

__device__ __forceinline__ unsigned xb_ld(unsigned* p)              { return __hip_atomic_load(p, __ATOMIC_RELAXED, __HIP_MEMORY_SCOPE_AGENT); }
__device__ __forceinline__ unsigned xb_add(unsigned* p, unsigned v) { return __hip_atomic_fetch_add(p, v, __ATOMIC_RELAXED, __HIP_MEMORY_SCOPE_AGENT); }
__device__ __forceinline__ unsigned xb_xcc_id() { return (unsigned)__builtin_amdgcn_s_getreg((3 << 11) | 20) & 0xFu; }
#define XB_SPIN(cond, bar) do { unsigned _sp = 0; while (cond) { __builtin_amdgcn_s_sleep(1); \
    if ((++_sp & 255u) == 0u) { if (xb_ld(&(bar)[XB_TMO])) break; if (_sp > XB_SPIN_CAP) { atomicAdd(&(bar)[XB_TMO], 1u); break; } } } } while (0)

struct XcdBarrier {
    unsigned* bar; unsigned x;
    volatile LAS unsigned* st;
};

__device__ __forceinline__ XcdBarrier xcd_barrier_post(unsigned* bar, volatile LAS unsigned* st) {
    XcdBarrier b; b.bar = bar; b.x = xb_xcc_id(); b.st = st;
    if (threadIdx.x == 0) (void)xb_add(&bar[XB_XCNT(b.x)], 1u);
    return b;
}
__device__ __forceinline__ void xcd_barrier_complete(unsigned* bar, unsigned x, unsigned& nloc, unsigned& nx) {
    const unsigned G = gridDim.x * gridDim.y * gridDim.z;
    unsigned sum, cnt, mine, sp = 0u;
    for (;;) {
        sum = 0u; cnt = 0u; mine = 0u;
#pragma unroll
        for (unsigned j = 0; j < 16; ++j) { const unsigned c = xb_ld(&bar[XB_XCNT(j)]); sum += c; cnt += (c > 0u) ? 1u : 0u; mine = (j == x) ? c : mine; }
        if (sum == G) break;
        __builtin_amdgcn_s_sleep(1);
        if ((++sp & 255u) == 0u) { if (xb_ld(&bar[XB_TMO])) break; if (sp > XB_SPIN_CAP) { atomicAdd(&bar[XB_TMO], 1u); break; } }
    }
    nloc = mine > 0u ? mine : 1u; nx = cnt > 0u ? cnt : 1u;
}

__device__ __forceinline__ void xcd_barrier(const XcdBarrier& b) {
    asm volatile("s_waitcnt vmcnt(0)" ::: "memory");
    __syncthreads();
    if (threadIdx.x == 0) {
        unsigned* bar = b.bar;
        __builtin_amdgcn_s_waitcnt(0);
        unsigned nloc = b.st[0], nx = b.st[1];
        if (nloc == 0u) { xcd_barrier_complete(bar, b.x, nloc, nx); b.st[0] = nloc; b.st[1] = nx; }
        const unsigned old = xb_add(&bar[XB_XSUB(b.x)], 1u);
        const unsigned gen = old / nloc;
        if (old + 1u == (gen + 1u) * nloc) {
            __builtin_amdgcn_fence(__ATOMIC_RELEASE, "agent");
            asm volatile("s_waitcnt vmcnt(0)" ::: "memory");
            const unsigned og = xb_add(&bar[XB_TOP], 1u);
            const unsigned tg = og / nx;
            if (og + 1u == (tg + 1u) * nx) xb_add(&bar[XB_TOPGEN], 1u);
            else XB_SPIN(xb_ld(&bar[XB_TOPGEN]) == tg, bar);
            __builtin_amdgcn_fence(__ATOMIC_ACQUIRE, "agent");
            xb_add(&bar[XB_XGEN(b.x)], 1u);
            asm volatile("s_waitcnt vmcnt(0)" ::: "memory");
        } else {
            XB_SPIN(xb_ld(&bar[XB_XGEN(b.x)]) == gen, bar);
            __builtin_amdgcn_fence(__ATOMIC_ACQUIRE, "agent");
            asm volatile("s_waitcnt vmcnt(0)" ::: "memory");
        }
    }
    __syncthreads();
}

#ifndef PG8_SP2
#define PG8_SP2 true
#endif
#ifndef PG8_ALIGN
#define PG8_ALIGN true
#endif
namespace pg8 {
struct EpiResF32 {
    static constexpr bool PERM = false, AFTER_DRAIN = false;
    const float* base; float* C; int ldc;
    __device__ __forceinline__ void operator()(const f32x4 (&acc)[2][2][4][2], const Unit& u, int wr, int wc, int fr, int fq) const {
        const int row0 = u.pm * BM + wr * 64 + fr, col0 = u.pn * BM + wc * 32 + 4 * fq;
#pragma unroll
        for (int ai = 0; ai < 2; ++ai)
#pragma unroll
            for (int m = 0; m < 4; ++m) { const size_t off = (size_t)(row0 + ai * HALF + m * 16) * ldc + col0;
#pragma unroll
                for (int bj = 0; bj < 2; ++bj)
#pragma unroll
                    for (int n = 0; n < 2; ++n) { const f32x4 bs = *(const f32x4*)(base + off + bj * HALF + n * 16); *(f32x4*)(C + off + bj * HALF + n * 16) = bs + acc[ai][bj][m][n]; }
                asm volatile("" ::: "memory"); }
    }
};
struct EpiResXn {
    static constexpr bool PERM = true, AFTER_DRAIN = false;
    const bf16_t* XN; const float* rms; bf16_t* O; int ldc;
    __device__ __forceinline__ void operator()(const f32x4 (&acc)[2][2][4][2], const Unit& u, int wr, int wc, int fr, int fq) const {
        const int row0 = u.pm * BM + wr * 64 + fr, col0 = u.pn * BM + wc * 32 + 8 * fq;
#pragma unroll
        for (int ai = 0; ai < 2; ++ai)
#pragma unroll
            for (int m = 0; m < 4; ++m) { const int row = row0 + ai * HALF + m * 16; const size_t off = (size_t)row * ldc + col0; const float rs = rms[row];
#pragma unroll
                for (int bj = 0; bj < 2; ++bj) { const u32x4 xw = *(const u32x4*)(XN + off + bj * HALF);
                    const f32x4 b0 = (f32x4){__builtin_bit_cast(float, xw.x << 16), __builtin_bit_cast(float, xw.x & 0xffff0000u), __builtin_bit_cast(float, xw.y << 16), __builtin_bit_cast(float, xw.y & 0xffff0000u)};
                    const f32x4 b1 = (f32x4){__builtin_bit_cast(float, xw.z << 16), __builtin_bit_cast(float, xw.z & 0xffff0000u), __builtin_bit_cast(float, xw.w << 16), __builtin_bit_cast(float, xw.w & 0xffff0000u)};
                    const f32x4 v0 = acc[ai][bj][m][0] + b0 * rs, v1 = acc[ai][bj][m][1] + b1 * rs;
                    u32x4 w; w.x = cvt_pk_bf16(v0[0], v0[1]); w.y = cvt_pk_bf16(v0[2], v0[3]); w.z = cvt_pk_bf16(v1[0], v1[1]); w.w = cvt_pk_bf16(v1[2], v1[3]);
                    *(u32x4*)(O + off + bj * HALF) = w; }
                asm volatile("" ::: "memory"); }
    }
};
struct EpiResBf16 {
    static constexpr bool PERM = true, AFTER_DRAIN = false;
    const float* base; bf16_t* O; int ldc;
    __device__ __forceinline__ void operator()(const f32x4 (&acc)[2][2][4][2], const Unit& u, int wr, int wc, int fr, int fq) const {
        const int row0 = u.pm * BM + wr * 64 + fr, col0 = u.pn * BM + wc * 32 + 8 * fq;
#pragma unroll
        for (int ai = 0; ai < 2; ++ai)
#pragma unroll
            for (int m = 0; m < 4; ++m) { const size_t off = (size_t)(row0 + ai * HALF + m * 16) * ldc + col0;
#pragma unroll
                for (int bj = 0; bj < 2; ++bj) { const f32x4 b0 = *(const f32x4*)(base + off + bj * HALF), b1 = *(const f32x4*)(base + off + bj * HALF + 4);
                    const f32x4 v0 = acc[ai][bj][m][0] + b0, v1 = acc[ai][bj][m][1] + b1;
                    u32x4 w; w.x = cvt_pk_bf16(v0[0], v0[1]); w.y = cvt_pk_bf16(v0[2], v0[3]); w.z = cvt_pk_bf16(v1[0], v1[1]); w.w = cvt_pk_bf16(v1[2], v1[3]);
                    *(u32x4*)(O + off + bj * HALF) = w; }
                asm volatile("" ::: "memory"); }
    }
};
struct EpiBiasBf16 {
    static constexpr bool PERM = true, AFTER_DRAIN = false;
    bf16_t* O; int ldc; const float* bias; int bstride;
    __device__ __forceinline__ void operator()(const f32x4 (&acc)[2][2][4][2], const Unit& u, int wr, int wc, int fr, int fq) const {
        const int row0 = u.pm * BM + wr * 64 + fr; const int col0 = u.pn * BM + wc * 32 + 8 * fq;
        const float* bp = bias ? bias + (size_t)u.e * bstride + col0 : nullptr;
        f32x4 bv[2][2];
#pragma unroll
        for (int bj = 0; bj < 2; ++bj)
#pragma unroll
            for (int n = 0; n < 2; ++n) bv[bj][n] = bias ? *(const f32x4*)(bp + bj * HALF + 4 * n) : (f32x4){0.f, 0.f, 0.f, 0.f};
#pragma unroll
        for (int ai = 0; ai < 2; ++ai)
#pragma unroll
            for (int m = 0; m < 4; ++m) { bf16_t* rowp = O + (size_t)(row0 + ai * HALF + m * 16) * ldc + col0;
#pragma unroll
                for (int bj = 0; bj < 2; ++bj) { const f32x4 v0 = acc[ai][bj][m][0] + bv[bj][0], v1 = acc[ai][bj][m][1] + bv[bj][1];
                    u32x4 w; w.x = cvt_pk_bf16(v0[0], v0[1]); w.y = cvt_pk_bf16(v0[2], v0[3]); w.z = cvt_pk_bf16(v1[0], v1[1]); w.w = cvt_pk_bf16(v1[2], v1[3]);
                    *(u32x4*)(rowp + bj * HALF) = w; } }
    }
};
__device__ __forceinline__ unsigned pk4_fp8e(float a, float b, float c, float d) {
    int w = 0; w = __builtin_amdgcn_cvt_pk_fp8_f32(a * 8.f, b * 8.f, w, false); w = __builtin_amdgcn_cvt_pk_fp8_f32(c * 8.f, d * 8.f, w, true); return (unsigned)w; }
typedef unsigned u32x2v __attribute__((ext_vector_type(2)));
__device__ __forceinline__ unsigned pk4_fp8c(float a, float b, float c, float d) {
    a = fminf(fmaxf(a * 8.f, -448.f), 448.f); b = fminf(fmaxf(b * 8.f, -448.f), 448.f); c = fminf(fmaxf(c * 8.f, -448.f), 448.f); d = fminf(fmaxf(d * 8.f, -448.f), 448.f);
    int w = 0; w = __builtin_amdgcn_cvt_pk_fp8_f32(a, b, w, false); w = __builtin_amdgcn_cvt_pk_fp8_f32(c, d, w, true); return (unsigned)w; }
struct EpiBiasLdsBf16 {
    static constexpr bool PERM = true, AFTER_DRAIN = false;
    bf16_t* O; int ldc; const PG8_LAS unsigned short* biasL;
    __device__ __forceinline__ void operator()(const f32x4 (&acc)[2][2][4][2], const Unit& u, int wr, int wc, int fr, int fq) const {
        const int row0 = u.pm * BM + wr * 64 + fr; const int col0 = u.pn * BM + wc * 32 + 8 * fq;
        f32x4 bv[2][2];
#pragma unroll
        for (int bj = 0; bj < 2; ++bj) { const u32x4 w = *(const PG8_LAS u32x4*)(biasL + u.e * 256 + bj * HALF + wc * 32 + 8 * fq);
            bv[bj][0] = (f32x4){__builtin_bit_cast(float, w.x << 16), __builtin_bit_cast(float, w.x & 0xffff0000u), __builtin_bit_cast(float, w.y << 16), __builtin_bit_cast(float, w.y & 0xffff0000u)};
            bv[bj][1] = (f32x4){__builtin_bit_cast(float, w.z << 16), __builtin_bit_cast(float, w.z & 0xffff0000u), __builtin_bit_cast(float, w.w << 16), __builtin_bit_cast(float, w.w & 0xffff0000u)}; }
#pragma unroll
        for (int ai = 0; ai < 2; ++ai)
#pragma unroll
            for (int m = 0; m < 4; ++m) { unsigned char* rowp = (unsigned char*)O + (size_t)(row0 + ai * HALF + m * 16) * ldc + col0;
#pragma unroll
                for (int bj = 0; bj < 2; ++bj) { const f32x4 v0 = acc[ai][bj][m][0] + bv[bj][0], v1 = acc[ai][bj][m][1] + bv[bj][1];
                    u32x2v w; w.x = pk4_fp8c(v0[0], v0[1], v0[2], v0[3]); w.y = pk4_fp8c(v1[0], v1[1], v1[2], v1[3]);
                    *(u32x2v*)(rowp + bj * HALF) = w; } }
    }
};
struct EpiSwiGLU {
    static constexpr bool PERM = true, AFTER_DRAIN = false;
    bf16_t* O; int ldc; const PG8_LAS unsigned short* biasL;
    __device__ __forceinline__ void operator()(const f32x4 (&acc)[2][2][4][2], const Unit& u, int wr, int wc, int fr, int fq) const {
        const int row0 = u.pm * BM + wr * 64 + fr; const int ff0 = u.pn * HALF + wc * 32 + 8 * fq;
        f32x4 bg[2], bu[2];
        { const PG8_LAS unsigned short* bp = biasL + u.e * 256 + wc * 32 + 8 * fq;
          const u32x4 wg = *(const PG8_LAS u32x4*)bp, wu = *(const PG8_LAS u32x4*)(bp + 128);
          bg[0] = (f32x4){__builtin_bit_cast(float, wg.x << 16), __builtin_bit_cast(float, wg.x & 0xffff0000u), __builtin_bit_cast(float, wg.y << 16), __builtin_bit_cast(float, wg.y & 0xffff0000u)};
          bg[1] = (f32x4){__builtin_bit_cast(float, wg.z << 16), __builtin_bit_cast(float, wg.z & 0xffff0000u), __builtin_bit_cast(float, wg.w << 16), __builtin_bit_cast(float, wg.w & 0xffff0000u)};
          bu[0] = (f32x4){__builtin_bit_cast(float, wu.x << 16), __builtin_bit_cast(float, wu.x & 0xffff0000u), __builtin_bit_cast(float, wu.y << 16), __builtin_bit_cast(float, wu.y & 0xffff0000u)};
          bu[1] = (f32x4){__builtin_bit_cast(float, wu.z << 16), __builtin_bit_cast(float, wu.z & 0xffff0000u), __builtin_bit_cast(float, wu.w << 16), __builtin_bit_cast(float, wu.w & 0xffff0000u)}; }
#pragma unroll
        for (int ai = 0; ai < 2; ++ai)
#pragma unroll
            for (int m = 0; m < 4; ++m) { unsigned char* rowp = (unsigned char*)O + (size_t)(row0 + ai * HALF + m * 16) * ldc + ff0;
                float o[8];
#pragma unroll
                for (int n = 0; n < 2; ++n) { const f32x4 g = acc[ai][0][m][n] + bg[n], up = acc[ai][1][m][n] + bu[n];
#pragma unroll
                    for (int j = 0; j < 4; ++j) { const float gg = fminf(g[j], 7.0f), uu = fminf(fmaxf(up[j], -7.0f), 7.0f);
                        const float sg = __builtin_amdgcn_rcpf(1.0f + __builtin_amdgcn_exp2f(-1.702f * 1.44269504089f * gg));
                        o[4 * n + j] = (uu + 1.0f) * (gg * sg); } }
                u32x2v w; w.x = pk4_fp8e(o[0], o[1], o[2], o[3]); w.y = pk4_fp8e(o[4], o[5], o[6], o[7]);
                *(u32x2v*)rowp = w; }
    }
};
struct MoeOrder {
    const PG8_LAS int* tile_e; int MT, nN, G, c;
    __device__ bool next(int i, Unit& u) const {
        const int per_round = G / nN, mpx = per_round / 8; int mt, pn;
        if (G % (8 * nN) == 0) { const int xcd = c & 7, loc = c >> 3; mt = i * per_round + xcd * mpx + loc / nN; pn = loc % nN; }
        else { const long L = (long)i * G + c; mt = (int)(L / nN); pn = (int)(L % nN); }
        if (mt >= MT) return false; const int e = __builtin_amdgcn_readfirstlane(tile_e[mt]);
        u.pm = mt; u.pn = pn; u.pb = e * nN + pn; u.e = e; return true;
    }
    __device__ __forceinline__ void a_ready(const Unit&) const {}
    __device__ __forceinline__ void done(const Unit&) const {}
};
}

constexpr int NWAVES = 8;
constexpr int BATCH = 4, SEQ = 8192, D = 1024, M = BATCH * SEQ;
constexpr int IN_COLS = 3328, CW = 512, RW = 512, NH = 8, HD = 64;
constexpr int NE = 32, TOPK = 4, FF = 1024;
constexpr int SLOT_ROWS = M * TOPK + NE * 256;
constexpr int MT_MAX = SLOT_ROWS / 256;
constexpr float NORM_EPS = 1e-5f, GN_EPS = 64e-5f;
#ifndef MK_N_LAUNCHES
#define MK_N_LAUNCHES 1
#endif
constexpr int NPHASE = 10;
constexpr int N_LAUNCHES = MK_N_LAUNCHES;

constexpr size_t MiB = 1u << 20;
constexpr size_t WS_CTL = 0, CTL_ZERO_BYTES = 1 * MiB;
constexpr size_t WS_WIN = 2 * MiB;
constexpr size_t WS_WOUT = 9 * MiB;
constexpr size_t WS_LORA = 11 * MiB;
constexpr size_t WS_TOKE = 12 * MiB, WS_TOKG = WS_TOKE + 512 * 1024, WS_TOKR = WS_TOKG + 512 * 1024, WS_DEST = WS_TOKR + 512 * 1024;
constexpr size_t WS_BDOT = 14 * MiB;
constexpr size_t WS_WGU = 16 * MiB;
constexpr size_t WS_WDN = 144 * MiB;
constexpr size_t WS_XN = 208 * MiB;
constexpr size_t WS_Y = 272 * MiB;
constexpr size_t WS_P = 336 * MiB;
constexpr size_t WS_FR = 544 * MiB;
constexpr size_t WS_SR = 544 * MiB, WS_SW = 608 * MiB, WS_SK = 672 * MiB, WS_SV = 864 * MiB, WS_SKK = 800 * MiB, WS_SB = 864 * MiB;
constexpr size_t WS_SG = 928 * MiB;
constexpr size_t WS_XIN = 272 * MiB;
constexpr size_t WS_YSLOT = WS_XIN;
constexpr size_t WS_ACT = 544 * MiB;
constexpr size_t WS_X1 = 816 * MiB;
constexpr size_t WS_END = 960 * MiB;
constexpr int CHK = 32, NCH = SEQ / CHK, NCHH = BATCH * NH * NCH;
constexpr size_t WS_SF = WS_FR;
constexpr size_t WS_RMS = 15 * MiB;
constexpr size_t WS_QF = 736 * MiB;
constexpr size_t WS_O1 = 768 * MiB;
constexpr size_t WS_GF = 608 * MiB;
constexpr size_t WS_HF = 672 * MiB;
constexpr size_t WS_PC = 800 * MiB;
static_assert(WS_ACT + (size_t)SLOT_ROWS * 1024 * 2 <= WS_X1 && WS_X1 + (size_t)M * D * 4 <= WS_END && WS_XIN + (size_t)SLOT_ROWS * 1024 * 2 <= WS_ACT, "ws map");
constexpr int CW_BAR = 4096;
constexpr int CW_CNT = 8192;
constexpr int CW_MT = 8256;
constexpr int CW_TILE_E = 8320;
constexpr int RING_BYTES = 131072, LDS_BYTES = 163840, LDSCTL_OFF = LDS_BYTES - 512, MISC_OFF = LDSCTL_OFF + 320;

constexpr int MOE_TOK_OFF = RING_BYTES + 2304 + 32 * 256 * 2, MOE_MAXU = 18;
constexpr size_t WS_LIST = 240 * MiB;
constexpr int MOE_TAB_OFF = RING_BYTES, MOE_BIAS_OFF = RING_BYTES + 2304;
static_assert(MOE_TOK_OFF + MOE_MAXU * 512 + 512 <= LDSCTL_OFF, "MoE LDS tables fit");
typedef unsigned u32x2 __attribute__((ext_vector_type(2)));
typedef float f32x2 __attribute__((ext_vector_type(2)));

typedef float f32x2_t __attribute__((ext_vector_type(2))); typedef __bf16 bf16x2_t __attribute__((ext_vector_type(2)));
__device__ __forceinline__ unsigned cvtpk_s(float lo, float hi) { f32x2_t v = {lo, hi}; bf16x2_t b = __builtin_convertvector(v, bf16x2_t); return __builtin_bit_cast(unsigned, b); }
__device__ __forceinline__ float wave_sum(float v) {
#pragma unroll
    for (int o = 1; o < 64; o <<= 1) v += __shfl_xor(v, o);
    return v;
}
__device__ __forceinline__ float bf_lo(unsigned w) { return __builtin_bit_cast(float, w << 16); }
__device__ __forceinline__ float bf_hi(unsigned w) { return __builtin_bit_cast(float, w & 0xffff0000u); }
__device__ __forceinline__ float fast_sigmoid(float x) { return __builtin_amdgcn_rcpf(1.0f + __builtin_amdgcn_exp2f(-1.44269504089f * x)); }
__device__ __forceinline__ float fast_tanh(float x) { const float xc = fminf(fmaxf(x, -15.f), 15.f); const float e = __builtin_amdgcn_exp2f(2.88539008178f * xc); return 1.0f - 2.0f * __builtin_amdgcn_rcpf(e + 1.0f); }

__device__ __forceinline__ void p0_transpose_item(const float* W, int K, int N, bf16* WT, int dst_row0, LAS float* scr, int k0, int n0, int lane) {
#pragma unroll
    for (int i = 0; i < 8; ++i) { const int kk = 8 * i + (lane >> 3), c4 = (lane & 7) * 4; const f32x4 v = *(const f32x4*)(W + (size_t)(k0 + kk) * N + n0 + c4);
        scr[kk * 33 + c4] = v.x; scr[kk * 33 + c4 + 1] = v.y; scr[kk * 33 + c4 + 2] = v.z; scr[kk * 33 + c4 + 3] = v.w; }
    LDS_WAIT(); asm volatile("" ::: "memory");
    const int c = lane & 7;
#pragma unroll
    for (int j = 0; j < 4; ++j) { const int n = (lane >> 3) + 8 * j; const LAS float* s = scr + (8 * c) * 33 + n;
        v4u o; o.x = pk2(s[0 * 33], s[1 * 33]); o.y = pk2(s[2 * 33], s[3 * 33]); o.z = pk2(s[4 * 33], s[5 * 33]); o.w = pk2(s[6 * 33], s[7 * 33]);
        *(GAS v4u*)(WT + (size_t)(dst_row0 + n) * K + k0 + 8 * c) = o; }
    LDS_WAIT(); asm volatile("" ::: "memory");
}

__device__ __forceinline__ void p0_transpose_item_g(const float* W, int K, int N, bf16* WT, int dst_row0, LAS float* scr, int k0, int n0, int lane, const float* gk) {
#pragma unroll
    for (int i = 0; i < 8; ++i) { const int kk = 8 * i + (lane >> 3), c4 = (lane & 7) * 4; const f32x4 v = *(const f32x4*)(W + (size_t)(k0 + kk) * N + n0 + c4);
        scr[kk * 33 + c4] = v.x; scr[kk * 33 + c4 + 1] = v.y; scr[kk * 33 + c4 + 2] = v.z; scr[kk * 33 + c4 + 3] = v.w; }
    const int c = lane & 7;
    const f32x4 ga = *(const f32x4*)(gk + k0 + 8 * c), gb = *(const f32x4*)(gk + k0 + 8 * c + 4);
    LDS_WAIT(); asm volatile("" ::: "memory");
#pragma unroll
    for (int j = 0; j < 4; ++j) { const int n = (lane >> 3) + 8 * j; const LAS float* s = scr + (8 * c) * 33 + n;
        v4u o; o.x = pk2(s[0 * 33] * ga.x, s[1 * 33] * ga.y); o.y = pk2(s[2 * 33] * ga.z, s[3 * 33] * ga.w); o.z = pk2(s[4 * 33] * gb.x, s[5 * 33] * gb.y); o.w = pk2(s[6 * 33] * gb.z, s[7 * 33] * gb.w);
        *(GAS v4u*)(WT + (size_t)(dst_row0 + n) * K + k0 + 8 * c) = o; }
    LDS_WAIT(); asm volatile("" ::: "memory");
}

__device__ __forceinline__ unsigned pk4_fp8(float a, float b, float c, float d, float s) {
    a = fminf(fmaxf(a * s, -448.f), 448.f); b = fminf(fmaxf(b * s, -448.f), 448.f); c = fminf(fmaxf(c * s, -448.f), 448.f); d = fminf(fmaxf(d * s, -448.f), 448.f);
    int w = 0; w = __builtin_amdgcn_cvt_pk_fp8_f32(a, b, w, false); w = __builtin_amdgcn_cvt_pk_fp8_f32(c, d, w, true); return (unsigned)w; }
constexpr float F8_W_SCALE = 1024.f, F8_H_SCALE = 32.f, F8_ACT_SCALE = 8.f;
constexpr int F8_W_BYTE = 0x75757575, F8_H_BYTE = 0x7a7a7a7a, F8_ACT_BYTE = 0x7c7c7c7c;
struct F8Item { f32x4 v[8]; };
__device__ __forceinline__ void f8_item_load(F8Item& it, const float* W, int N, int k0, int n0, int lane) {
#pragma unroll
    for (int i = 0; i < 8; ++i) { const int kk = 8 * i + (lane >> 3), c4 = (lane & 7) * 4; it.v[i] = *(const f32x4*)(W + (size_t)(k0 + kk) * N + n0 + c4); }
}
__device__ __forceinline__ void f8_item_finish(const F8Item& it, int K, unsigned char* WT, int dst_row0, LAS float* scr, int k0, int lane) {
#pragma unroll
    for (int i = 0; i < 8; ++i) { const int kk = 8 * i + (lane >> 3), c4 = (lane & 7) * 4; scr[kk * 33 + c4] = it.v[i].x; scr[kk * 33 + c4 + 1] = it.v[i].y; scr[kk * 33 + c4 + 2] = it.v[i].z; scr[kk * 33 + c4 + 3] = it.v[i].w; }
    LDS_WAIT(); asm volatile("" ::: "memory");
    const int c = lane & 7;
#pragma unroll
    for (int j = 0; j < 4; ++j) { const int n = (lane >> 3) + 8 * j; const LAS float* s = scr + (8 * c) * 33 + n;
        u32x2 o; o.x = pk4_fp8(s[0 * 33], s[1 * 33], s[2 * 33], s[3 * 33], F8_W_SCALE); o.y = pk4_fp8(s[4 * 33], s[5 * 33], s[6 * 33], s[7 * 33], F8_W_SCALE);
        *(GAS u32x2*)(WT + (size_t)(dst_row0 + n) * K + k0 + 8 * c) = o; }
    LDS_WAIT(); asm volatile("" ::: "memory");
}
__device__ __forceinline__ void p0_transpose_item_f8(const float* W, int K, int N, unsigned char* WT, int dst_row0, LAS float* scr, int k0, int n0, int lane) {
#pragma unroll
    for (int i = 0; i < 8; ++i) { const int kk = 8 * i + (lane >> 3), c4 = (lane & 7) * 4; const f32x4 v = *(const f32x4*)(W + (size_t)(k0 + kk) * N + n0 + c4);
        scr[kk * 33 + c4] = v.x; scr[kk * 33 + c4 + 1] = v.y; scr[kk * 33 + c4 + 2] = v.z; scr[kk * 33 + c4 + 3] = v.w; }
    LDS_WAIT(); asm volatile("" ::: "memory");
    const int c = lane & 7;
#pragma unroll
    for (int j = 0; j < 4; ++j) { const int n = (lane >> 3) + 8 * j; const LAS float* s = scr + (8 * c) * 33 + n;
        u32x2 o; o.x = pk4_fp8(s[0 * 33], s[1 * 33], s[2 * 33], s[3 * 33], F8_W_SCALE); o.y = pk4_fp8(s[4 * 33], s[5 * 33], s[6 * 33], s[7 * 33], F8_W_SCALE);
        *(GAS u32x2*)(WT + (size_t)(dst_row0 + n) * K + k0 + 8 * c) = o; }
    LDS_WAIT(); asm volatile("" ::: "memory");
}

constexpr int MOE_I_DN = 32 * 512, MOE_I_GU = 32 * 1024, MOE_NIT = MOE_I_DN + MOE_I_GU, MOE_P1_ITEMS = 28672;
__device__ __forceinline__ void moe_convert_items(const float* wdn, const float* wgu, unsigned char* WDN8, unsigned char* WGU8, LAS float* scr, int first, int limit, int stride, int lane) {
#define MOE_ITEM(it_, W_, N_, WT_, DR_, K0_, N0_) do { int r_ = (it_); if (r_ < MOE_I_DN) { const int e_ = r_ / 512, q_ = r_ % 512, kb_ = q_ / 32, nb_ = q_ % 32; W_ = wdn + (size_t)e_ * 1024 * 1024; N_ = 1024; \
            WT_ = WDN8 + (size_t)e_ * 1024 * 1024; DR_ = 32 * nb_; K0_ = 64 * kb_; N0_ = 32 * nb_; } \
        else { r_ -= MOE_I_DN; const int e_ = r_ / 1024, q_ = r_ % 1024, kb_ = q_ / 64, nb_ = q_ % 64; const int n0_ = 32 * nb_, half_ = n0_ >> 10, j_ = n0_ & 1023; W_ = wgu + (size_t)e_ * 1024 * 2048; N_ = 2048; \
            WT_ = WGU8 + (size_t)e_ * 2048 * 1024; DR_ = 256 * (j_ >> 7) + 128 * half_ + (j_ & 127); K0_ = 64 * kb_; N0_ = n0_; } } while (0)
    F8Item q0, q1, q2, q3; const float* Wq[4]; int Nq[4], DRq[4], K0q[4], N0q[4]; unsigned char* WTq[4];
#define MOE_PREF(Q_, slot_, it_) do { if ((it_) < limit) { MOE_ITEM((it_), Wq[slot_], Nq[slot_], WTq[slot_], DRq[slot_], K0q[slot_], N0q[slot_]); f8_item_load(Q_, Wq[slot_], Nq[slot_], K0q[slot_], N0q[slot_], lane); } } while (0)
    MOE_PREF(q0, 0, first); MOE_PREF(q1, 1, first + stride); MOE_PREF(q2, 2, first + 2 * stride);
    for (int it = first; it < limit; it += 4 * stride) {
        MOE_PREF(q3, 3, it + 3 * stride); f8_item_finish(q0, 1024, WTq[0], DRq[0], scr, K0q[0], lane);
        if (it + stride < limit) { MOE_PREF(q0, 0, it + 4 * stride); f8_item_finish(q1, 1024, WTq[1], DRq[1], scr, K0q[1], lane); }
        if (it + 2 * stride < limit) { MOE_PREF(q1, 1, it + 5 * stride); f8_item_finish(q2, 1024, WTq[2], DRq[2], scr, K0q[2], lane); }
        if (it + 3 * stride < limit) { MOE_PREF(q2, 2, it + 6 * stride); f8_item_finish(q3, 1024, WTq[3], DRq[3], scr, K0q[3], lane); }
    }
#undef MOE_PREF
#undef MOE_ITEM
}

struct Args { const float* in[25]; float* out; unsigned char* ws; int ph_lo, ph_hi, li, pad; };

__global__ void __launch_bounds__(NWAVES * 64, 2) mk_fwd(Args args) {
    extern __shared__ __attribute__((aligned(16))) unsigned char lds_raw[];
    LAS unsigned char* lds = (LAS unsigned char*)lds_raw;
    volatile LAS unsigned* MISC = (volatile LAS unsigned*)(lds + MISC_OFF);
    const int tid = threadIdx.x, lane = tid & 63, wave = __builtin_amdgcn_readfirstlane(tid >> 6);
    const int G = gridDim.x; const int vcu = (G % 8 == 0) ? ((int)blockIdx.x % 8) * (G / 8) + (int)blockIdx.x / 8 : (int)blockIdx.x;
    const int gw = vcu * NWAVES + wave, NGW = G * NWAVES;
    unsigned char* ws = args.ws;
    unsigned* ctl = (unsigned*)(ws + WS_CTL);
    const float* x = args.in[0];
    bf16* WIN_T = (bf16*)(ws + WS_WIN); bf16* WOUT_T = (bf16*)(ws + WS_WOUT); bf16* WGU_T = (bf16*)(ws + WS_WGU); bf16* WDN_T = (bf16*)(ws + WS_WDN);
    bf16* WUP_T = (bf16*)(ws + WS_LORA); bf16* AUP_T = WUP_T + 512 * 64; bf16* GUP_T = AUP_T + 512 * 64;
    bf16* XN = (bf16*)(ws + WS_XN); bf16* Y = (bf16*)(ws + WS_Y); bf16* P = (bf16*)(ws + WS_P);
    float* SR = (float*)(ws + WS_SR); float* SW = (float*)(ws + WS_SW); float* SK = (float*)(ws + WS_SK); float* SV = (float*)(ws + WS_SV); float* SKK = (float*)(ws + WS_SKK); float* SB = (float*)(ws + WS_SB);
    bf16* SG = (bf16*)(ws + WS_SG); float* BDOT = (float*)(ws + WS_BDOT);
    bf16* X1 = (bf16*)(ws + WS_X1); bf16* XIN = (bf16*)(ws + WS_XIN); bf16* ACT = (bf16*)(ws + WS_ACT); bf16* YSLOT = (bf16*)(ws + WS_YSLOT);
    int* TOKE = (int*)(ws + WS_TOKE); float* TOKG = (float*)(ws + WS_TOKG); int* TOKR = (int*)(ws + WS_TOKR); int* DEST = (int*)(ws + WS_DEST);

    for (int u = tid; u < (LDS_BYTES - LDSCTL_OFF) / 4; u += NWAVES * 64) ((LAS unsigned*)(lds + LDSCTL_OFF))[u] = 0u;
    __syncthreads();
    XcdBarrier bar; bar.bar = ctl + CW_BAR; bar.x = 0; bar.st = nullptr;
    if (N_LAUNCHES == 1) bar = xcd_barrier_post(ctl + CW_BAR, MISC + 8);
#define GRID_BAR() do { if (N_LAUNCHES == 1) xcd_barrier(bar); } while (0)
    const int lo = args.ph_lo, hi = args.ph_hi;
#ifndef PHASE_MASK
#define PHASE_MASK 0x3ff
#endif
#define IN(k) (((PHASE_MASK >> (k)) & 1) && lo <= (k) && (k) < hi)
#define BOTH(k) (IN(k) && IN((k) + 1))

    if (IN(0)) {
        LAS float* scr = (LAS float*)(lds + wave * 16384);
        constexpr int I_IN = 16 * 104, I_OUT = 16 * 32, I_WUP = 16, I_AUP = 16, I_GUP = 32;
        constexpr int NITEMS = I_IN + I_OUT + I_WUP + I_AUP + I_GUP;
        for (int it = gw; it < NITEMS; it += NGW) {
            int r = it;
            if (r < I_IN) { const int kb = r / 104, nb = r % 104; p0_transpose_item_g(args.in[1], 1024, IN_COLS, WIN_T, 32 * nb, scr, 64 * kb, 32 * nb, lane, args.in[16]); continue; } r -= I_IN;
            if (r < I_OUT) { const int kb = r / 32, nb = r % 32; p0_transpose_item(args.in[15], 1024, 1024, WOUT_T, 32 * nb, scr, 64 * kb, 32 * nb, lane); continue; } r -= I_OUT;
            if (r < I_WUP) { p0_transpose_item(args.in[6], 64, 512, WUP_T, 32 * r, scr, 0, 32 * r, lane); continue; } r -= I_WUP;
            if (r < I_AUP) { p0_transpose_item(args.in[8], 64, 512, AUP_T, 32 * r, scr, 0, 32 * r, lane); continue; } r -= I_AUP;
            { const int kb = r / 16, nb = r % 16; p0_transpose_item(args.in[9], 128, 512, GUP_T, 32 * nb, scr, 64 * kb, 32 * nb, lane); }
        }
        float* RMS = (float*)(ws + WS_RMS);
        for (int m = gw; m < M; m += NGW) {
            const GAS f32x4* xr = (const GAS f32x4*)(x + (size_t)m * D) + lane; f32x4 v[4]; float s = 0.f;
#pragma unroll
            for (int j = 0; j < 4; ++j) { v[j] = xr[64 * j]; s += (v[j].x * v[j].x + v[j].y * v[j].y) + (v[j].z * v[j].z + v[j].w * v[j].w); }
            const float ms = wave_sum(s) * (1.f / D) + NORM_EPS; const float rstd = 1.0f / sqrtf(ms);
            if (lane == 0) RMS[m] = sqrtf(ms);
            GAS unsigned long long* o8 = (GAS unsigned long long*)(XN + (size_t)m * D) + lane;
#pragma unroll
            for (int j = 0; j < 4; ++j)
                o8[64 * j] = (unsigned long long)pk2(v[j].x * rstd, v[j].y * rstd) | ((unsigned long long)pk2(v[j].z * rstd, v[j].w * rstd) << 32);
        }
        if (BOTH(0)) GRID_BAR();
    }

    if (IN(1)) {
        constexpr int P1_GEMM_WGS = 208;
        const bool split = (G == 256);
        if (!split || (int)blockIdx.x < P1_GEMM_WGS) {
            pg8::Gemm g{XN, WIN_T, M, IN_COLS, D, 0, 0, nullptr}; pg8::StaticOrder S; S.init(M, IN_COLS, split ? P1_GEMM_WGS : G, (int)blockIdx.x);
            pg8::EpiBiasBf16 E{P, IN_COLS, nullptr, 0};
            pg8::gemm_phase<pg8::EpiBiasBf16, pg8::StaticOrder, PG8_ALIGN, PG8_SP2>(lds, g, S, E);
        } else {
            moe_convert_items(args.in[22], args.in[20], (unsigned char*)WDN_T, (unsigned char*)WGU_T, (LAS float*)(lds + wave * 16384), ((int)blockIdx.x - P1_GEMM_WGS) * NWAVES + wave, MOE_P1_ITEMS, (G - P1_GEMM_WGS) * NWAVES, lane);
        }
        if (BOTH(1)) GRID_BAR();
    }

    if (IN(2)) {
        const float* mu = args.in[4]; const float* w0 = args.in[5]; const float* a0 = args.in[7]; const float* k_k = args.in[10]; const float* k_a = args.in[11]; const float* r_k = args.in[12];
        const float* conv_w = args.in[2]; const float* conv_g = args.in[3];
        v4u* QF = (v4u*)(ws + WS_QF); u32x2* O1F = (u32x2*)(ws + WS_O1); v4u* GF = (v4u*)(ws + WS_GF); v4u* HF = (v4u*)(ws + WS_HF); float* PCG = (float*)(ws + WS_PC);
        v4u* FRG = (v4u*)(ws + WS_FR);
#define PACK8(lo, hi) __builtin_bit_cast(pg8::bf16x8, (v4u){cvtpk_s((lo)[0], (lo)[1]), cvtpk_s((lo)[2], (lo)[3]), cvtpk_s((hi)[0], (hi)[1]), cvtpk_s((hi)[2], (hi)[3])})
#define MFMA16(a, b, c) __builtin_amdgcn_mfma_f32_16x16x32_bf16((a), (b), (c), 0, 0, 0)
        const f32x4 Z4 = (f32x4){0.f, 0.f, 0.f, 0.f};
        const int h = wave;
        {
            LAS float* cst0 = (LAS float*)(lds + 16896 + wave * 16128 + 12288);
            cst0[0 * 64 + lane] = mu[h * 64 + lane]; cst0[1 * 64 + lane] = mu[512 + h * 64 + lane]; cst0[2 * 64 + lane] = mu[1024 + h * 64 + lane]; cst0[3 * 64 + lane] = k_k[h * 64 + lane];
            cst0[4 * 64 + lane] = k_a[h * 64 + lane]; cst0[5 * 64 + lane] = a0[h * 64 + lane]; cst0[6 * 64 + lane] = w0[h * 64 + lane]; cst0[7 * 64 + lane] = r_k[h * 64 + lane];
            LDS_WAIT(); }
        for (int ck = vcu; ck < M / CHK; ck += G) {
            int tid_ = tid; asm volatile("" : "+v"(tid_)); const int lane_ = tid_ & 63;
            const int fr = lane_ & 15, fq = lane_ >> 4;
            LAS unsigned char* wl = lds + 16896 + wave * 16128;
            LAS bf16* TB = (LAS bf16*)wl;
            LAS float* Amat = (LAS float*)(wl + 5120);
            LAS bf16* Tm = (LAS bf16*)(wl + 9728);
            const LAS float* cst = (const LAS float*)(wl + 12288);
            const int T0 = ck * CHK; const int bb = T0 / SEQ, n = (T0 % SEQ) / CHK; const int chh = (bb * NH + h) * NCH + n;
            {
                const int c8 = (tid_ & 31) * 8, tr = tid_ >> 5;
                const f32x4 mu0 = *(const f32x4*)(mu + 1536 + c8), mu1 = *(const f32x4*)(mu + 1536 + c8 + 4);
                const float mm[8] = {mu0.x, mu0.y, mu0.z, mu0.w, mu1.x, mu1.y, mu1.z, mu1.w};
#pragma unroll
                for (int i = 0; i < 2; ++i) { const int tk = tr + 16 * i, t = T0 + tk;
                    const v4u cur = *(const v4u*)(P + (size_t)t * IN_COLS + 3072 + c8);
                    v4u prv = (v4u){0u, 0u, 0u, 0u}; if ((t % SEQ) != 0) prv = *(const v4u*)(P + (size_t)(t - 1) * IN_COLS + 3072 + c8);
                    const unsigned cw[4] = {cur.x, cur.y, cur.z, cur.w}, pw[4] = {prv.x, prv.y, prv.z, prv.w}; float f[8];
#pragma unroll
                    for (int j = 0; j < 4; ++j) { const float c0 = bf_lo(cw[j]), c1 = bf_hi(cw[j]), p0 = bf_lo(pw[j]), p1 = bf_hi(pw[j]);
                        const float q0 = c0 + (p0 - c0) * mm[2 * j], q1 = c1 + (p1 - c1) * mm[2 * j + 1];
                        f[2 * j] = (c8 < 64) ? fast_tanh(q0) : ((c8 < 128) ? q0 : fast_sigmoid(q0)); f[2 * j + 1] = (c8 < 64) ? fast_tanh(q1) : ((c8 < 128) ? q1 : fast_sigmoid(q1)); }
                    v4u o; o.x = pk2(f[0], f[1]); o.y = pk2(f[2], f[3]); o.z = pk2(f[4], f[5]); o.w = pk2(f[6], f[7]);
                    *(LAS v4u*)(lds + tk * 528 + c8 * 2) = o; }
            }
            __syncthreads();
#define TB_WRITE_T(X_, tt_) do { _Pragma("unroll") for (int m_ = 0; m_ < 4; ++m_) _Pragma("unroll") for (int j_ = 0; j_ < 4; ++j_) \
                TB[(16 * m_ + 4 * fq + j_) * 40 + 16 * (tt_) + fr] = (bf16)(cvtpk_s(X_[m_][j_], 0.f) & 0xffffu); } while (0)
#define TB_READ(fbase_) do { LDS_WAIT(); asm volatile("" ::: "memory"); _Pragma("unroll") for (int q_ = 0; q_ < 4; ++q_) { const u32x2 lo_ = *(const LAS u32x2*)(TB + (16 * q_ + fr) * 40 + 4 * fq), hi_ = *(const LAS u32x2*)(TB + (16 * q_ + fr) * 40 + 16 + 4 * fq); \
                frw[((fbase_) + q_) * 64] = (v4u){lo_.x, lo_.y, hi_.x, hi_.y}; } LDS_WAIT(); asm volatile("" ::: "memory"); } while (0)
#define UNPK(w_) ((f32x4){bf_lo((w_).x), bf_hi((w_).x), bf_lo((w_).y), bf_hi((w_).y)})
            const size_t prow0 = (size_t)T0 * IN_COLS + 1536 + h * 64 + 4 * fq;
            f32x4 ev[2][4]; u32x2 avp[2][4]; u32x2 kkp[2][4] = {}, b0p[2][4] = {}, kmp[2][4] = {};
#pragma unroll
            for (int m = 0; m < 4; ++m) { const int row = h * 64 + 16 * m + fr; const int cl = 16 * m + 4 * fq;
                pg8::bf16x8 ww[2], wa[2], wg[4];
#pragma unroll
                for (int ks = 0; ks < 2; ++ks) { ww[ks] = *(const pg8::bf16x8*)(WUP_T + row * 64 + ks * 32 + fq * 8); wa[ks] = *(const pg8::bf16x8*)(AUP_T + row * 64 + ks * 32 + fq * 8); }
#pragma unroll
                for (int ks = 0; ks < 4; ++ks) wg[ks] = *(const pg8::bf16x8*)(GUP_T + row * 128 + ks * 32 + fq * 8);
                const f32x4 a0v = *(const LAS f32x4*)(cst + 5 * 64 + cl), w0v = *(const LAS f32x4*)(cst + 6 * 64 + cl);
#pragma unroll
                for (int tt = 0; tt < 2; ++tt) { const LAS unsigned char* lrow = lds + (16 * tt + fr) * 528 + fq * 16; f32x4 aw = Z4, aa = Z4, ag = Z4;
#pragma unroll
                    for (int ks = 0; ks < 2; ++ks) { aw = MFMA16(ww[ks], *(const LAS pg8::bf16x8*)(lrow + ks * 64), aw); aa = MFMA16(wa[ks], *(const LAS pg8::bf16x8*)(lrow + (2 + ks) * 64), aa); }
#pragma unroll
                    for (int ks = 0; ks < 4; ++ks) ag = MFMA16(wg[ks], *(const LAS pg8::bf16x8*)(lrow + (4 + ks) * 64), ag);
                    f32x4 avv;
#pragma unroll
                    for (int j = 0; j < 4; ++j) { avv[j] = fast_sigmoid(a0v[j] + aa[j]); const float wlin = w0v[j] + aw[j];
                        const float sp = fmaxf(-wlin, 0.f) + 0.69314718056f * __builtin_amdgcn_logf(1.0f + __builtin_amdgcn_exp2f(-1.44269504089f * fabsf(wlin))); ev[tt][m][j] = __builtin_amdgcn_exp2f(-1.44269504089f * (sp + 0.5f)); }
                    avp[tt][m] = (u32x2){cvtpk_s(avv[0], avv[1]), cvtpk_s(avv[2], avv[3])};
                    u32x2 go; go.x = cvtpk_s(ag[0], ag[1]); go.y = cvtpk_s(ag[2], ag[3]); *(u32x2*)(SG + (size_t)(T0 + 16 * tt + fr) * RW + h * 64 + cl) = go; }
                __builtin_amdgcn_sched_barrier(0); }
#pragma unroll 1
            for (int tt = 0; tt < 2; ++tt) { u32x2 kkt[4], b0t[4], kmt[4]; int frl = fr, fql = fq; asm volatile("" : "+v"(frl), "+v"(fql)); const int PFR = frl; const int tk = 16 * tt + frl; const size_t tok = (size_t)(T0 + tk); const bool first = (tok % SEQ) == 0; const size_t prow = (size_t)T0 * IN_COLS + 1536 + h * 64 + 4 * fql + (size_t)tk * IN_COLS;
                f32x4 kq[4]; float ss = 0.f;
#pragma unroll
                for (int m = 0; m < 4; ++m) { const int cl = 16 * m + 4 * fql; const f32x4 muk = *(const LAS f32x4*)(cst + 1 * 64 + cl), kkv = *(const LAS f32x4*)(cst + 3 * 64 + cl);
                    const u32x2 cu = *(const u32x2*)(P + prow + 512 + 16 * m); u32x2 pu = (u32x2){0u, 0u}; if (!first && PFR == 0) pu = *(const u32x2*)(P + prow - IN_COLS + 512 + 16 * m); pu.x = (unsigned)__builtin_amdgcn_update_dpp((int)pu.x, (int)cu.x, 0x111, 0xf, 0xf, false); pu.y = (unsigned)__builtin_amdgcn_update_dpp((int)pu.y, (int)cu.y, 0x111, 0xf, 0xf, false);
                    const f32x4 cf = UNPK(cu), pf = UNPK(pu); kq[m] = cf + (pf - cf) * muk;
#pragma unroll
                    for (int j = 0; j < 4; ++j) { const float kr = kq[m][j] * kkv[j]; ss += kr * kr; } }
                ss += __shfl_xor(ss, 16); ss += __shfl_xor(ss, 32); const float inv = 1.0f / fmaxf(sqrtf(ss), 1e-12f);
#pragma unroll
                for (int m = 0; m < 4; ++m) { const int cl = 16 * m + 4 * fql; const f32x4 kkv = *(const LAS f32x4*)(cst + 3 * 64 + cl), kav = *(const LAS f32x4*)(cst + 4 * 64 + cl);
                    const u32x2 avq = (tt == 0) ? avp[0][m] : avp[1][m]; const f32x4 av = UNPK(avq);
                    const f32x4 kk = kq[m] * kkv * inv, bq = kk * av, kmv = kq[m] * (1.0f + (av - 1.0f) * kav);
                    kkt[m] = (u32x2){cvtpk_s(kk[0], kk[1]), cvtpk_s(kk[2], kk[3])}; b0t[m] = (u32x2){cvtpk_s(bq[0], bq[1]), cvtpk_s(bq[2], bq[3])}; kmt[m] = (u32x2){cvtpk_s(kmv[0], kmv[1]), cvtpk_s(kmv[2], kmv[3])}; }
#pragma unroll
                for (int m = 0; m < 4; ++m) { if (tt == 0) { kkp[0][m] = kkt[m]; b0p[0][m] = b0t[m]; kmp[0][m] = kmt[m]; } else { kkp[1][m] = kkt[m]; b0p[1][m] = b0t[m]; kmp[1][m] = kmt[m]; } }
                asm volatile("" ::: "memory"); __builtin_amdgcn_sched_barrier(0); }
            LAS float* pcl = (LAS float*)(wl + 14336);
#pragma unroll
            for (int m = 0; m < 4; ++m)
#pragma unroll
                for (int j = 0; j < 4; ++j) { float x0 = ev[0][m][j], x1 = ev[1][m][j];
#define DPP_SHR(v_, n_) __builtin_bit_cast(float, __builtin_amdgcn_update_dpp(0, __builtin_bit_cast(int, (v_)), 0x110 + (n_), 0xf, 0xf, false))
                    x0 += DPP_SHR(x0, 1); x1 += DPP_SHR(x1, 1); x0 += DPP_SHR(x0, 2); x1 += DPP_SHR(x1, 2); x0 += DPP_SHR(x0, 4); x1 += DPP_SHR(x1, 4); x0 += DPP_SHR(x0, 8); x1 += DPP_SHR(x1, 8);
                    const float tot0 = __shfl(x0, 15, 16); x1 += tot0; ev[0][m][j] = x0; ev[1][m][j] = x1; }
#define cum ev
            if (fr == 15) {
#pragma unroll
                for (int m = 0; m < 4; ++m) { *(LAS f32x4*)(pcl + 16 * m + 4 * fq) = cum[1][m]; f32x4 pcv;
#pragma unroll
                    for (int j = 0; j < 4; ++j) pcv[j] = __expf(-cum[1][m][j]);
                    *(f32x4*)(PCG + (size_t)chh * 64 + 16 * m + 4 * fq) = pcv; } }
            LDS_WAIT(); asm volatile("" ::: "memory");
            v4u* frw = FRG + (size_t)gw * 32 * 64 + lane_;
#define FR_ST(f_, val_) (frw[(f_) * 64] = __builtin_bit_cast(v4u, (val_)))
            {
                f32x4 em0[4];
#pragma unroll
                for (int tt = 0; tt < 2; ++tt) { f32x4 x1[4];
#pragma unroll
                    for (int m = 0; m < 4; ++m) { const f32x4 kk = UNPK(kkp[tt][m]);
#pragma unroll
                        for (int j = 0; j < 4; ++j) { const float em = __expf(-cum[tt][m][j]); float pv = DPP_SHR(em, 1);
                            if (tt == 0) { em0[m][j] = em; if (fr == 0) pv = 1.0f; } else { const float last0 = __shfl(em0[m][j], 15, 16); if (fr == 0) pv = last0; }
                            x1[m][j] = -kk[j] * pv; } }
#pragma unroll
                    for (int ks = 0; ks < 2; ++ks) FR_ST(0 + 2 * tt + ks, PACK8(x1[2 * ks], x1[2 * ks + 1]));
                    TB_WRITE_T(x1, tt); }
            }
            TB_READ(16);
#pragma unroll
            for (int tt = 0; tt < 2; ++tt) {
                f32x4 x1[4], x2[4];
#pragma unroll
                for (int m = 0; m < 4; ++m) { const f32x4 bq = UNPK(b0p[tt][m]); const f32x4 cC = *(const LAS f32x4*)(pcl + 16 * m + 4 * fq);
#pragma unroll
                    for (int j = 0; j < 4; ++j) { x1[m][j] = bq[j] * __expf(cum[tt][m][j] - cC[j]); x2[m][j] = bq[j] * __expf(cum[tt][m][j]); } }
#pragma unroll
                for (int ks = 0; ks < 2; ++ks) FR_ST(4 + 2 * tt + ks, PACK8(x2[2 * ks], x2[2 * ks + 1]));
                TB_WRITE_T(x1, tt); }
            TB_READ(20);
#pragma unroll
            for (int tt = 0; tt < 2; ++tt) {
                f32x4 x1[4], x2[4];
#pragma unroll
                for (int m = 0; m < 4; ++m) { const f32x4 kmv = UNPK(kmp[tt][m]); const f32x4 cC = *(const LAS f32x4*)(pcl + 16 * m + 4 * fq);
#pragma unroll
                    for (int j = 0; j < 4; ++j) { x1[m][j] = kmv[j] * __expf(cum[tt][m][j] - cC[j]); x2[m][j] = kmv[j] * __expf(cum[tt][m][j]); } }
#pragma unroll
                for (int ks = 0; ks < 2; ++ks) FR_ST(8 + 2 * tt + ks, PACK8(x2[2 * ks], x2[2 * ks + 1]));
                TB_WRITE_T(x1, tt); }
            TB_READ(24);
#pragma unroll
            for (int tt = 0; tt < 2; ++tt) {
                f32x4 x1[4]; const int PFR = fr; const int tk = 16 * tt + fr; const bool first = ((T0 + tk) % SEQ) == 0; const size_t prow = prow0 + (size_t)tk * IN_COLS; float bd = 0.f;
#pragma unroll
                for (int m = 0; m < 4; ++m) { const int c = h * 64 + 16 * m + 4 * fq; const f32x4 mur = *(const LAS f32x4*)(cst + 0 * 64 + 16 * m + 4 * fq), rkv = *(const LAS f32x4*)(cst + 7 * 64 + 16 * m + 4 * fq);
                    const u32x2 cu = *(const u32x2*)(P + prow + 16 * m); u32x2 pu = (u32x2){0u, 0u}; if (!first && PFR == 0) pu = *(const u32x2*)(P + prow - IN_COLS + 16 * m); pu.x = (unsigned)__builtin_amdgcn_update_dpp((int)pu.x, (int)cu.x, 0x111, 0xf, 0xf, false); pu.y = (unsigned)__builtin_amdgcn_update_dpp((int)pu.y, (int)cu.y, 0x111, 0xf, 0xf, false);
                    const f32x4 cf = UNPK(cu), pf = UNPK(pu); const f32x4 rq = cf + (pf - cf) * mur; const f32x4 pr = rq * UNPK(kmp[tt][m]) * rkv; bd += (pr.x + pr.y) + (pr.z + pr.w);
#pragma unroll
                    for (int j = 0; j < 4; ++j) x1[m][j] = rq[j] * __expf(-cum[tt][m][j]); }
                bd += __shfl_xor(bd, 16); bd += __shfl_xor(bd, 32);
                if (fq == 0) BDOT[(size_t)(T0 + tk) * NH + h] = bd;
#pragma unroll
                for (int ks = 0; ks < 2; ++ks) FR_ST(12 + 2 * tt + ks, PACK8(x1[2 * ks], x1[2 * ks + 1])); }
#pragma unroll
            for (int tt = 0; tt < 2; ++tt) {
                f32x4 x1[4]; const int PFR = fr; const int tk = 16 * tt + fr; const bool first = ((T0 + tk) % SEQ) == 0; const size_t prow = prow0 + (size_t)tk * IN_COLS;
#pragma unroll
                for (int m = 0; m < 4; ++m) { const int c = h * 64 + 16 * m + 4 * fq; const f32x4 muv = *(const LAS f32x4*)(cst + 2 * 64 + 16 * m + 4 * fq);
                    const u32x2 cu = *(const u32x2*)(P + prow + 1024 + 16 * m); u32x2 pu = (u32x2){0u, 0u}; if (!first && PFR == 0) pu = *(const u32x2*)(P + prow - IN_COLS + 1024 + 16 * m); pu.x = (unsigned)__builtin_amdgcn_update_dpp((int)pu.x, (int)cu.x, 0x111, 0xf, 0xf, false); pu.y = (unsigned)__builtin_amdgcn_update_dpp((int)pu.y, (int)cu.y, 0x111, 0xf, 0xf, false);
                    const f32x4 cf = UNPK(cu), pf = UNPK(pu); x1[m] = cf + (pf - cf) * muv; }
                TB_WRITE_T(x1, tt); }
            TB_READ(28);
            asm volatile("s_waitcnt vmcnt(0)" ::: "memory");
#define FR_LD(f_) __builtin_bit_cast(pg8::bf16x8, __builtin_nontemporal_load(frw + (f_) * 64))
            pg8::bf16x8 Aak[2], Arb[2], Ark[2], Rt[2][2];
            {
                pg8::bf16x8 At[2][2], Bt[2][2], Kt[2][2];
#pragma unroll
                for (int tt = 0; tt < 2; ++tt)
#pragma unroll
                    for (int ks = 0; ks < 2; ++ks) { At[tt][ks] = FR_LD(0 + 2 * tt + ks); Bt[tt][ks] = FR_LD(4 + 2 * tt + ks); Kt[tt][ks] = FR_LD(8 + 2 * tt + ks); Rt[tt][ks] = FR_LD(12 + 2 * tt + ks); }
                f32x4 Dab[2][2], Dak[2][2], Drb[2][2], Drk[2][2];
#pragma unroll
                for (int jt = 0; jt < 2; ++jt)
#pragma unroll
                    for (int tt = 0; tt < 2; ++tt) { Dab[jt][tt] = Z4; Dak[jt][tt] = Z4; Drb[jt][tt] = Z4; Drk[jt][tt] = Z4;
#pragma unroll
                        for (int ks = 0; ks < 2; ++ks) { Dab[jt][tt] = MFMA16(Bt[jt][ks], At[tt][ks], Dab[jt][tt]); Dak[jt][tt] = MFMA16(Kt[jt][ks], At[tt][ks], Dak[jt][tt]);
                            Drb[jt][tt] = MFMA16(Bt[jt][ks], Rt[tt][ks], Drb[jt][tt]); Drk[jt][tt] = MFMA16(Kt[jt][ks], Rt[tt][ks], Drk[jt][tt]); }
#pragma unroll
                        for (int jj = 0; jj < 4; ++jj) { const int j = 16 * jt + 4 * fq + jj, t = 16 * tt + fr;
                            if (!(j < t)) { Dab[jt][tt][jj] = 0.f; Dak[jt][tt][jj] = 0.f; }
                            if (!(j <= t)) { Drb[jt][tt][jj] = 0.f; Drk[jt][tt][jj] = 0.f; } }
                        *(LAS f32x4*)(Amat + (16 * tt + fr) * 36 + 16 * jt + 4 * fq) = Dab[jt][tt]; }
#pragma unroll
                for (int tt = 0; tt < 2; ++tt) { Aak[tt] = PACK8(Dak[0][tt], Dak[1][tt]); Arb[tt] = PACK8(Drb[0][tt], Drb[1][tt]); Ark[tt] = PACK8(Drk[0][tt], Drk[1][tt]); }
            }
            LDS_WAIT(); asm volatile("" ::: "memory");
            {
                const int col = lane_ & 31; float xs[32];
#pragma unroll
                for (int t = 0; t < 32; ++t) { float s0 = (t == col) ? 1.0f : 0.0f, s1 = 0.f;
#pragma unroll
                    for (int j4 = 0; j4 < (t + 3) / 4; ++j4) { const f32x4 a4 = *(const LAS f32x4*)(Amat + t * 36 + 4 * j4);
                        if (4 * j4 + 0 < t) s0 += a4[0] * xs[4 * j4 + 0]; if (4 * j4 + 1 < t) s1 += a4[1] * xs[4 * j4 + 1];
                        if (4 * j4 + 2 < t) s0 += a4[2] * xs[4 * j4 + 2]; if (4 * j4 + 3 < t) s1 += a4[3] * xs[4 * j4 + 3]; }
                    xs[t] = s0 + s1; }
                if (lane_ < 32) {
#pragma unroll
                    for (int t = 0; t < 32; ++t) Tm[t * 40 + col] = (bf16)f2bf(xs[t]); }
            }
            LDS_WAIT(); asm volatile("" ::: "memory");
            pg8::bf16x8 Tf[2];
#pragma unroll
            for (int tt = 0; tt < 2; ++tt) { const u32x2 lo = *(const LAS u32x2*)(Tm + (16 * tt + fr) * 40 + 4 * fq), hi = *(const LAS u32x2*)(Tm + (16 * tt + fr) * 40 + 16 + 4 * fq);
                Tf[tt] = __builtin_bit_cast(pg8::bf16x8, (v4u){lo.x, lo.y, hi.x, hi.y}); }
            pg8::bf16x8 Wp[4], U0p[4], Vf[4];
#pragma unroll
            for (int q = 0; q < 4; ++q) Vf[q] = FR_LD(28 + q);
            {
                pg8::bf16x8 Y2p[4], Af[4];
#pragma unroll
                for (int q = 0; q < 4; ++q) Af[q] = FR_LD(16 + q);
#pragma unroll
                for (int vt = 0; vt < 4; ++vt) { const f32x4 y0 = MFMA16(Aak[0], Vf[vt], Z4), y1 = MFMA16(Aak[1], Vf[vt], Z4); Y2p[vt] = PACK8(y0, y1); }
#pragma unroll
                for (int q = 0; q < 4; ++q) { const f32x4 wa = MFMA16(Tf[0], Af[q], Z4), wb = MFMA16(Tf[1], Af[q], Z4); Wp[q] = PACK8(wa, wb);
                    const f32x4 u0 = MFMA16(Tf[0], Y2p[q], Z4), u1 = MFMA16(Tf[1], Y2p[q], Z4); U0p[q] = PACK8(u0, u1); }
            }
#pragma unroll
            for (int tt = 0; tt < 2; ++tt) {
                f32x4 qt[4];
#pragma unroll
                for (int ct = 0; ct < 4; ++ct) { const v4u rw = __builtin_bit_cast(v4u, Rt[tt][ct >> 1]); const unsigned r0 = (ct & 1) ? rw.z : rw.x, r1 = (ct & 1) ? rw.w : rw.y;
                    qt[ct] = MFMA16(Wp[ct], Arb[tt], ((f32x4){bf_lo(r0), bf_hi(r0), bf_lo(r1), bf_hi(r1)})); }
#pragma unroll
                for (int ks = 0; ks < 2; ++ks) __builtin_nontemporal_store(__builtin_bit_cast(v4u, PACK8(qt[2 * ks], qt[2 * ks + 1])), QF + (((size_t)chh * 2 + tt) * 2 + ks) * 64 + lane_);
#pragma unroll
                for (int vt = 0; vt < 4; ++vt) { f32x4 o = MFMA16(U0p[vt], Arb[tt], Z4); o = MFMA16(Vf[vt], Ark[tt], o);
                    u32x2 w; w.x = cvtpk_s(o[0], o[1]); w.y = cvtpk_s(o[2], o[3]); __builtin_nontemporal_store(w, O1F + (((size_t)chh * 4 + vt) * 2 + tt) * 64 + lane_); } }
            pg8::bf16x8 Bh[4], Kh[4];
#pragma unroll
            for (int q = 0; q < 4; ++q) { Bh[q] = FR_LD(20 + q); Kh[q] = FR_LD(24 + q); }
#pragma unroll
            for (int m = 0; m < 4; ++m) { f32x4 gt[4];
#pragma unroll
                for (int ct = 0; ct < 4; ++ct) gt[ct] = MFMA16(Wp[ct], Bh[m], Z4);
#pragma unroll
                for (int ks = 0; ks < 2; ++ks) __builtin_nontemporal_store(__builtin_bit_cast(v4u, PACK8(gt[2 * ks], gt[2 * ks + 1])), GF + (((size_t)chh * 4 + m) * 2 + ks) * 64 + lane_); }
#pragma unroll
            for (int mp = 0; mp < 2; ++mp)
#pragma unroll
                for (int vt = 0; vt < 4; ++vt) { f32x4 ha = MFMA16(Bh[2 * mp], U0p[vt], Z4); ha = MFMA16(Kh[2 * mp], Vf[vt], ha); f32x4 hb2 = MFMA16(Bh[2 * mp + 1], U0p[vt], Z4); hb2 = MFMA16(Kh[2 * mp + 1], Vf[vt], hb2);
                    __builtin_nontemporal_store(__builtin_bit_cast(v4u, PACK8(ha, hb2)), HF + (((size_t)chh * 4 + vt) * 2 + mp) * 64 + lane_); }
            {
                const int t0 = T0 + wave * 4, tb0 = t0 % SEQ; const int c8 = lane_ * 8;
                v4u ur[6], cr[6], br[4];
#pragma unroll
                for (int d = 0; d < 6; ++d) { const bool ok = (tb0 + d - 2) >= 0; const size_t ro = (size_t)(t0 + d - 2) * IN_COLS;
                    ur[d] = (v4u){0u, 0u, 0u, 0u}; cr[d] = ur[d]; if (ok) { ur[d] = *(const v4u*)(P + ro + c8); cr[d] = *(const v4u*)(P + ro + 1024 + c8); } }
#pragma unroll
                for (int i = 0; i < 4; ++i) br[i] = *(const v4u*)(P + (size_t)(t0 + i) * IN_COLS + 512 + c8);
                float cw0[8], cw1[8], cw2[8], cg[8];
#pragma unroll
                for (int j = 0; j < 8; ++j) { cw0[j] = conv_w[c8 + j]; cw1[j] = conv_w[512 + c8 + j]; cw2[j] = conv_w[1024 + c8 + j]; cg[j] = conv_g[c8 + j]; }
                float z[6][8];
#pragma unroll
                for (int d = 0; d < 6; ++d) { const unsigned uw[4] = {ur[d].x, ur[d].y, ur[d].z, ur[d].w}, cw[4] = {cr[d].x, cr[d].y, cr[d].z, cr[d].w};
#pragma unroll
                    for (int j = 0; j < 4; ++j) { z[d][2 * j] = bf_lo(uw[j]) * bf_lo(cw[j]); z[d][2 * j + 1] = bf_hi(uw[j]) * bf_hi(cw[j]); } }
#pragma unroll
                for (int i = 0; i < 4; ++i) { const unsigned bw[4] = {br[i].x, br[i].y, br[i].z, br[i].w}; float yv[8], ss = 0.f;
#pragma unroll
                    for (int j = 0; j < 8; ++j) { const float bg = (j & 1) ? bf_hi(bw[j >> 1]) : bf_lo(bw[j >> 1]); const float cv = cw0[j] * z[i][j] + cw1[j] * z[i + 1][j] + cw2[j] * z[i + 2][j]; yv[j] = bg * cv; ss += yv[j] * yv[j]; }
                    ss += __shfl_xor(ss, 1); ss += __shfl_xor(ss, 2); ss += __shfl_xor(ss, 4);
                    const float rs = 1.0f / sqrtf(ss * (1.0f / 64.0f) + NORM_EPS);
                    v4u o; o.x = pk2(yv[0] * rs * cg[0], yv[1] * rs * cg[1]); o.y = pk2(yv[2] * rs * cg[2], yv[3] * rs * cg[3]); o.z = pk2(yv[4] * rs * cg[4], yv[5] * rs * cg[5]); o.w = pk2(yv[6] * rs * cg[6], yv[7] * rs * cg[7]);
                    *(v4u*)(Y + (size_t)(t0 + i) * D + c8) = o; }
            }
            LDS_WAIT();
            __syncthreads();
        }
#undef TB_WRITE_T
#undef DPP_SHR
#undef FR_ST
#undef FR_LD
#undef cum
#undef TB_READ
#undef UNPK
#undef PACK8
#undef MFMA16
        if (BOTH(2)) GRID_BAR();
    }

#define PACK8(lo, hi) __builtin_bit_cast(pg8::bf16x8, (v4u){cvtpk_s((lo)[0], (lo)[1]), cvtpk_s((lo)[2], (lo)[3]), cvtpk_s((hi)[0], (hi)[1]), cvtpk_s((hi)[2], (hi)[3])})
#define MFMA16(a, b, c) __builtin_amdgcn_mfma_f32_16x16x32_bf16((a), (b), (c), 0, 0, 0)
    if (IN(3)) {
        constexpr int RSLOT = 10752, RING_R = 15, RING_D = 13, NSCAN = BATCH * NH * 4;
        static_assert(RSLOT * RING_R <= LDSCTL_OFF && NCH % 2 == 0, "scan ring fits");
        if ((int)blockIdx.x < NSCAN) {
            const int fr = lane & 15, fq = lane >> 4; const int bxs = (int)blockIdx.x; const int vt = (bxs >> 3) & 3, bh = (bxs & 7) + 8 * (bxs >> 5); const bool ldr = wave < 4, act = wave == 0;
            const v4u* GF = (const v4u*)(ws + WS_GF); const v4u* HF = (const v4u*)(ws + WS_HF); const float* PCG = (const float*)(ws + WS_PC); v4u* SF = (v4u*)(ws + WS_SF);
            const int ch0 = bh * NCH;
            f32x4 acc[4];
#pragma unroll
            for (int m = 0; m < 4; ++m) acc[m] = (f32x4){0.f, 0.f, 0.f, 0.f};
#define P3B_ISSUE(step_) do { const int cn_ = ch0 + ((step_) < NCH ? (step_) : NCH - 1); LAS unsigned char* sl_ = lds + ((step_) % RING_R) * RSLOT; \
                __builtin_amdgcn_global_load_lds((const unsigned*)(GF + (((size_t)cn_ * 4 + wave) * 2 + 0) * 64 + lane), (LAS unsigned*)(sl_ + (wave * 2 + 0) * 1024), 16, 0, 0); \
                __builtin_amdgcn_global_load_lds((const unsigned*)(GF + (((size_t)cn_ * 4 + wave) * 2 + 1) * 64 + lane), (LAS unsigned*)(sl_ + (wave * 2 + 1) * 1024), 16, 0, 0); \
                if (wave == 1) { __builtin_amdgcn_global_load_lds((const unsigned*)(HF + (((size_t)cn_ * 4 + vt) * 2 + 0) * 64 + lane), (LAS unsigned*)(sl_ + 8192), 16, 0, 0); \
                                 __builtin_amdgcn_global_load_lds((const unsigned*)(HF + (((size_t)cn_ * 4 + vt) * 2 + 1) * 64 + lane), (LAS unsigned*)(sl_ + 9216), 16, 0, 0); } \
                if (wave == 2) __builtin_amdgcn_global_load_lds((const unsigned*)(PCG + (size_t)cn_ * 64 + lane), (LAS unsigned*)(sl_ + 10240), 4, 0, 0); } while (0)
#define P3B_READ(G_, H_, P_, step_) do { const LAS unsigned char* sl_ = lds + ((step_) % RING_R) * RSLOT; _Pragma("unroll") for (int m = 0; m < 4; ++m) { \
                G_[m][0] = *(const LAS pg8::bf16x8*)(sl_ + (m * 2 + 0) * 1024 + lane * 16); G_[m][1] = *(const LAS pg8::bf16x8*)(sl_ + (m * 2 + 1) * 1024 + lane * 16); \
                P_[m] = *(const LAS f32x4*)(sl_ + 10240 + (16 * m + 4 * fq) * 4); } \
                H_[0] = *(const LAS pg8::bf16x8*)(sl_ + 8192 + lane * 16); H_[1] = *(const LAS pg8::bf16x8*)(sl_ + 9216 + lane * 16); } while (0)
#define P3B_STEP(G_, H_, P_, n_) do { pg8::bf16x8 sb_[2]; _Pragma("unroll") for (int ks = 0; ks < 2; ++ks) { sb_[ks] = PACK8(acc[2 * ks], acc[2 * ks + 1]); SF[(((size_t)(ch0 + (n_)) * 4 + vt) * 2 + ks) * 64 + lane] = __builtin_bit_cast(v4u, sb_[ks]); } \
                _Pragma("unroll") for (int m = 0; m < 4; ++m) { const v4u hw_ = __builtin_bit_cast(v4u, H_[m >> 1]); const unsigned h0w_ = (m & 1) ? hw_.z : hw_.x, h1w_ = (m & 1) ? hw_.w : hw_.y; \
                    f32x4 nw_ = P_[m] * acc[m] + (f32x4){bf_lo(h0w_), bf_hi(h0w_), bf_lo(h1w_), bf_hi(h1w_)}; \
                    nw_ = MFMA16(G_[m][0], sb_[0], nw_); nw_ = MFMA16(G_[m][1], sb_[1], nw_); acc[m] = nw_; } } while (0)
            if (ldr) {
#pragma unroll 1
                for (int s0 = 0; s0 < RING_D; ++s0) P3B_ISSUE(s0);
            }
            for (int n = 0; n < NCH; n += 2) {
                if (wave == 1) asm volatile("s_waitcnt vmcnt(44)" ::: "memory"); else if (wave == 2) asm volatile("s_waitcnt vmcnt(33)" ::: "memory"); else if (ldr) asm volatile("s_waitcnt vmcnt(22)" ::: "memory");
                __builtin_amdgcn_s_barrier(); asm volatile("" ::: "memory");
                if (act) {
                    pg8::bf16x8 gA[4][2], hA[2], gB[4][2], hB[2]; f32x4 pA[4], pB[4];
                    P3B_READ(gA, hA, pA, n); P3B_READ(gB, hB, pB, n + 1);
                    asm volatile("s_waitcnt lgkmcnt(0)" ::: "memory"); __builtin_amdgcn_sched_barrier(0);
                    P3B_STEP(gA, hA, pA, n);
                    P3B_STEP(gB, hB, pB, n + 1);
                }
                if (ldr) { P3B_ISSUE(n + RING_D); P3B_ISSUE(n + RING_D + 1); }
            }
            if (ldr) asm volatile("s_waitcnt vmcnt(0)" ::: "memory");
            __builtin_amdgcn_s_barrier(); asm volatile("" ::: "memory");
#undef P3B_READ
#undef P3B_STEP
#undef P3B_ISSUE
        }
        {
            LAS float* scr = (LAS float*)(lds + wave * 16384);
            const int p1i = (G == 256) ? MOE_P1_ITEMS : 0; const int NSPLIT = p1i + (int)((MOE_NIT - p1i) * 0.74f);
            const bool scanwg = (int)blockIdx.x < NSCAN && G > NSCAN;
            const int nw = scanwg ? NSCAN * NWAVES : (G > NSCAN ? (G - NSCAN) * NWAVES : G * NWAVES);
            const int widx = scanwg ? NSPLIT + (int)blockIdx.x * NWAVES + wave : p1i + (G > NSCAN ? ((int)blockIdx.x - NSCAN) * NWAVES + wave : gw);
            const int ilim = scanwg ? MOE_NIT : (G > NSCAN ? NSPLIT : MOE_NIT);
            moe_convert_items(args.in[22], args.in[20], (unsigned char*)WDN_T, (unsigned char*)WGU_T, scr, widx, ilim, nw, lane);
        }
        if (BOTH(3)) GRID_BAR();
    }

    if (IN(4)) {
        const int fr = lane & 15, fq = lane >> 4;
        const v4u* QF = (const v4u*)(ws + WS_QF); const u32x2* O1F = (const u32x2*)(ws + WS_O1); const v4u* SF = (const v4u*)(ws + WS_SF);
        const float* gnw = args.in[13]; const float* gnb = args.in[14];
        for (int chh = gw; chh < NCHH; chh += NGW) {
            const int n = chh & (NCH - 1), bh = chh >> 8, b = bh >> 3, h = bh & 7;
            const size_t tok0 = (size_t)b * SEQ + (size_t)n * CHK;
            pg8::bf16x8 Sf[4][2], Qf[2][2];
#pragma unroll
            for (int vt = 0; vt < 4; ++vt)
#pragma unroll
                for (int ks = 0; ks < 2; ++ks) Sf[vt][ks] = __builtin_bit_cast(pg8::bf16x8, SF[(((size_t)chh * 4 + vt) * 2 + ks) * 64 + lane]);
#pragma unroll
            for (int tt = 0; tt < 2; ++tt)
#pragma unroll
                for (int ks = 0; ks < 2; ++ks) Qf[tt][ks] = __builtin_bit_cast(pg8::bf16x8, QF[(((size_t)chh * 2 + tt) * 2 + ks) * 64 + lane]);
#pragma unroll
            for (int tt = 0; tt < 2; ++tt) { const size_t tok = tok0 + 16 * tt + fr;
                f32x4 o[4]; float s = 0.f;
#pragma unroll
                for (int vt = 0; vt < 4; ++vt) { const u32x2 w = O1F[(((size_t)chh * 4 + vt) * 2 + tt) * 64 + lane]; o[vt] = (f32x4){bf_lo(w.x), bf_hi(w.x), bf_lo(w.y), bf_hi(w.y)};
                    o[vt] = MFMA16(Sf[vt][0], Qf[tt][0], o[vt]); o[vt] = MFMA16(Sf[vt][1], Qf[tt][1], o[vt]); s += (o[vt][0] + o[vt][1]) + (o[vt][2] + o[vt][3]); }
                s += __shfl_xor(s, 16); s += __shfl_xor(s, 32);
                const float mean = s * (1.0f / 64.0f); float q = 0.f;
#pragma unroll
                for (int vt = 0; vt < 4; ++vt) { o[vt] = o[vt] - mean; q += (o[vt][0] * o[vt][0] + o[vt][1] * o[vt][1]) + (o[vt][2] * o[vt][2] + o[vt][3] * o[vt][3]); }
                q += __shfl_xor(q, 16); q += __shfl_xor(q, 32);
                const float rs = 1.0f / sqrtf(q * (1.0f / 64.0f) + GN_EPS); const float bd = BDOT[tok * NH + h];
#pragma unroll
                for (int vt = 0; vt < 4; ++vt) { const int c = h * 64 + 16 * vt + 4 * fq; const f32x4 gw4 = *(const f32x4*)(gnw + c), gb4 = *(const f32x4*)(gnb + c), vv = ({ const u32x2 cu_ = *(const u32x2*)(P + tok * IN_COLS + 2560 + c); u32x2 pu_ = (u32x2){0u, 0u}; if (fr == 0 && (tok % SEQ) != 0) pu_ = *(const u32x2*)(P + (tok - 1) * IN_COLS + 2560 + c);
                        pu_.x = (unsigned)__builtin_amdgcn_update_dpp((int)pu_.x, (int)cu_.x, 0x111, 0xf, 0xf, false); pu_.y = (unsigned)__builtin_amdgcn_update_dpp((int)pu_.y, (int)cu_.y, 0x111, 0xf, 0xf, false);
                        const f32x4 cf_ = (f32x4){bf_lo(cu_.x), bf_hi(cu_.x), bf_lo(cu_.y), bf_hi(cu_.y)}, pf_ = (f32x4){bf_lo(pu_.x), bf_hi(pu_.x), bf_lo(pu_.y), bf_hi(pu_.y)}; const f32x4 mv_ = *(const f32x4*)(args.in[4] + 1024 + c); cf_ + (pf_ - cf_) * mv_; });
                    const u32x2 gg = *(const u32x2*)(SG + tok * RW + c); const f32x4 g4 = (f32x4){bf_lo(gg.x), bf_hi(gg.x), bf_lo(gg.y), bf_hi(gg.y)};
                    const f32x4 yv = (o[vt] * rs * gw4 + gb4 + bd * vv) * g4;
                    u32x2 w; w.x = cvtpk_s(yv[0], yv[1]); w.y = cvtpk_s(yv[2], yv[3]); *(u32x2*)(Y + tok * D + 512 + c) = w; } }
        }
#undef PACK8
#undef MFMA16
        if (BOTH(4)) GRID_BAR();
    }

    if (IN(5)) {
        pg8::Gemm g{Y, WOUT_T, M, D, D, 0, 0, nullptr}; pg8::StaticOrder S; S.init(M, D, G, (int)blockIdx.x);
        pg8::EpiResXn E{(const pg8::bf16_t*)XN, (const float*)(ws + WS_RMS), (pg8::bf16_t*)X1, D};
        pg8::gemm_phase<pg8::EpiResXn, pg8::StaticOrder, PG8_ALIGN, PG8_SP2>(lds, g, S, E);
        if (BOTH(5)) GRID_BAR();
    }

    if (IN(6)) {
        const float* gf = args.in[17]; const float* wr = args.in[18]; const float* br = args.in[19]; int* LISTG = (int*)(ws + WS_LIST);
        constexpr int WRS2 = 1032;
        LAS unsigned short* wH = (LAS unsigned short*)lds;
        LAS unsigned short* wL = wH + 32 * WRS2;
#pragma unroll
        for (int q = 0; q < 8; ++q) { const int i4 = tid + q * NWAVES * 64, kp = i4 >> 3, e0 = (i4 & 7) * 4;
            const f32x4 wa = *(const f32x4*)(wr + (2 * kp) * 32 + e0), wb = *(const f32x4*)(wr + (2 * kp + 1) * 32 + e0); const float ga = gf[2 * kp], gb = gf[2 * kp + 1];
#pragma unroll
            for (int j = 0; j < 4; ++j) { const float va = wa[j] * ga, vb = wb[j] * gb; const unsigned ha = f2bf(va), hb = f2bf(vb);
                const unsigned la = f2bf(va - __uint_as_float(ha << 16)), lb = f2bf(vb - __uint_as_float(hb << 16));
                ((LAS unsigned*)(wH + (e0 + j) * WRS2))[kp] = ha | (hb << 16); ((LAS unsigned*)(wL + (e0 + j) * WRS2))[kp] = la | (lb << 16); } }
        __syncthreads();
        const int fr = lane & 15, fq = lane >> 4;
        LAS unsigned* lcnt = (LAS unsigned*)(lds + 2 * 32 * WRS2 * 2);
        for (int it = 0; it < (M / 16 + NGW - 1) / NGW; ++it) {
            int tile = gw + it * NGW; const bool live = tile < M / 16; if (!live) tile = M / 16 - 1;
            if (tid < 64) lcnt[tid] = 0u;
            __syncthreads();
            const int t = tile * 16 + fr;
            const bf16* xrow = X1 + (size_t)t * D + 8 * fq;
            const LAS unsigned short* h0p = wH + fr * WRS2 + 8 * fq; const LAS unsigned short* h1p = wH + (16 + fr) * WRS2 + 8 * fq;
            const LAS unsigned short* l0p = wL + fr * WRS2 + 8 * fq; const LAS unsigned short* l1p = wL + (16 + fr) * WRS2 + 8 * fq;
            f32x4 acc0 = (f32x4){0.f, 0.f, 0.f, 0.f}, acc1 = acc0; float ss = 0.f;
#pragma unroll 4
            for (int sp = 0; sp < 32; ++sp) {
                const pg8::u32x4 xw = *(const pg8::u32x4*)(xrow + 32 * sp); const pg8::bf16x8 xb = __builtin_bit_cast(pg8::bf16x8, xw);
                const pg8::bf16x8 h0 = *(const LAS pg8::bf16x8*)(h0p + 32 * sp), h1 = *(const LAS pg8::bf16x8*)(h1p + 32 * sp), l0 = *(const LAS pg8::bf16x8*)(l0p + 32 * sp), l1 = *(const LAS pg8::bf16x8*)(l1p + 32 * sp);
                const f32x4 x0 = (f32x4){__uint_as_float(xw.x << 16), __uint_as_float(xw.x & 0xffff0000u), __uint_as_float(xw.y << 16), __uint_as_float(xw.y & 0xffff0000u)};
                const f32x4 x1 = (f32x4){__uint_as_float(xw.z << 16), __uint_as_float(xw.z & 0xffff0000u), __uint_as_float(xw.w << 16), __uint_as_float(xw.w & 0xffff0000u)};
                ss += ((x0[0] * x0[0] + x0[1] * x0[1]) + (x0[2] * x0[2] + x0[3] * x0[3])) + ((x1[0] * x1[0] + x1[1] * x1[1]) + (x1[2] * x1[2] + x1[3] * x1[3]));
                acc0 = __builtin_amdgcn_mfma_f32_16x16x32_bf16(l0, xb, acc0, 0, 0, 0); acc1 = __builtin_amdgcn_mfma_f32_16x16x32_bf16(l1, xb, acc1, 0, 0, 0);
                acc0 = __builtin_amdgcn_mfma_f32_16x16x32_bf16(h0, xb, acc0, 0, 0, 0); acc1 = __builtin_amdgcn_mfma_f32_16x16x32_bf16(h1, xb, acc1, 0, 0, 0);
            }
            ss += __shfl_xor(ss, 16); ss += __shfl_xor(ss, 32);
            const float rstd = 1.0f / sqrtf(ss * (1.f / D) + NORM_EPS);
            float lg[8]; const f32x4 b0 = *(const f32x4*)(br + 4 * fq), b1 = *(const f32x4*)(br + 16 + 4 * fq);
#pragma unroll
            for (int j = 0; j < 4; ++j) { lg[j] = acc0[j] * rstd + b0[j]; lg[4 + j] = acc1[j] * rstd + b1[j]; }
            int te[4]; float tv[4];
#pragma unroll
            for (int r = 0; r < 4; ++r) { float bv = lg[0]; int bi = 4 * fq;
#pragma unroll
                for (int j = 1; j < 8; ++j) { const int ei = (j < 4) ? 4 * fq + j : 16 + 4 * fq + (j - 4); if (lg[j] > bv) { bv = lg[j]; bi = ei; } }
#pragma unroll
                for (int o = 16; o <= 32; o <<= 1) { const float ov = __shfl_xor(bv, o); const int oi = __shfl_xor(bi, o); if (ov > bv || (ov == bv && oi < bi)) { bv = ov; bi = oi; } }
                te[r] = bi; tv[r] = bv;
#pragma unroll
                for (int j = 0; j < 8; ++j) { const int ei = (j < 4) ? 4 * fq + j : 16 + 4 * fq + (j - 4); if (ei == bi) lg[j] = -3.0e38f; } }
            const float e1 = __expf(tv[1] - tv[0]), e2 = __expf(tv[2] - tv[0]), e3 = __expf(tv[3] - tv[0]); const float inv = 1.0f / (1.0f + e1 + e2 + e3);
            int rk[4] = {0, 0, 0, 0};
            if (fq == 0 && live) {
#pragma unroll
                for (int r = 0; r < 4; ++r) rk[r] = (int)__hip_atomic_fetch_add(lcnt + te[r], 1u, __ATOMIC_RELAXED, __HIP_MEMORY_SCOPE_WORKGROUP); }
            __syncthreads();
            if (tid < 32) { const unsigned c = lcnt[tid]; lcnt[32 + tid] = c ? __hip_atomic_fetch_add(ctl + CW_CNT + tid, c, __ATOMIC_RELAXED, __HIP_MEMORY_SCOPE_AGENT) : 0u; }
            __syncthreads();
            if (fq == 0 && live) {
#pragma unroll
                for (int r = 0; r < 4; ++r) rk[r] += (int)lcnt[32 + te[r]];
                *(int4*)(TOKE + (size_t)t * 4) = make_int4(te[0], te[1], te[2], te[3]); *(f32x4*)(TOKG + (size_t)t * 4) = (f32x4){inv, e1 * inv, e2 * inv, e3 * inv}; *(int4*)(TOKR + (size_t)t * 4) = make_int4(rk[0], rk[1], rk[2], rk[3]);
#pragma unroll
                for (int r = 0; r < 4; ++r) LISTG[(size_t)te[r] * M + rk[r]] = t; }
            if (live)
#pragma unroll 4
            for (int r = 0; r < 16; ++r) { const float rs = __shfl(rstd, r); const size_t row = (size_t)(tile * 16 + r) * D;
                GAS u32x2* o8 = (GAS u32x2*)((unsigned char*)XN + row) + lane;
#pragma unroll
                for (int j = 0; j < 2; ++j) { const pg8::u32x4 xw = ((const GAS pg8::u32x4*)(X1 + row))[lane + 64 * j]; const f32x4 g0 = ((const GAS f32x4*)gf)[2 * (lane + 64 * j)], g1 = ((const GAS f32x4*)gf)[2 * (lane + 64 * j) + 1];
                    u32x2 w;
                    w.x = pk4_fp8(__uint_as_float(xw.x << 16) * rs * g0.x, __uint_as_float(xw.x & 0xffff0000u) * rs * g0.y, __uint_as_float(xw.y << 16) * rs * g0.z, __uint_as_float(xw.y & 0xffff0000u) * rs * g0.w, F8_H_SCALE);
                    w.y = pk4_fp8(__uint_as_float(xw.z << 16) * rs * g1.x, __uint_as_float(xw.z & 0xffff0000u) * rs * g1.y, __uint_as_float(xw.w << 16) * rs * g1.z, __uint_as_float(xw.w & 0xffff0000u) * rs * g1.w, F8_H_SCALE);
                    o8[64 * j] = w; } }
        }
        __syncthreads();
        if (BOTH(6)) GRID_BAR();
    }

#define MOE_BUILD_TABLES() \
        LAS int* tabL = (LAS int*)(lds + MOE_TAB_OFF); LAS bf16* biasL = (LAS bf16*)(lds + MOE_BIAS_OFF); LAS int* metaL = (LAS int*)(lds + MOE_TOK_OFF + MOE_MAXU * 512);     \
        if (wave == 0) { unsigned cntv = 0u; if (lane < 32) cntv = __hip_atomic_load(ctl + CW_CNT + lane, __ATOMIC_RELAXED, __HIP_MEMORY_SCOPE_AGENT); \
            const int ntile = (int)((cntv + 255u) >> 8); int incl = ntile; \
            _Pragma("unroll") for (int o = 1; o < 32; o <<= 1) { const int nn = __shfl_up(incl, o); if (lane >= o) incl += nn; } \
            const int tst = incl - ntile; \
            if (lane < 32) { metaL[lane] = tst; metaL[32 + lane] = (int)cntv; for (int i = 0; i < ntile; ++i) tabL[tst + i] = lane; } \
            if (lane == 31) metaL[64] = incl; } \
        LDS_WAIT(); __syncthreads(); \
        const int MT = metaL[64];
    if (IN(7)) {
        MOE_BUILD_TABLES();
        LAS unsigned short* tokL = (LAS unsigned short*)(lds + MOE_TOK_OFF);
        { const int pnw = ((int)blockIdx.x >> 3) % 8;
          const float* bgu = args.in[21];
          for (int i = tid; i < 32 * 256; i += NWAVES * 64) { const int e = i >> 8, j = i & 255; biasL[i] = (bf16)f2bf(bgu[e * 2048 + (j >> 7) * 1024 + pnw * 128 + (j & 127)]); }
          const int* LISTG = (const int*)(ws + WS_LIST); const int per_round = G / 8, mpx = per_round / 8, xcd = (int)blockIdx.x & 7, loc = (int)blockIdx.x >> 3;
          int tokv[MOE_MAXU * 256 / (NWAVES * 64)];
#pragma unroll
          for (int q = 0; q < MOE_MAXU * 256 / (NWAVES * 64); ++q) { const int idx = tid + q * NWAVES * 64, u = idx >> 8, r = idx & 255; const int mt = u * per_round + xcd * mpx + loc / 8; tokv[q] = 0;
              if (mt < MT) { const int e = tabL[mt]; const int lr = (mt - metaL[e]) * 256 + r; if (lr < metaL[32 + e]) tokv[q] = LISTG[(size_t)e * M + lr]; } }
#pragma unroll
          for (int q = 0; q < MOE_MAXU * 256 / (NWAVES * 64); ++q) tokL[tid + q * NWAVES * 64] = (unsigned short)tokv[q];
          LDS_WAIT(); __syncthreads(); }
        pg8::Gemm g{XN, WGU_T, SLOT_ROWS, 2048, D / 2, F8_W_BYTE, F8_H_BYTE, (const LAS unsigned short*)tokL};         pg8::MoeOrder S{(const LAS int*)tabL, MT, 8, G, (int)blockIdx.x};
        pg8::EpiSwiGLU E{ACT, FF, (const LAS unsigned short*)biasL};
        pg8::gemm_phase<pg8::EpiSwiGLU, pg8::MoeOrder, PG8_ALIGN, PG8_SP2, true, true>(lds, g, S, E);
        if (BOTH(7)) GRID_BAR();
    }

    if (IN(8)) {
        MOE_BUILD_TABLES();
        { const int pnw = ((int)blockIdx.x >> 3) % 4;
          const float* bdn = args.in[23];
          for (int i = tid; i < 32 * 256; i += NWAVES * 64) { const int e = i >> 8, j = i & 255; biasL[i] = (bf16)f2bf(bdn[e * 1024 + pnw * 256 + j]); }
          LDS_WAIT(); __syncthreads(); }
        pg8::Gemm g{ACT, WDN_T, SLOT_ROWS, 1024, FF / 2, F8_W_BYTE, F8_ACT_BYTE}; pg8::MoeOrder S{(const LAS int*)tabL, MT, 4, G, (int)blockIdx.x};
        pg8::EpiBiasLdsBf16 E{YSLOT, D, (const LAS unsigned short*)biasL};
        pg8::gemm_phase<pg8::EpiBiasLdsBf16, pg8::MoeOrder, PG8_ALIGN, PG8_SP2, true>(lds, g, S, E);
        if (BOTH(8)) GRID_BAR();
    }

    if (IN(9)) {
        const float* gfin = args.in[24];
        unsigned cntv = 0u; if (lane < 32) cntv = __hip_atomic_load(ctl + CW_CNT + lane, __ATOMIC_RELAXED, __HIP_MEMORY_SCOPE_AGENT);
        const int padded = (int)((cntv + 255u) & ~255u); int incl = padded;
#pragma unroll
        for (int o = 1; o < 32; o <<= 1) { const int nn = __shfl_up(incl, o); if (lane >= o) incl += nn; }
        const int pstart = incl - padded;
        for (int t = gw; t < M; t += NGW) {
            const GAS u32x2* xr = (const GAS u32x2*)(X1 + (size_t)t * D) + lane; f32x4 v[4];
#pragma unroll
            for (int j = 0; j < 4; ++j) { const u32x2 xw = xr[64 * j]; v[j] = (f32x4){__uint_as_float(xw.x << 16), __uint_as_float(xw.x & 0xffff0000u), __uint_as_float(xw.y << 16), __uint_as_float(xw.y & 0xffff0000u)}; }
            const int4 e4 = *(const int4*)(TOKE + (size_t)t * 4), r4 = *(const int4*)(TOKR + (size_t)t * 4); const f32x4 g4 = *(const f32x4*)(TOKG + (size_t)t * 4);
            const int dd[4] = {__shfl(pstart, e4.x) + r4.x, __shfl(pstart, e4.y) + r4.y, __shfl(pstart, e4.z) + r4.z, __shfl(pstart, e4.w) + r4.w}; const float gg[4] = {g4.x, g4.y, g4.z, g4.w};
#pragma unroll
            for (int q = 0; q < 4; ++q) { const GAS unsigned* yr = (const GAS unsigned*)((const unsigned char*)YSLOT + (size_t)dd[q] * D) + lane; const float gq8 = gg[q] * 0.125f;
#pragma unroll
                for (int j = 0; j < 4; ++j) { const unsigned w = yr[64 * j]; const f32x2_t lo = __builtin_amdgcn_cvt_pk_f32_fp8((int)w, false), hi = __builtin_amdgcn_cvt_pk_f32_fp8((int)w, true);
                    v[j].x += gq8 * lo.x; v[j].y += gq8 * lo.y; v[j].z += gq8 * hi.x; v[j].w += gq8 * hi.y; } }
            float s = 0.f;
#pragma unroll
            for (int j = 0; j < 4; ++j) s += (v[j].x * v[j].x + v[j].y * v[j].y) + (v[j].z * v[j].z + v[j].w * v[j].w);
            const float rstd = 1.0f / sqrtf(wave_sum(s) * (1.f / D) + NORM_EPS);
            GAS f32x4* orow = (GAS f32x4*)(args.out + (size_t)t * D) + lane;
#pragma unroll
            for (int j = 0; j < 4; ++j) { const f32x4 gq = ((const GAS f32x4*)gfin)[lane + 64 * j]; orow[64 * j] = v[j] * rstd * gq; }
        }
    }
#undef IN
#undef BOTH
#undef GRID_BAR
}

extern "C" void kernel_launch(void* const* d_in, const int* in_sizes, int n_in, void* d_out, int out_size, void* d_ws, size_t ws_size, hipStream_t stream) {
    static int grid = 0;
    if (grid == 0) {
        if (n_in != 25 || in_sizes[0] != M * D || out_size != M * D || ws_size < WS_END) { fprintf(stderr, "kernel_launch: unexpected shapes / workspace (%d inputs, ws %zu)\n", n_in, ws_size); grid = -1; return; }
        int dev = 0, cus = 0, per_cu = 0;
        if (hipGetDevice(&dev) != hipSuccess || hipDeviceGetAttribute(&cus, hipDeviceAttributeMultiprocessorCount, dev) != hipSuccess) { grid = -1; return; }
        if (hipFuncSetAttribute((const void*)mk_fwd, hipFuncAttributeMaxDynamicSharedMemorySize, LDS_BYTES) != hipSuccess) { grid = -1; return; }
        if (hipOccupancyMaxActiveBlocksPerMultiprocessor(&per_cu, (const void*)mk_fwd, NWAVES * 64, LDS_BYTES) != hipSuccess || per_cu < 1) { fprintf(stderr, "kernel_launch: occupancy query says %d blocks per CU\n", per_cu); grid = -1; (void)hipGetLastError(); return; }
        (void)hipGetLastError();
        grid = cus;
    }
    if (grid < 0) return;
    if (hipMemsetAsync((char*)d_ws + WS_CTL, 0, CTL_ZERO_BYTES, stream) != hipSuccess) return;
    Args a{};
    for (int i = 0; i < 25; ++i) a.in[i] = (const float*)d_in[i];
    a.out = (float*)d_out; a.ws = (unsigned char*)d_ws;
    if (N_LAUNCHES == 1) { a.ph_lo = 0; a.ph_hi = NPHASE; a.li = 0; hipLaunchKernelGGL(mk_fwd, dim3(grid), dim3(NWAVES * 64), LDS_BYTES, stream, a); }
    else for (int li = 0; li < NPHASE; ++li) { a.ph_lo = li; a.ph_hi = li + 1; a.li = li; hipLaunchKernelGGL(mk_fwd, dim3(grid), dim3(NWAVES * 64), LDS_BYTES, stream, a); }
}
```

```cpp
#include <hip/hip_runtime.h>
#include <cstdio>
#include <cstdint>
namespace pg8 {
#define PG8_LAS __attribute__((address_space(3)))
typedef unsigned short bf16_t;
typedef short bf16x8 __attribute__((ext_vector_type(8)));
typedef float f32x4 __attribute__((ext_vector_type(4)));
typedef unsigned u32x4 __attribute__((ext_vector_type(4)));
constexpr int BM = 256, BK = 64, HALF = 128, HTB = HALF * BK * 2  , STAGE_BYTES = 8 * HTB, NXCD = 8, WGM = 8;

__host__ __device__ __forceinline__ int lds_byte(int r, int c) { const int st = (r >> 4) * 2 + (c >> 5), rr = r & 15, cc = c & 31, ob = rr * 64 + cc * 2; return st * 1024 + (ob ^ (((ob >> 9) & 1) << 5)); }
__host__ __device__ __forceinline__ void stage_rc(int b, int& R, int& C) { const int st = b / 1024, sb = b % 1024, swz = sb ^ (((sb >> 9) & 1) << 5); R = (st >> 1) * 16 + swz / 64; C = (st & 1) * 32 + (swz % 64) / 2; }
__host__ __device__ __forceinline__ int perm32(int rho) { const int n = rho >> 4, i = rho & 15; return 8 * (i >> 2) + 4 * n + (i & 3); }

struct Unit { int pm, pn, pb, e; };
struct Gemm { const bf16_t* A; const bf16_t* Bt; int M, N, K; int scl_w, scl_a; const PG8_LAS unsigned short* tokL; };

struct StaticOrder {
    int nM, nN, nwg, G, c;
    __host__ __device__ void init(int M, int N, int G_, int c_) { nM = M / BM; nN = N / BM; nwg = nM * nN; G = G_; c = c_; }
    __host__ __device__ bool next(int i, Unit& u) const {
        const long L = (long)i * G + c; if (L >= nwg) return false;
        int wgid = (int)L; { const int q = nwg / NXCD, r = nwg % NXCD, xcd = wgid % NXCD, off = wgid / NXCD; wgid = (xcd < r ? xcd * (q + 1) : r * (q + 1) + (xcd - r) * q) + off; }
        const int nig = WGM * nN, gid = wgid / nig, fm = gid * WGM, gsz = (nM - fm) < WGM ? (nM - fm) : WGM;
        u.pm = fm + ((wgid % nig) % gsz); u.pn = (wgid % nig) / gsz; u.pb = u.pn; u.e = 0; return true;
    }
    __device__ __forceinline__ void a_ready(const Unit&) const {}
    __device__ __forceinline__ void done(const Unit&) const {}
};

__device__ __forceinline__ unsigned cvt_pk_bf16(float lo, float hi) { unsigned r; asm volatile("v_cvt_pk_bf16_f32 %0, %1, %2" : "=v"(r) : "v"(lo), "v"(hi)); return r; }
typedef float f32x2 __attribute__((ext_vector_type(2)));
__device__ __forceinline__ f32x2 gelu_pk(f32x2 v) {
    const f32x2 av = __builtin_elementwise_abs(v), d = av * 0.2316418882f + 1.0f;
    f32x2 t; t.x = __builtin_amdgcn_rcpf(d.x); t.y = __builtin_amdgcn_rcpf(d.y);
    f32x2 q = t * 0.5307027145f + (-0.7265760135f); q = q * t + 0.7107068705f; q = q * t + (-0.142248368f); q = q * t + 0.127414796f; q = q * t;
    const f32x2 s = (v * v) * (-0.72134752044f);
    f32x2 e; e.x = __builtin_amdgcn_exp2f(s.x); e.y = __builtin_amdgcn_exp2f(s.y);
    const f32x2 m = v * (q * e), r = v - m;
    f32x2 o; o.x = v.x < 0.f ? m.x : r.x; o.y = v.y < 0.f ? m.y : r.y; return o;
}

template <int ACT  > struct EpiBf16 {
    static constexpr bool PERM = true, AFTER_DRAIN = false; static_assert(ACT == 0 || ACT == 1, "EpiBf16: ACT is 0 (none) or 1 (gelu_pk)");
    bf16_t* O; int ldc; const float* bias; int split_cols; size_t split_stride; float scale0;
    __device__ __forceinline__ void operator()(const f32x4 (&acc)[2][2][4][2], const Unit& u, int wr, int wc, int fr, int fq) const {
        const int row0 = u.pm * BM + wr * 64 + fr; int colt = u.pn * BM; bf16_t* base = O;
        float sc = 1.f; if (split_cols) { const int t = colt / split_cols; base += (size_t)t * split_stride; colt -= t * split_cols; if (t == 0) sc = scale0; }
        const int col0 = colt + wc * 32 + 8 * fq, bcol0 = u.pn * BM + wc * 32 + 8 * fq;
        f32x4 bv[2][2];
#pragma unroll
        for (int bj = 0; bj < 2; ++bj)
#pragma unroll
            for (int n = 0; n < 2; ++n) bv[bj][n] = bias ? *(const f32x4*)(bias + bcol0 + bj * HALF + 4 * n) : (f32x4){0.f, 0.f, 0.f, 0.f};
#pragma unroll
        for (int ai = 0; ai < 2; ++ai)
#pragma unroll
            for (int m = 0; m < 4; ++m) { bf16_t* rowp = base + (size_t)(row0 + ai * HALF + m * 16) * ldc + col0;
#pragma unroll
                for (int bj = 0; bj < 2; ++bj) { f32x4 v0 = acc[ai][bj][m][0] + bv[bj][0], v1 = acc[ai][bj][m][1] + bv[bj][1];
                    if (ACT == 1) { f32x2 a = gelu_pk((f32x2){v0[0], v0[1]}), b = gelu_pk((f32x2){v0[2], v0[3]}), c = gelu_pk((f32x2){v1[0], v1[1]}), d = gelu_pk((f32x2){v1[2], v1[3]});
                        v0 = (f32x4){a.x, a.y, b.x, b.y}; v1 = (f32x4){c.x, c.y, d.x, d.y}; }
                    v0 = v0 * sc; v1 = v1 * sc; u32x4 w; w.x = cvt_pk_bf16(v0[0], v0[1]); w.y = cvt_pk_bf16(v0[2], v0[3]); w.z = cvt_pk_bf16(v1[0], v1[1]); w.w = cvt_pk_bf16(v1[2], v1[3]);
                    *(u32x4*)(rowp + bj * HALF) = w; } }
    }
};

typedef int v8i_t __attribute__((ext_vector_type(8))); typedef int v4i_t __attribute__((ext_vector_type(4)));
__device__ __forceinline__ v8i_t cat8(bf16x8 lo, bf16x8 hi) { return __builtin_shufflevector(__builtin_bit_cast(v4i_t, lo), __builtin_bit_cast(v4i_t, hi), 0, 1, 2, 3, 4, 5, 6, 7); }
template <class Epi, class Sched, bool ALIGN_EPI = false, bool SP2 = false, bool FP8 = false, bool GATHER = false>
__device__ __forceinline__ void gemm_phase(PG8_LAS unsigned char* lds, const Gemm g, const Sched& S, const Epi& E) {
    const int tid = threadIdx.x, wid = __builtin_amdgcn_readfirstlane(tid >> 6), lane = tid & 63, wr = wid >> 2, wc = wid & 3, fr = lane & 15, fq = lane >> 4;
    const int K = g.K, nt = K / BK;
    unsigned voffA[2], voffB[2];
#pragma unroll
    for (int i = 0; i < 2; ++i) { int R, C; stage_rc(tid * 16 + i * 8192, R, C); const int Rb = Epi::PERM ? ((R & ~31) + perm32(R & 31)) : R;
        voffA[i] = (unsigned)(R * K + C) * 2u; voffB[i] = (unsigned)(Rb * K + C) * 2u; }
    unsigned voffAc[2][2] = {{0u, 0u}, {0u, 0u}}, voffAn[2][2] = {{0u, 0u}, {0u, 0u}}; int gRA[2] = {0, 0}; unsigned gCb[2] = {0u, 0u};
    if constexpr (GATHER) {
#pragma unroll
        for (int i = 0; i < 2; ++i) { int R, C; stage_rc(tid * 16 + i * 8192, R, C); gRA[i] = R; gCb[i] = (unsigned)C * 2u; } }
#define PG8_GVOFF(dst, uidx) do { _Pragma("unroll") for (int h_ = 0; h_ < 2; ++h_) _Pragma("unroll") for (int i_ = 0; i_ < 2; ++i_) dst[h_][i_] = (unsigned)g.tokL[(uidx) * 256 + 128 * h_ + gRA[i_]] * (unsigned)(K * 2) + gCb[i_]; } while (0)
    const size_t kstep = (size_t)(BK * 2);
    const size_t hstep = (size_t)HALF * K * 2;
    const size_t tstep = 2 * hstep;
    const unsigned ldsw = (unsigned)wid * 1024u;
    const int aoff = lds_byte(wr * 64 + fr, fq * 8), boff = lds_byte(wc * 32 + fr, fq * 8);
#define PG8_SA(b, h) (((b) * 2 + (h)) * HTB)
#define PG8_SB(b, h) ((4 + (b) * 2 + (h)) * HTB)
#define PG8_STAGE(bufoff, gbase, voff) do { _Pragma("unroll") for (int _i = 0; _i < 2; ++_i) \
        __builtin_amdgcn_global_load_lds((const unsigned*)((const char*)(gbase) + (voff)[_i]), (PG8_LAS unsigned*)(lds + (bufoff) + ldsw + _i * 8192), 16, 0, 0); } while (0)
#define PG8_STAGE_A(bufoff, gbase, half, nx) do { if constexpr (GATHER) { const unsigned v0_ = (nx) ? voffAn[half][0] : voffAc[half][0], v1_ = (nx) ? voffAn[half][1] : voffAc[half][1]; \
        __builtin_amdgcn_global_load_lds((const unsigned*)((const char*)(gbase) + v0_), (PG8_LAS unsigned*)(lds + (bufoff) + ldsw), 16, 0, 0); \
        __builtin_amdgcn_global_load_lds((const unsigned*)((const char*)(gbase) + v1_), (PG8_LAS unsigned*)(lds + (bufoff) + ldsw + 8192), 16, 0, 0); } \
        else { PG8_STAGE(bufoff, (gbase) + (half) * hstep, voffA); } } while (0)
#define PG8_LDA(dst, b, h) do { if constexpr (FP8) { _Pragma("unroll") for (int m = 0; m < 4; ++m) dst##8[m] = cat8(*(const PG8_LAS bf16x8*)(lds + PG8_SA(b, h) + aoff + m * 2048), *(const PG8_LAS bf16x8*)(lds + PG8_SA(b, h) + aoff + m * 2048 + 1024)); } \
        else { _Pragma("unroll") for (int m = 0; m < 4; ++m) _Pragma("unroll") for (int k = 0; k < 2; ++k) dst[m][k] = *(const PG8_LAS bf16x8*)(lds + PG8_SA(b, h) + aoff + m * 2048 + k * 1024); } } while (0)
#define PG8_LDB(dst, b, h) do { if constexpr (FP8) { _Pragma("unroll") for (int n = 0; n < 2; ++n) dst##8[n] = cat8(*(const PG8_LAS bf16x8*)(lds + PG8_SB(b, h) + boff + n * 2048), *(const PG8_LAS bf16x8*)(lds + PG8_SB(b, h) + boff + n * 2048 + 1024)); } \
        else { _Pragma("unroll") for (int n = 0; n < 2; ++n) _Pragma("unroll") for (int k = 0; k < 2; ++k) dst[n][k] = *(const PG8_LAS bf16x8*)(lds + PG8_SB(b, h) + boff + n * 2048 + k * 1024); } } while (0)
#define PG8_MMA(ai, bj, At, Bt) do { __builtin_amdgcn_s_setprio(1); if constexpr (FP8) { _Pragma("unroll") for (int m = 0; m < 4; ++m) _Pragma("unroll") for (int n = 0; n < 2; ++n) \
        acc[ai][bj][m][n] = __builtin_amdgcn_mfma_scale_f32_16x16x128_f8f6f4(Bt##8[n], At##8[m], acc[ai][bj][m][n], 0, 0, 0, g.scl_w, 0, g.scl_a); \
        _Pragma("unroll") for (int m = 0; m < 4; ++m) _Pragma("unroll") for (int n = 0; n < 2; ++n) asm volatile("" : "+v"(acc[ai][bj][m][n]));   } else { \
        _Pragma("unroll") for (int m = 0; m < 4; ++m) _Pragma("unroll") for (int n = 0; n < 2; ++n) _Pragma("unroll") for (int k = 0; k < 2; ++k) \
        acc[ai][bj][m][n] = __builtin_amdgcn_mfma_f32_16x16x32_bf16(Bt[n][k], At[m][k], acc[ai][bj][m][n], 0, 0, 0); } __builtin_amdgcn_s_setprio(0); } while (0)
#define PG8_WAIT_V(n) asm volatile("s_waitcnt vmcnt(" #n ")" ::: "memory")
#define PG8_WAIT_L(n) asm volatile("s_waitcnt lgkmcnt(" #n ")" ::: "memory")
#define PG8_BAR __builtin_amdgcn_s_barrier()
#define PG8_SCHED __builtin_amdgcn_sched_barrier(0)
    Unit cur, nxt; int ui = 0;
    if (!S.next(0, cur)) return;
    f32x4 acc[2][2][4][2];
#pragma unroll
    for (int a = 0; a < 2; ++a)
#pragma unroll
        for (int b = 0; b < 2; ++b)
#pragma unroll
            for (int m = 0; m < 4; ++m)
#pragma unroll
                for (int n = 0; n < 2; ++n) acc[a][b][m][n] = (f32x4){0.f, 0.f, 0.f, 0.f};
    bf16x8 At[4][2], B0[2][2], B1[2][2]; v8i_t At8[4], B08[2], B18[2];
    const char* cA = (const char*)g.A + (GATHER ? (size_t)0 : (size_t)cur.pm * tstep); const char* cB = (const char*)g.Bt + (size_t)cur.pb * tstep;
    if constexpr (GATHER) { PG8_GVOFF(voffAc, 0); }
    S.a_ready(cur);
    if constexpr (SP2) {
        PG8_STAGE(PG8_SB(0, 0), cB, voffB); PG8_STAGE(PG8_SB(0, 1), cB + hstep, voffB); PG8_STAGE_A(PG8_SA(0, 0), cA, 0, false); PG8_STAGE_A(PG8_SA(0, 1), cA, 1, false);
        if (wr == 1) PG8_BAR;
        PG8_WAIT_V(2); PG8_BAR;
        PG8_STAGE(PG8_SB(1, 0), cB + kstep, voffB); PG8_STAGE_A(PG8_SA(1, 0), cA + kstep, 0, false); PG8_STAGE(PG8_SB(1, 1), cB + hstep + kstep, voffB);
        PG8_WAIT_V(6); PG8_BAR;
    } else {
        PG8_STAGE(PG8_SB(0, 0), cB, voffB); PG8_STAGE_A(PG8_SA(0, 0), cA, 0, false); PG8_STAGE(PG8_SB(0, 1), cB + hstep, voffB); PG8_STAGE_A(PG8_SA(0, 1), cA, 1, false);
        if (wr == 1) PG8_BAR;
        PG8_WAIT_V(4); PG8_BAR;
        PG8_STAGE(PG8_SB(1, 0), cB + kstep, voffB); PG8_STAGE_A(PG8_SA(1, 0), cA + kstep, 0, false); PG8_STAGE(PG8_SB(1, 1), cB + hstep + kstep, voffB);
        PG8_WAIT_V(6); PG8_BAR;
    }
    for (;;) {
        const bool has_next = S.next(ui + 1, nxt);
        const char* nA = (has_next && !GATHER) ? (const char*)g.A + (size_t)nxt.pm * tstep : cA; const char* nB = has_next ? (const char*)g.Bt + (size_t)nxt.pb * tstep : cB;
        if constexpr (GATHER) { if (has_next) { PG8_GVOFF(voffAn, ui + 1); } else {
#pragma unroll
            for (int h_ = 0; h_ < 2; ++h_) { voffAn[h_][0] = voffAc[h_][0]; voffAn[h_][1] = voffAc[h_][1]; } } }
        for (int t = 0; t < nt; t += 2) {
            const bool last = (t == nt - 2);
            const char* a1 = cA + (size_t)(t + 1) * kstep;
            const char* a2 = last ? nA : cA + (size_t)(t + 2) * kstep; const char* b2 = last ? nB : cB + (size_t)(t + 2) * kstep;
            const char* a3 = a2 + kstep; const char* b3 = b2 + kstep;
            if (last && has_next) S.a_ready(nxt);
            if constexpr (SP2) {
            PG8_LDB(B0, 0, 0); PG8_LDB(B1, 0, 1); PG8_SCHED; PG8_LDA(At, 0, 0); PG8_STAGE_A(PG8_SA(1, 1), a1, 1, false);
            PG8_WAIT_V(8); PG8_WAIT_L(0); PG8_BAR; PG8_MMA(0, 0, At, B0); PG8_MMA(0, 1, At, B1); PG8_BAR; PG8_SCHED;
            PG8_LDA(At, 0, 1); PG8_STAGE(PG8_SB(0, 0), b2, voffB); PG8_STAGE(PG8_SB(0, 1), b2 + hstep, voffB); PG8_STAGE_A(PG8_SA(0, 0), a2, 0, last);
            PG8_WAIT_V(8); PG8_WAIT_L(0); PG8_BAR; PG8_MMA(1, 0, At, B0); PG8_MMA(1, 1, At, B1); PG8_BAR; PG8_SCHED;
            PG8_LDB(B0, 1, 0); PG8_LDB(B1, 1, 1); PG8_SCHED; PG8_LDA(At, 1, 0); PG8_STAGE_A(PG8_SA(0, 1), a2, 1, last);
            PG8_WAIT_V(8); PG8_WAIT_L(0); PG8_BAR; PG8_MMA(0, 0, At, B0); PG8_MMA(0, 1, At, B1); PG8_BAR; PG8_SCHED;
            PG8_LDA(At, 1, 1); PG8_STAGE(PG8_SB(1, 0), b3, voffB); PG8_STAGE(PG8_SB(1, 1), b3 + hstep, voffB); PG8_STAGE_A(PG8_SA(1, 0), a3, 0, last);
            PG8_WAIT_V(8); PG8_WAIT_L(0); PG8_BAR; PG8_MMA(1, 0, At, B0); PG8_MMA(1, 1, At, B1); PG8_BAR; PG8_SCHED;
            } else {
            PG8_LDB(B0, 0, 0); PG8_SCHED; PG8_LDA(At, 0, 0); PG8_STAGE_A(PG8_SA(1, 1), a1, 1, false);
            PG8_WAIT_L(8); PG8_BAR; PG8_WAIT_L(0); PG8_MMA(0, 0, At, B0); PG8_BAR; PG8_SCHED;
            PG8_LDB(B1, 0, 1); PG8_STAGE(PG8_SB(0, 0), b2, voffB);
            PG8_BAR; PG8_WAIT_L(0); PG8_MMA(0, 1, At, B1); PG8_BAR;
            PG8_LDA(At, 0, 1); PG8_STAGE_A(PG8_SA(0, 0), a2, 0, last);
            PG8_BAR; PG8_WAIT_L(0); PG8_MMA(1, 0, At, B0); PG8_BAR; PG8_SCHED;
            PG8_STAGE(PG8_SB(0, 1), b2 + hstep, voffB);
            PG8_WAIT_V(6); PG8_BAR; PG8_MMA(1, 1, At, B1); PG8_BAR;
            PG8_LDB(B0, 1, 0); PG8_SCHED; PG8_LDA(At, 1, 0); PG8_STAGE_A(PG8_SA(0, 1), a2, 1, last);
            PG8_WAIT_L(8); PG8_BAR; PG8_WAIT_L(0); PG8_MMA(0, 0, At, B0); PG8_BAR; PG8_SCHED;
            PG8_LDB(B1, 1, 1); PG8_STAGE(PG8_SB(1, 0), b3, voffB);
            PG8_BAR; PG8_WAIT_L(0); PG8_MMA(0, 1, At, B1); PG8_BAR;
            PG8_LDA(At, 1, 1); PG8_STAGE_A(PG8_SA(1, 0), a3, 0, last);
            PG8_BAR; PG8_WAIT_L(0); PG8_MMA(1, 0, At, B0); PG8_BAR; PG8_SCHED;
            PG8_STAGE(PG8_SB(1, 1), b3 + hstep, voffB);
            PG8_WAIT_V(6); PG8_BAR; PG8_MMA(1, 1, At, B1); PG8_BAR;
            }
        }
        if constexpr (ALIGN_EPI) { if (wr == 0) PG8_BAR; }
        if constexpr (!Epi::AFTER_DRAIN) { E(acc, cur, wr, wc, fr, fq); S.done(cur); }
        if (!has_next) break;
#pragma unroll
        for (int a = 0; a < 2; ++a)
#pragma unroll
            for (int b = 0; b < 2; ++b)
#pragma unroll
                for (int m = 0; m < 4; ++m)
#pragma unroll
                    for (int n = 0; n < 2; ++n) acc[a][b][m][n] = (f32x4){0.f, 0.f, 0.f, 0.f};
        cur = nxt; cA = nA; cB = nB; ++ui;
        if constexpr (GATHER) {
#pragma unroll
            for (int h_ = 0; h_ < 2; ++h_) { voffAc[h_][0] = voffAn[h_][0]; voffAc[h_][1] = voffAn[h_][1]; } }
        if constexpr (ALIGN_EPI) { if (wr == 1) PG8_BAR; }
    }
    PG8_WAIT_V(0);
    if constexpr (!ALIGN_EPI) { if (wr == 0) PG8_BAR; }
    PG8_BAR;
    if constexpr (Epi::AFTER_DRAIN) { E.fused(acc, cur, wr, wc, fr, fq, lds, wid, lane); S.done(cur); }
#undef PG8_SA
#undef PG8_SB
#undef PG8_STAGE
#undef PG8_STAGE_A
#undef PG8_GVOFF
#undef PG8_LDA
#undef PG8_LDB
#undef PG8_MMA
#undef PG8_WAIT_V
#undef PG8_WAIT_L
#undef PG8_BAR
#undef PG8_SCHED
}
}
#define GAS __attribute__((address_space(1)))
#define LAS __attribute__((address_space(3)))
typedef unsigned short bf16;
typedef unsigned v4u __attribute__((ext_vector_type(4)));
typedef float f32x4 __attribute__((ext_vector_type(4)));
typedef short bf16x8 __attribute__((ext_vector_type(8)));
typedef GAS unsigned gu32;
typedef GAS unsigned long long gu64;
#define RLX_AGENT __ATOMIC_RELAXED, __HIP_MEMORY_SCOPE_AGENT
#define LDS_WAIT() asm volatile("s_waitcnt lgkmcnt(0)" ::: "memory")
#define VM_WAIT() asm volatile("s_waitcnt vmcnt(0)" ::: "memory")
__device__ __forceinline__ unsigned long long rt() { return __builtin_amdgcn_s_memrealtime(); }
__device__ __forceinline__ unsigned f2bf(float f) { unsigned u = __builtin_bit_cast(unsigned, f); return (u + 0x7fffu + ((u >> 16) & 1u)) >> 16; }
__device__ __forceinline__ unsigned pk2(float lo, float hi) { return f2bf(lo) | (f2bf(hi) << 16); }

#define XB_TMO      128
#define XB_XCNT(j)  (256  + 64 * (j))
#define XB_XSUB(j)  (1280 + 64 * (j))
#define XB_XGEN(j)  (2304 + 64 * (j))
#define XB_TOP      3328
#define XB_TOPGEN   3392
#define XCD_BAR_WORDS 3456
#define XB_SPIN_CAP (1u << 22)

__device__ __forceinline__ unsigned xb_ld(unsigned* p)              { return __hip_atomic_load(p, __ATOMIC_RELAXED, __HIP_MEMORY_SCOPE_AGENT); }
__device__ __forceinline__ unsigned xb_add(unsigned* p, unsigned v) { return __hip_atomic_fetch_add(p, v, __ATOMIC_RELAXED, __HIP_MEMORY_SCOPE_AGENT); }
__device__ __forceinline__ unsigned xb_xcc_id() { return (unsigned)__builtin_amdgcn_s_getreg((3 << 11) | 20) & 0xFu; }
#define XB_SPIN(cond, bar) do { unsigned _sp = 0; while (cond) { __builtin_amdgcn_s_sleep(1); \
    if ((++_sp & 255u) == 0u) { if (xb_ld(&(bar)[XB_TMO])) break; if (_sp > XB_SPIN_CAP) { atomicAdd(&(bar)[XB_TMO], 1u); break; } } } } while (0)

struct XcdBarrier {
    unsigned* bar; unsigned x;
    volatile LAS unsigned* st;
};

__device__ __forceinline__ XcdBarrier xcd_barrier_post(unsigned* bar, volatile LAS unsigned* st) {
    XcdBarrier b; b.bar = bar; b.x = xb_xcc_id(); b.st = st;
    if (threadIdx.x == 0) (void)xb_add(&bar[XB_XCNT(b.x)], 1u);
    return b;
}
__device__ __forceinline__ void xcd_barrier_complete(unsigned* bar, unsigned x, unsigned& nloc, unsigned& nx) {
    const unsigned G = gridDim.x * gridDim.y * gridDim.z;
    unsigned sum, cnt, mine, sp = 0u;
    for (;;) {
        sum = 0u; cnt = 0u; mine = 0u;
#pragma unroll
        for (unsigned j = 0; j < 16; ++j) { const unsigned c = xb_ld(&bar[XB_XCNT(j)]); sum += c; cnt += (c > 0u) ? 1u : 0u; mine = (j == x) ? c : mine; }
        if (sum == G) break;
        __builtin_amdgcn_s_sleep(1);
        if ((++sp & 255u) == 0u) { if (xb_ld(&bar[XB_TMO])) break; if (sp > XB_SPIN_CAP) { atomicAdd(&bar[XB_TMO], 1u); break; } }
    }
    nloc = mine > 0u ? mine : 1u; nx = cnt > 0u ? cnt : 1u;
}

__device__ __forceinline__ void xcd_barrier(const XcdBarrier& b) {
    asm volatile("s_waitcnt vmcnt(0)" ::: "memory");
    __syncthreads();
    if (threadIdx.x == 0) {
        unsigned* bar = b.bar;
        __builtin_amdgcn_s_waitcnt(0);
        unsigned nloc = b.st[0], nx = b.st[1];
        if (nloc == 0u) { xcd_barrier_complete(bar, b.x, nloc, nx); b.st[0] = nloc; b.st[1] = nx; }
        const unsigned old = xb_add(&bar[XB_XSUB(b.x)], 1u);
        const unsigned gen = old / nloc;
        if (old + 1u == (gen + 1u) * nloc) {
            __builtin_amdgcn_fence(__ATOMIC_RELEASE, "agent");
            asm volatile("s_waitcnt vmcnt(0)" ::: "memory");
            const unsigned og = xb_add(&bar[XB_TOP], 1u);
            const unsigned tg = og / nx;
            if (og + 1u == (tg + 1u) * nx) xb_add(&bar[XB_TOPGEN], 1u);
            else XB_SPIN(xb_ld(&bar[XB_TOPGEN]) == tg, bar);
            __builtin_amdgcn_fence(__ATOMIC_ACQUIRE, "agent");
            xb_add(&bar[XB_XGEN(b.x)], 1u);
            asm volatile("s_waitcnt vmcnt(0)" ::: "memory");
        } else {
            XB_SPIN(xb_ld(&bar[XB_XGEN(b.x)]) == gen, bar);
            __builtin_amdgcn_fence(__ATOMIC_ACQUIRE, "agent");
            asm volatile("s_waitcnt vmcnt(0)" ::: "memory");
        }
    }
    __syncthreads();
}

#ifndef PG8_SP2
#define PG8_SP2 true
#endif
#ifndef PG8_ALIGN
#define PG8_ALIGN true
#endif
namespace pg8 {
struct EpiResF32 {
    static constexpr bool PERM = false, AFTER_DRAIN = false;
    const float* base; float* C; int ldc;
    __device__ __forceinline__ void operator()(const f32x4 (&acc)[2][2][4][2], const Unit& u, int wr, int wc, int fr, int fq) const {
        const int row0 = u.pm * BM + wr * 64 + fr, col0 = u.pn * BM + wc * 32 + 4 * fq;
#pragma unroll
        for (int ai = 0; ai < 2; ++ai)
#pragma unroll
            for (int m = 0; m < 4; ++m) { const size_t off = (size_t)(row0 + ai * HALF + m * 16) * ldc + col0;
#pragma unroll
                for (int bj = 0; bj < 2; ++bj)
#pragma unroll
                    for (int n = 0; n < 2; ++n) { const f32x4 bs = *(const f32x4*)(base + off + bj * HALF + n * 16); *(f32x4*)(C + off + bj * HALF + n * 16) = bs + acc[ai][bj][m][n]; }
                asm volatile("" ::: "memory"); }
    }
};
struct EpiResXn {
    static constexpr bool PERM = true, AFTER_DRAIN = false;
    const bf16_t* XN; const float* rms; bf16_t* O; int ldc;
    __device__ __forceinline__ void operator()(const f32x4 (&acc)[2][2][4][2], const Unit& u, int wr, int wc, int fr, int fq) const {
        const int row0 = u.pm * BM + wr * 64 + fr, col0 = u.pn * BM + wc * 32 + 8 * fq;
#pragma unroll
        for (int ai = 0; ai < 2; ++ai)
#pragma unroll
            for (int m = 0; m < 4; ++m) { const int row = row0 + ai * HALF + m * 16; const size_t off = (size_t)row * ldc + col0; const float rs = rms[row];
#pragma unroll
                for (int bj = 0; bj < 2; ++bj) { const u32x4 xw = *(const u32x4*)(XN + off + bj * HALF);
                    const f32x4 b0 = (f32x4){__builtin_bit_cast(float, xw.x << 16), __builtin_bit_cast(float, xw.x & 0xffff0000u), __builtin_bit_cast(float, xw.y << 16), __builtin_bit_cast(float, xw.y & 0xffff0000u)};
                    const f32x4 b1 = (f32x4){__builtin_bit_cast(float, xw.z << 16), __builtin_bit_cast(float, xw.z & 0xffff0000u), __builtin_bit_cast(float, xw.w << 16), __builtin_bit_cast(float, xw.w & 0xffff0000u)};
                    const f32x4 v0 = acc[ai][bj][m][0] + b0 * rs, v1 = acc[ai][bj][m][1] + b1 * rs;
                    u32x4 w; w.x = cvt_pk_bf16(v0[0], v0[1]); w.y = cvt_pk_bf16(v0[2], v0[3]); w.z = cvt_pk_bf16(v1[0], v1[1]); w.w = cvt_pk_bf16(v1[2], v1[3]);
                    *(u32x4*)(O + off + bj * HALF) = w; }
                asm volatile("" ::: "memory"); }
    }
};
struct EpiResBf16 {
    static constexpr bool PERM = true, AFTER_DRAIN = false;
    const float* base; bf16_t* O; int ldc;
    __device__ __forceinline__ void operator()(const f32x4 (&acc)[2][2][4][2], const Unit& u, int wr, int wc, int fr, int fq) const {
        const int row0 = u.pm * BM + wr * 64 + fr, col0 = u.pn * BM + wc * 32 + 8 * fq;
#pragma unroll
        for (int ai = 0; ai < 2; ++ai)
#pragma unroll
            for (int m = 0; m < 4; ++m) { const size_t off = (size_t)(row0 + ai * HALF + m * 16) * ldc + col0;
#pragma unroll
                for (int bj = 0; bj < 2; ++bj) { const f32x4 b0 = *(const f32x4*)(base + off + bj * HALF), b1 = *(const f32x4*)(base + off + bj * HALF + 4);
                    const f32x4 v0 = acc[ai][bj][m][0] + b0, v1 = acc[ai][bj][m][1] + b1;
                    u32x4 w; w.x = cvt_pk_bf16(v0[0], v0[1]); w.y = cvt_pk_bf16(v0[2], v0[3]); w.z = cvt_pk_bf16(v1[0], v1[1]); w.w = cvt_pk_bf16(v1[2], v1[3]);
                    *(u32x4*)(O + off + bj * HALF) = w; }
                asm volatile("" ::: "memory"); }
    }
};
struct EpiBiasBf16 {
    static constexpr bool PERM = true, AFTER_DRAIN = false;
    bf16_t* O; int ldc; const float* bias; int bstride;
    __device__ __forceinline__ void operator()(const f32x4 (&acc)[2][2][4][2], const Unit& u, int wr, int wc, int fr, int fq) const {
        const int row0 = u.pm * BM + wr * 64 + fr; const int col0 = u.pn * BM + wc * 32 + 8 * fq;
        const float* bp = bias ? bias + (size_t)u.e * bstride + col0 : nullptr;
        f32x4 bv[2][2];
#pragma unroll
        for (int bj = 0; bj < 2; ++bj)
#pragma unroll
            for (int n = 0; n < 2; ++n) bv[bj][n] = bias ? *(const f32x4*)(bp + bj * HALF + 4 * n) : (f32x4){0.f, 0.f, 0.f, 0.f};
#pragma unroll
        for (int ai = 0; ai < 2; ++ai)
#pragma unroll
            for (int m = 0; m < 4; ++m) { bf16_t* rowp = O + (size_t)(row0 + ai * HALF + m * 16) * ldc + col0;
#pragma unroll
                for (int bj = 0; bj < 2; ++bj) { const f32x4 v0 = acc[ai][bj][m][0] + bv[bj][0], v1 = acc[ai][bj][m][1] + bv[bj][1];
                    u32x4 w; w.x = cvt_pk_bf16(v0[0], v0[1]); w.y = cvt_pk_bf16(v0[2], v0[3]); w.z = cvt_pk_bf16(v1[0], v1[1]); w.w = cvt_pk_bf16(v1[2], v1[3]);
                    *(u32x4*)(rowp + bj * HALF) = w; } }
    }
};
__device__ __forceinline__ unsigned pk4_fp8e(float a, float b, float c, float d) {
    int w = 0; w = __builtin_amdgcn_cvt_pk_fp8_f32(a * 8.f, b * 8.f, w, false); w = __builtin_amdgcn_cvt_pk_fp8_f32(c * 8.f, d * 8.f, w, true); return (unsigned)w; }
typedef unsigned u32x2v __attribute__((ext_vector_type(2)));
__device__ __forceinline__ unsigned pk4_fp8c(float a, float b, float c, float d) {
    a = fminf(fmaxf(a * 8.f, -448.f), 448.f); b = fminf(fmaxf(b * 8.f, -448.f), 448.f); c = fminf(fmaxf(c * 8.f, -448.f), 448.f); d = fminf(fmaxf(d * 8.f, -448.f), 448.f);
    int w = 0; w = __builtin_amdgcn_cvt_pk_fp8_f32(a, b, w, false); w = __builtin_amdgcn_cvt_pk_fp8_f32(c, d, w, true); return (unsigned)w; }
struct EpiBiasLdsBf16 {
    static constexpr bool PERM = true, AFTER_DRAIN = false;
    bf16_t* O; int ldc; const PG8_LAS unsigned short* biasL;
    __device__ __forceinline__ void operator()(const f32x4 (&acc)[2][2][4][2], const Unit& u, int wr, int wc, int fr, int fq) const {
        const int row0 = u.pm * BM + wr * 64 + fr; const int col0 = u.pn * BM + wc * 32 + 8 * fq;
        f32x4 bv[2][2];
#pragma unroll
        for (int bj = 0; bj < 2; ++bj) { const u32x4 w = *(const PG8_LAS u32x4*)(biasL + u.e * 256 + bj * HALF + wc * 32 + 8 * fq);
            bv[bj][0] = (f32x4){__builtin_bit_cast(float, w.x << 16), __builtin_bit_cast(float, w.x & 0xffff0000u), __builtin_bit_cast(float, w.y << 16), __builtin_bit_cast(float, w.y & 0xffff0000u)};
            bv[bj][1] = (f32x4){__builtin_bit_cast(float, w.z << 16), __builtin_bit_cast(float, w.z & 0xffff0000u), __builtin_bit_cast(float, w.w << 16), __builtin_bit_cast(float, w.w & 0xffff0000u)}; }
#pragma unroll
        for (int ai = 0; ai < 2; ++ai)
#pragma unroll
            for (int m = 0; m < 4; ++m) { unsigned char* rowp = (unsigned char*)O + (size_t)(row0 + ai * HALF + m * 16) * ldc + col0;
#pragma unroll
                for (int bj = 0; bj < 2; ++bj) { const f32x4 v0 = acc[ai][bj][m][0] + bv[bj][0], v1 = acc[ai][bj][m][1] + bv[bj][1];
                    u32x2v w; w.x = pk4_fp8c(v0[0], v0[1], v0[2], v0[3]); w.y = pk4_fp8c(v1[0], v1[1], v1[2], v1[3]);
                    *(u32x2v*)(rowp + bj * HALF) = w; } }
    }
};
struct EpiSwiGLU {
    static constexpr bool PERM = true, AFTER_DRAIN = false;
    bf16_t* O; int ldc; const PG8_LAS unsigned short* biasL;
    __device__ __forceinline__ void operator()(const f32x4 (&acc)[2][2][4][2], const Unit& u, int wr, int wc, int fr, int fq) const {
        const int row0 = u.pm * BM + wr * 64 + fr; const int ff0 = u.pn * HALF + wc * 32 + 8 * fq;
        f32x4 bg[2], bu[2];
        { const PG8_LAS unsigned short* bp = biasL + u.e * 256 + wc * 32 + 8 * fq;
          const u32x4 wg = *(const PG8_LAS u32x4*)bp, wu = *(const PG8_LAS u32x4*)(bp + 128);
          bg[0] = (f32x4){__builtin_bit_cast(float, wg.x << 16), __builtin_bit_cast(float, wg.x & 0xffff0000u), __builtin_bit_cast(float, wg.y << 16), __builtin_bit_cast(float, wg.y & 0xffff0000u)};
          bg[1] = (f32x4){__builtin_bit_cast(float, wg.z << 16), __builtin_bit_cast(float, wg.z & 0xffff0000u), __builtin_bit_cast(float, wg.w << 16), __builtin_bit_cast(float, wg.w & 0xffff0000u)};
          bu[0] = (f32x4){__builtin_bit_cast(float, wu.x << 16), __builtin_bit_cast(float, wu.x & 0xffff0000u), __builtin_bit_cast(float, wu.y << 16), __builtin_bit_cast(float, wu.y & 0xffff0000u)};
          bu[1] = (f32x4){__builtin_bit_cast(float, wu.z << 16), __builtin_bit_cast(float, wu.z & 0xffff0000u), __builtin_bit_cast(float, wu.w << 16), __builtin_bit_cast(float, wu.w & 0xffff0000u)}; }
#pragma unroll
        for (int ai = 0; ai < 2; ++ai)
#pragma unroll
            for (int m = 0; m < 4; ++m) { unsigned char* rowp = (unsigned char*)O + (size_t)(row0 + ai * HALF + m * 16) * ldc + ff0;
                float o[8];
#pragma unroll
                for (int n = 0; n < 2; ++n) { const f32x4 g = acc[ai][0][m][n] + bg[n], up = acc[ai][1][m][n] + bu[n];
#pragma unroll
                    for (int j = 0; j < 4; ++j) { const float gg = fminf(g[j], 7.0f), uu = fminf(fmaxf(up[j], -7.0f), 7.0f);
                        const float sg = __builtin_amdgcn_rcpf(1.0f + __builtin_amdgcn_exp2f(-1.702f * 1.44269504089f * gg));
                        o[4 * n + j] = (uu + 1.0f) * (gg * sg); } }
                u32x2v w; w.x = pk4_fp8e(o[0], o[1], o[2], o[3]); w.y = pk4_fp8e(o[4], o[5], o[6], o[7]);
                *(u32x2v*)rowp = w; }
    }
};
struct MoeOrder {
    const PG8_LAS int* tile_e; int MT, nN, G, c;
    __device__ bool next(int i, Unit& u) const {
        const int per_round = G / nN, mpx = per_round / 8; int mt, pn;
        if (G % (8 * nN) == 0) { const int xcd = c & 7, loc = c >> 3; mt = i * per_round + xcd * mpx + loc / nN; pn = loc % nN; }
        else { const long L = (long)i * G + c; mt = (int)(L / nN); pn = (int)(L % nN); }
        if (mt >= MT) return false; const int e = __builtin_amdgcn_readfirstlane(tile_e[mt]);
        u.pm = mt; u.pn = pn; u.pb = e * nN + pn; u.e = e; return true;
    }
    __device__ __forceinline__ void a_ready(const Unit&) const {}
    __device__ __forceinline__ void done(const Unit&) const {}
};
}

constexpr int NWAVES = 8;
constexpr int BATCH = 4, SEQ = 8192, D = 1024, M = BATCH * SEQ;
constexpr int IN_COLS = 3328, CW = 512, RW = 512, NH = 8, HD = 64;
constexpr int NE = 32, TOPK = 4, FF = 1024;
constexpr int SLOT_ROWS = M * TOPK + NE * 256;
constexpr int MT_MAX = SLOT_ROWS / 256;
constexpr float NORM_EPS = 1e-5f, GN_EPS = 64e-5f;
#ifndef MK_N_LAUNCHES
#define MK_N_LAUNCHES 1
#endif
constexpr int NPHASE = 10;
constexpr int N_LAUNCHES = MK_N_LAUNCHES;

constexpr size_t MiB = 1u << 20;
constexpr size_t WS_CTL = 0, CTL_ZERO_BYTES = 1 * MiB;
constexpr size_t WS_WIN = 2 * MiB;
constexpr size_t WS_WOUT = 9 * MiB;
constexpr size_t WS_LORA = 11 * MiB;
constexpr size_t WS_TOKE = 12 * MiB, WS_TOKG = WS_TOKE + 512 * 1024, WS_TOKR = WS_TOKG + 512 * 1024, WS_DEST = WS_TOKR + 512 * 1024;
constexpr size_t WS_BDOT = 14 * MiB;
constexpr size_t WS_WGU = 16 * MiB;
constexpr size_t WS_WDN = 144 * MiB;
constexpr size_t WS_XN = 208 * MiB;
constexpr size_t WS_Y = 272 * MiB;
constexpr size_t WS_P = 336 * MiB;
constexpr size_t WS_FR = 544 * MiB;
constexpr size_t WS_SR = 544 * MiB, WS_SW = 608 * MiB, WS_SK = 672 * MiB, WS_SV = 864 * MiB, WS_SKK = 800 * MiB, WS_SB = 864 * MiB;
constexpr size_t WS_SG = 928 * MiB;
constexpr size_t WS_XIN = 272 * MiB;
constexpr size_t WS_YSLOT = WS_XIN;
constexpr size_t WS_ACT = 544 * MiB;
constexpr size_t WS_X1 = 816 * MiB;
constexpr size_t WS_END = 960 * MiB;
constexpr int CHK = 32, NCH = SEQ / CHK, NCHH = BATCH * NH * NCH;
constexpr size_t WS_SF = WS_P;
constexpr size_t WS_RMS = 15 * MiB;
constexpr size_t WS_QF = 736 * MiB;
constexpr size_t WS_O1 = 768 * MiB;
constexpr size_t WS_GF = 608 * MiB;
constexpr size_t WS_HF = 672 * MiB;
constexpr size_t WS_PC = 800 * MiB;
static_assert(WS_ACT + (size_t)SLOT_ROWS * 1024 * 2 <= WS_X1 && WS_X1 + (size_t)M * D * 4 <= WS_END && WS_XIN + (size_t)SLOT_ROWS * 1024 * 2 <= WS_ACT, "ws map");
constexpr int CW_BAR = 4096;
constexpr int CW_CNT = 8192;
constexpr int CW_MT = 8256;
constexpr int CW_TILE_E = 8320;
constexpr int RING_BYTES = 131072, LDS_BYTES = 163840, LDSCTL_OFF = LDS_BYTES - 512, MISC_OFF = LDSCTL_OFF + 320;

constexpr int MOE_TOK_OFF = RING_BYTES + 2304 + 32 * 256 * 2, MOE_MAXU = 18;
constexpr size_t WS_LIST = 240 * MiB;
constexpr int MOE_TAB_OFF = RING_BYTES, MOE_BIAS_OFF = RING_BYTES + 2304;
static_assert(MOE_TOK_OFF + MOE_MAXU * 512 + 512 <= LDSCTL_OFF, "MoE LDS tables fit");
typedef unsigned u32x2 __attribute__((ext_vector_type(2)));
typedef float f32x2 __attribute__((ext_vector_type(2)));

typedef float f32x2_t __attribute__((ext_vector_type(2))); typedef __bf16 bf16x2_t __attribute__((ext_vector_type(2)));
__device__ __forceinline__ unsigned cvtpk_s(float lo, float hi) { f32x2_t v = {lo, hi}; bf16x2_t b = __builtin_convertvector(v, bf16x2_t); return __builtin_bit_cast(unsigned, b); }
__device__ __forceinline__ float wave_sum(float v) {
#pragma unroll
    for (int o = 1; o < 64; o <<= 1) v += __shfl_xor(v, o);
    return v;
}
__device__ __forceinline__ float bf_lo(unsigned w) { return __builtin_bit_cast(float, w << 16); }
__device__ __forceinline__ float bf_hi(unsigned w) { return __builtin_bit_cast(float, w & 0xffff0000u); }
__device__ __forceinline__ float fast_sigmoid(float x) { return __builtin_amdgcn_rcpf(1.0f + __builtin_amdgcn_exp2f(-1.44269504089f * x)); }
__device__ __forceinline__ float fast_tanh(float x) { const float xc = fminf(fmaxf(x, -15.f), 15.f); const float e = __builtin_amdgcn_exp2f(2.88539008178f * xc); return 1.0f - 2.0f * __builtin_amdgcn_rcpf(e + 1.0f); }

__device__ __forceinline__ void p0_transpose_item(const float* W, int K, int N, bf16* WT, int dst_row0, LAS float* scr, int k0, int n0, int lane) {
#pragma unroll
    for (int i = 0; i < 8; ++i) { const int kk = 8 * i + (lane >> 3), c4 = (lane & 7) * 4; const f32x4 v = *(const f32x4*)(W + (size_t)(k0 + kk) * N + n0 + c4);
        scr[kk * 33 + c4] = v.x; scr[kk * 33 + c4 + 1] = v.y; scr[kk * 33 + c4 + 2] = v.z; scr[kk * 33 + c4 + 3] = v.w; }
    LDS_WAIT(); asm volatile("" ::: "memory");
    const int c = lane & 7;
#pragma unroll
    for (int j = 0; j < 4; ++j) { const int n = (lane >> 3) + 8 * j; const LAS float* s = scr + (8 * c) * 33 + n;
        v4u o; o.x = pk2(s[0 * 33], s[1 * 33]); o.y = pk2(s[2 * 33], s[3 * 33]); o.z = pk2(s[4 * 33], s[5 * 33]); o.w = pk2(s[6 * 33], s[7 * 33]);
        *(GAS v4u*)(WT + (size_t)(dst_row0 + n) * K + k0 + 8 * c) = o; }
    LDS_WAIT(); asm volatile("" ::: "memory");
}

__device__ __forceinline__ void p0_transpose_item_g(const float* W, int K, int N, bf16* WT, int dst_row0, LAS float* scr, int k0, int n0, int lane, const float* gk) {
#pragma unroll
    for (int i = 0; i < 8; ++i) { const int kk = 8 * i + (lane >> 3), c4 = (lane & 7) * 4; const f32x4 v = *(const f32x4*)(W + (size_t)(k0 + kk) * N + n0 + c4);
        scr[kk * 33 + c4] = v.x; scr[kk * 33 + c4 + 1] = v.y; scr[kk * 33 + c4 + 2] = v.z; scr[kk * 33 + c4 + 3] = v.w; }
    const int c = lane & 7;
    const f32x4 ga = *(const f32x4*)(gk + k0 + 8 * c), gb = *(const f32x4*)(gk + k0 + 8 * c + 4);
    LDS_WAIT(); asm volatile("" ::: "memory");
#pragma unroll
    for (int j = 0; j < 4; ++j) { const int n = (lane >> 3) + 8 * j; const LAS float* s = scr + (8 * c) * 33 + n;
        v4u o; o.x = pk2(s[0 * 33] * ga.x, s[1 * 33] * ga.y); o.y = pk2(s[2 * 33] * ga.z, s[3 * 33] * ga.w); o.z = pk2(s[4 * 33] * gb.x, s[5 * 33] * gb.y); o.w = pk2(s[6 * 33] * gb.z, s[7 * 33] * gb.w);
        *(GAS v4u*)(WT + (size_t)(dst_row0 + n) * K + k0 + 8 * c) = o; }
    LDS_WAIT(); asm volatile("" ::: "memory");
}

__device__ __forceinline__ unsigned pk4_fp8(float a, float b, float c, float d, float s) {
    a = fminf(fmaxf(a * s, -448.f), 448.f); b = fminf(fmaxf(b * s, -448.f), 448.f); c = fminf(fmaxf(c * s, -448.f), 448.f); d = fminf(fmaxf(d * s, -448.f), 448.f);
    int w = 0; w = __builtin_amdgcn_cvt_pk_fp8_f32(a, b, w, false); w = __builtin_amdgcn_cvt_pk_fp8_f32(c, d, w, true); return (unsigned)w; }
constexpr float F8_W_SCALE = 1024.f, F8_H_SCALE = 32.f, F8_ACT_SCALE = 8.f;
constexpr int F8_W_BYTE = 0x75757575, F8_H_BYTE = 0x7a7a7a7a, F8_ACT_BYTE = 0x7c7c7c7c;
struct F8Item { f32x4 v[8]; };
__device__ __forceinline__ void f8_item_load(F8Item& it, const float* W, int N, int k0, int n0, int lane) {
#pragma unroll
    for (int i = 0; i < 8; ++i) { const int kk = 8 * i + (lane >> 3), c4 = (lane & 7) * 4; it.v[i] = *(const f32x4*)(W + (size_t)(k0 + kk) * N + n0 + c4); }
}
__device__ __forceinline__ void f8_item_finish(const F8Item& it, int K, unsigned char* WT, int dst_row0, LAS float* scr, int k0, int lane) {
#pragma unroll
    for (int i = 0; i < 8; ++i) { const int kk = 8 * i + (lane >> 3), c4 = (lane & 7) * 4; scr[kk * 33 + c4] = it.v[i].x; scr[kk * 33 + c4 + 1] = it.v[i].y; scr[kk * 33 + c4 + 2] = it.v[i].z; scr[kk * 33 + c4 + 3] = it.v[i].w; }
    LDS_WAIT(); asm volatile("" ::: "memory");
    const int c = lane & 7;
#pragma unroll
    for (int j = 0; j < 4; ++j) { const int n = (lane >> 3) + 8 * j; const LAS float* s = scr + (8 * c) * 33 + n;
        u32x2 o; o.x = pk4_fp8(s[0 * 33], s[1 * 33], s[2 * 33], s[3 * 33], F8_W_SCALE); o.y = pk4_fp8(s[4 * 33], s[5 * 33], s[6 * 33], s[7 * 33], F8_W_SCALE);
        *(GAS u32x2*)(WT + (size_t)(dst_row0 + n) * K + k0 + 8 * c) = o; }
    LDS_WAIT(); asm volatile("" ::: "memory");
}
__device__ __forceinline__ void p0_transpose_item_f8(const float* W, int K, int N, unsigned char* WT, int dst_row0, LAS float* scr, int k0, int n0, int lane) {
#pragma unroll
    for (int i = 0; i < 8; ++i) { const int kk = 8 * i + (lane >> 3), c4 = (lane & 7) * 4; const f32x4 v = *(const f32x4*)(W + (size_t)(k0 + kk) * N + n0 + c4);
        scr[kk * 33 + c4] = v.x; scr[kk * 33 + c4 + 1] = v.y; scr[kk * 33 + c4 + 2] = v.z; scr[kk * 33 + c4 + 3] = v.w; }
    LDS_WAIT(); asm volatile("" ::: "memory");
    const int c = lane & 7;
#pragma unroll
    for (int j = 0; j < 4; ++j) { const int n = (lane >> 3) + 8 * j; const LAS float* s = scr + (8 * c) * 33 + n;
        u32x2 o; o.x = pk4_fp8(s[0 * 33], s[1 * 33], s[2 * 33], s[3 * 33], F8_W_SCALE); o.y = pk4_fp8(s[4 * 33], s[5 * 33], s[6 * 33], s[7 * 33], F8_W_SCALE);
        *(GAS u32x2*)(WT + (size_t)(dst_row0 + n) * K + k0 + 8 * c) = o; }
    LDS_WAIT(); asm volatile("" ::: "memory");
}

constexpr int MOE_I_DN = 32 * 512, MOE_I_GU = 32 * 1024, MOE_NIT = MOE_I_DN + MOE_I_GU, MOE_P1_ITEMS = 28672;
__device__ __forceinline__ void moe_convert_items(const float* wdn, const float* wgu, unsigned char* WDN8, unsigned char* WGU8, LAS float* scr, int first, int limit, int stride, int lane) {
#define MOE_ITEM(it_, W_, N_, WT_, DR_, K0_, N0_) do { int r_ = (it_); if (r_ < MOE_I_DN) { const int e_ = r_ / 512, q_ = r_ % 512, kb_ = q_ / 32, nb_ = q_ % 32; W_ = wdn + (size_t)e_ * 1024 * 1024; N_ = 1024; \
            WT_ = WDN8 + (size_t)e_ * 1024 * 1024; DR_ = 32 * nb_; K0_ = 64 * kb_; N0_ = 32 * nb_; } \
        else { r_ -= MOE_I_DN; const int e_ = r_ / 1024, q_ = r_ % 1024, kb_ = q_ / 64, nb_ = q_ % 64; const int n0_ = 32 * nb_, half_ = n0_ >> 10, j_ = n0_ & 1023; W_ = wgu + (size_t)e_ * 1024 * 2048; N_ = 2048; \
            WT_ = WGU8 + (size_t)e_ * 2048 * 1024; DR_ = 256 * (j_ >> 7) + 128 * half_ + (j_ & 127); K0_ = 64 * kb_; N0_ = n0_; } } while (0)
    F8Item q0, q1, q2, q3; const float* Wq[4]; int Nq[4], DRq[4], K0q[4], N0q[4]; unsigned char* WTq[4];
#define MOE_PREF(Q_, slot_, it_) do { if ((it_) < limit) { MOE_ITEM((it_), Wq[slot_], Nq[slot_], WTq[slot_], DRq[slot_], K0q[slot_], N0q[slot_]); f8_item_load(Q_, Wq[slot_], Nq[slot_], K0q[slot_], N0q[slot_], lane); } } while (0)
    MOE_PREF(q0, 0, first); MOE_PREF(q1, 1, first + stride); MOE_PREF(q2, 2, first + 2 * stride);
    for (int it = first; it < limit; it += 4 * stride) {
        MOE_PREF(q3, 3, it + 3 * stride); f8_item_finish(q0, 1024, WTq[0], DRq[0], scr, K0q[0], lane);
        if (it + stride < limit) { MOE_PREF(q0, 0, it + 4 * stride); f8_item_finish(q1, 1024, WTq[1], DRq[1], scr, K0q[1], lane); }
        if (it + 2 * stride < limit) { MOE_PREF(q1, 1, it + 5 * stride); f8_item_finish(q2, 1024, WTq[2], DRq[2], scr, K0q[2], lane); }
        if (it + 3 * stride < limit) { MOE_PREF(q2, 2, it + 6 * stride); f8_item_finish(q3, 1024, WTq[3], DRq[3], scr, K0q[3], lane); }
    }
#undef MOE_PREF
#undef MOE_ITEM
}

struct Args { const float* in[25]; float* out; unsigned char* ws; int ph_lo, ph_hi, li, pad; };

__global__ void __launch_bounds__(NWAVES * 64, 2) mk_fwd(Args args) {
    extern __shared__ __attribute__((aligned(16))) unsigned char lds_raw[];
    LAS unsigned char* lds = (LAS unsigned char*)lds_raw;
    volatile LAS unsigned* MISC = (volatile LAS unsigned*)(lds + MISC_OFF);
    const int tid = threadIdx.x, lane = tid & 63, wave = __builtin_amdgcn_readfirstlane(tid >> 6);
    const int G = gridDim.x; const int vcu = (G % 8 == 0) ? ((int)blockIdx.x % 8) * (G / 8) + (int)blockIdx.x / 8 : (int)blockIdx.x;
    const int gw = vcu * NWAVES + wave, NGW = G * NWAVES;
    unsigned char* ws = args.ws;
    unsigned* ctl = (unsigned*)(ws + WS_CTL);
    const float* x = args.in[0];
    bf16* WIN_T = (bf16*)(ws + WS_WIN); bf16* WOUT_T = (bf16*)(ws + WS_WOUT); bf16* WGU_T = (bf16*)(ws + WS_WGU); bf16* WDN_T = (bf16*)(ws + WS_WDN);
    bf16* WUP_T = (bf16*)(ws + WS_LORA); bf16* AUP_T = WUP_T + 512 * 64; bf16* GUP_T = AUP_T + 512 * 64;
    bf16* XN = (bf16*)(ws + WS_XN); bf16* Y = (bf16*)(ws + WS_Y); bf16* P = (bf16*)(ws + WS_P);
    float* SR = (float*)(ws + WS_SR); float* SW = (float*)(ws + WS_SW); float* SK = (float*)(ws + WS_SK); float* SV = (float*)(ws + WS_SV); float* SKK = (float*)(ws + WS_SKK); float* SB = (float*)(ws + WS_SB);
    bf16* SG = (bf16*)(ws + WS_SG); float* BDOT = (float*)(ws + WS_BDOT);
    bf16* X1 = (bf16*)(ws + WS_X1); bf16* XIN = (bf16*)(ws + WS_XIN); bf16* ACT = (bf16*)(ws + WS_ACT); bf16* YSLOT = (bf16*)(ws + WS_YSLOT);
    int* TOKE = (int*)(ws + WS_TOKE); float* TOKG = (float*)(ws + WS_TOKG); int* TOKR = (int*)(ws + WS_TOKR); int* DEST = (int*)(ws + WS_DEST);

    for (int u = tid; u < (LDS_BYTES - LDSCTL_OFF) / 4; u += NWAVES * 64) ((LAS unsigned*)(lds + LDSCTL_OFF))[u] = 0u;
    __syncthreads();
    XcdBarrier bar; bar.bar = ctl + CW_BAR; bar.x = 0; bar.st = nullptr;
    if (N_LAUNCHES == 1) bar = xcd_barrier_post(ctl + CW_BAR, MISC + 8);
#define GRID_BAR() do { if (N_LAUNCHES == 1) xcd_barrier(bar); } while (0)
    const int lo = args.ph_lo, hi = args.ph_hi;
#ifndef PHASE_MASK
#define PHASE_MASK 0x3ff
#endif
#define IN(k) (((PHASE_MASK >> (k)) & 1) && lo <= (k) && (k) < hi)
#define BOTH(k) (IN(k) && IN((k) + 1))

    if (IN(0)) {
        LAS float* scr = (LAS float*)(lds + wave * 16384);
        constexpr int I_IN = 16 * 104, I_OUT = 16 * 32, I_WUP = 16, I_AUP = 16, I_GUP = 32;
        constexpr int NITEMS = I_IN + I_OUT + I_WUP + I_AUP + I_GUP;
        for (int it = gw; it < NITEMS; it += NGW) {
            int r = it;
            if (r < I_IN) { const int kb = r / 104, nb = r % 104; p0_transpose_item_g(args.in[1], 1024, IN_COLS, WIN_T, 32 * nb, scr, 64 * kb, 32 * nb, lane, args.in[16]); continue; } r -= I_IN;
            if (r < I_OUT) { const int kb = r / 32, nb = r % 32; p0_transpose_item(args.in[15], 1024, 1024, WOUT_T, 32 * nb, scr, 64 * kb, 32 * nb, lane); continue; } r -= I_OUT;
            if (r < I_WUP) { p0_transpose_item(args.in[6], 64, 512, WUP_T, 32 * r, scr, 0, 32 * r, lane); continue; } r -= I_WUP;
            if (r < I_AUP) { p0_transpose_item(args.in[8], 64, 512, AUP_T, 32 * r, scr, 0, 32 * r, lane); continue; } r -= I_AUP;
            { const int kb = r / 16, nb = r % 16; p0_transpose_item(args.in[9], 128, 512, GUP_T, 32 * nb, scr, 64 * kb, 32 * nb, lane); }
        }
        float* RMS = (float*)(ws + WS_RMS);
        for (int m = gw; m < M; m += NGW) {
            const GAS f32x4* xr = (const GAS f32x4*)(x + (size_t)m * D) + lane; f32x4 v[4]; float s = 0.f;
#pragma unroll
            for (int j = 0; j < 4; ++j) { v[j] = xr[64 * j]; s += (v[j].x * v[j].x + v[j].y * v[j].y) + (v[j].z * v[j].z + v[j].w * v[j].w); }
            const float ms = wave_sum(s) * (1.f / D) + NORM_EPS; const float rstd = 1.0f / sqrtf(ms);
            if (lane == 0) RMS[m] = sqrtf(ms);
            GAS unsigned long long* o8 = (GAS unsigned long long*)(XN + (size_t)m * D) + lane;
#pragma unroll
            for (int j = 0; j < 4; ++j)
                o8[64 * j] = (unsigned long long)pk2(v[j].x * rstd, v[j].y * rstd) | ((unsigned long long)pk2(v[j].z * rstd, v[j].w * rstd) << 32);
        }
        if (BOTH(0)) GRID_BAR();
    }

    if (IN(1)) {
        constexpr int P1_GEMM_WGS = 208;
        const bool split = (G == 256);
        if (!split || (int)blockIdx.x < P1_GEMM_WGS) {
            pg8::Gemm g{XN, WIN_T, M, IN_COLS, D, 0, 0, nullptr}; pg8::StaticOrder S; S.init(M, IN_COLS, split ? P1_GEMM_WGS : G, (int)blockIdx.x);
            pg8::EpiBiasBf16 E{P, IN_COLS, nullptr, 0};
            pg8::gemm_phase<pg8::EpiBiasBf16, pg8::StaticOrder, PG8_ALIGN, PG8_SP2>(lds, g, S, E);
        } else {
            moe_convert_items(args.in[22], args.in[20], (unsigned char*)WDN_T, (unsigned char*)WGU_T, (LAS float*)(lds + wave * 16384), ((int)blockIdx.x - P1_GEMM_WGS) * NWAVES + wave, MOE_P1_ITEMS, (G - P1_GEMM_WGS) * NWAVES, lane);
        }
        if (BOTH(1)) GRID_BAR();
    }

    if (IN(2)) {
        const float* mu = args.in[4]; const float* w0 = args.in[5]; const float* a0 = args.in[7]; const float* k_k = args.in[10]; const float* k_a = args.in[11]; const float* r_k = args.in[12];
        const float* conv_w = args.in[2]; const float* conv_g = args.in[3];
        v4u* QF = (v4u*)(ws + WS_QF); u32x2* O1F = (u32x2*)(ws + WS_O1); v4u* GF = (v4u*)(ws + WS_GF); v4u* HF = (v4u*)(ws + WS_HF); float* PCG = (float*)(ws + WS_PC);
        v4u* FRG = (v4u*)(ws + WS_FR);
#define PACK8(lo, hi) __builtin_bit_cast(pg8::bf16x8, (v4u){cvtpk_s((lo)[0], (lo)[1]), cvtpk_s((lo)[2], (lo)[3]), cvtpk_s((hi)[0], (hi)[1]), cvtpk_s((hi)[2], (hi)[3])})
#define MFMA16(a, b, c) __builtin_amdgcn_mfma_f32_16x16x32_bf16((a), (b), (c), 0, 0, 0)
        const f32x4 Z4 = (f32x4){0.f, 0.f, 0.f, 0.f};
        const int h = wave;
        {
            LAS float* cst0 = (LAS float*)(lds + 16896 + wave * 16128 + 12288);
            cst0[0 * 64 + lane] = mu[h * 64 + lane]; cst0[1 * 64 + lane] = mu[512 + h * 64 + lane]; cst0[2 * 64 + lane] = mu[1024 + h * 64 + lane]; cst0[3 * 64 + lane] = k_k[h * 64 + lane];
            cst0[4 * 64 + lane] = k_a[h * 64 + lane]; cst0[5 * 64 + lane] = a0[h * 64 + lane]; cst0[6 * 64 + lane] = w0[h * 64 + lane]; cst0[7 * 64 + lane] = r_k[h * 64 + lane];
            LDS_WAIT(); }
        for (int ck = vcu; ck < M / CHK; ck += G) {
            int tid_ = tid; asm volatile("" : "+v"(tid_)); const int lane_ = tid_ & 63;
            const int fr = lane_ & 15, fq = lane_ >> 4;
            LAS unsigned char* wl = lds + 16896 + wave * 16128;
            LAS bf16* TB = (LAS bf16*)wl;
            LAS float* Amat = (LAS float*)(wl + 5120);
            LAS bf16* Tm = (LAS bf16*)(wl + 9728);
            const LAS float* cst = (const LAS float*)(wl + 12288);
            const int T0 = ck * CHK; const int bb = T0 / SEQ, n = (T0 % SEQ) / CHK; const int chh = (bb * NH + h) * NCH + n;
            {
                const int c8 = (tid_ & 31) * 8, tr = tid_ >> 5;
                const f32x4 mu0 = *(const f32x4*)(mu + 1536 + c8), mu1 = *(const f32x4*)(mu + 1536 + c8 + 4);
                const float mm[8] = {mu0.x, mu0.y, mu0.z, mu0.w, mu1.x, mu1.y, mu1.z, mu1.w};
#pragma unroll
                for (int i = 0; i < 2; ++i) { const int tk = tr + 16 * i, t = T0 + tk;
                    const v4u cur = *(const v4u*)(P + (size_t)t * IN_COLS + 3072 + c8);
                    v4u prv = (v4u){0u, 0u, 0u, 0u}; if ((t % SEQ) != 0) prv = *(const v4u*)(P + (size_t)(t - 1) * IN_COLS + 3072 + c8);
                    const unsigned cw[4] = {cur.x, cur.y, cur.z, cur.w}, pw[4] = {prv.x, prv.y, prv.z, prv.w}; float f[8];
#pragma unroll
                    for (int j = 0; j < 4; ++j) { const float c0 = bf_lo(cw[j]), c1 = bf_hi(cw[j]), p0 = bf_lo(pw[j]), p1 = bf_hi(pw[j]);
                        const float q0 = c0 + (p0 - c0) * mm[2 * j], q1 = c1 + (p1 - c1) * mm[2 * j + 1];
                        f[2 * j] = (c8 < 64) ? fast_tanh(q0) : ((c8 < 128) ? q0 : fast_sigmoid(q0)); f[2 * j + 1] = (c8 < 64) ? fast_tanh(q1) : ((c8 < 128) ? q1 : fast_sigmoid(q1)); }
                    v4u o; o.x = pk2(f[0], f[1]); o.y = pk2(f[2], f[3]); o.z = pk2(f[4], f[5]); o.w = pk2(f[6], f[7]);
                    *(LAS v4u*)(lds + tk * 528 + c8 * 2) = o; }
            }
            __syncthreads();
#define TB_WRITE_T(X_, tt_) do { _Pragma("unroll") for (int m_ = 0; m_ < 4; ++m_) _Pragma("unroll") for (int j_ = 0; j_ < 4; ++j_) \
                TB[(16 * m_ + 4 * fq + j_) * 40 + 16 * (tt_) + fr] = (bf16)(cvtpk_s(X_[m_][j_], 0.f) & 0xffffu); } while (0)
#define TB_READ(fbase_) do { LDS_WAIT(); asm volatile("" ::: "memory"); _Pragma("unroll") for (int q_ = 0; q_ < 4; ++q_) { const u32x2 lo_ = *(const LAS u32x2*)(TB + (16 * q_ + fr) * 40 + 4 * fq), hi_ = *(const LAS u32x2*)(TB + (16 * q_ + fr) * 40 + 16 + 4 * fq); \
                frw[((fbase_) + q_) * 64] = (v4u){lo_.x, lo_.y, hi_.x, hi_.y}; } LDS_WAIT(); asm volatile("" ::: "memory"); } while (0)
#define UNPK(w_) ((f32x4){bf_lo((w_).x), bf_hi((w_).x), bf_lo((w_).y), bf_hi((w_).y)})
            const size_t prow0 = (size_t)T0 * IN_COLS + 1536 + h * 64 + 4 * fq;
            f32x4 ev[2][4]; u32x2 avp[2][4]; u32x2 kkp[2][4] = {}, b0p[2][4] = {}, kmp[2][4] = {};
#pragma unroll
            for (int m = 0; m < 4; ++m) { const int row = h * 64 + 16 * m + fr; const int cl = 16 * m + 4 * fq;
                pg8::bf16x8 ww[2], wa[2], wg[4];
#pragma unroll
                for (int ks = 0; ks < 2; ++ks) { ww[ks] = *(const pg8::bf16x8*)(WUP_T + row * 64 + ks * 32 + fq * 8); wa[ks] = *(const pg8::bf16x8*)(AUP_T + row * 64 + ks * 32 + fq * 8); }
#pragma unroll
                for (int ks = 0; ks < 4; ++ks) wg[ks] = *(const pg8::bf16x8*)(GUP_T + row * 128 + ks * 32 + fq * 8);
                const f32x4 a0v = *(const LAS f32x4*)(cst + 5 * 64 + cl), w0v = *(const LAS f32x4*)(cst + 6 * 64 + cl);
#pragma unroll
                for (int tt = 0; tt < 2; ++tt) { const LAS unsigned char* lrow = lds + (16 * tt + fr) * 528 + fq * 16; f32x4 aw = Z4, aa = Z4, ag = Z4;
#pragma unroll
                    for (int ks = 0; ks < 2; ++ks) { aw = MFMA16(ww[ks], *(const LAS pg8::bf16x8*)(lrow + ks * 64), aw); aa = MFMA16(wa[ks], *(const LAS pg8::bf16x8*)(lrow + (2 + ks) * 64), aa); }
#pragma unroll
                    for (int ks = 0; ks < 4; ++ks) ag = MFMA16(wg[ks], *(const LAS pg8::bf16x8*)(lrow + (4 + ks) * 64), ag);
                    f32x4 avv;
#pragma unroll
                    for (int j = 0; j < 4; ++j) { avv[j] = fast_sigmoid(a0v[j] + aa[j]); const float wlin = w0v[j] + aw[j];
                        const float sp = fmaxf(-wlin, 0.f) + 0.69314718056f * __builtin_amdgcn_logf(1.0f + __builtin_amdgcn_exp2f(-1.44269504089f * fabsf(wlin))); ev[tt][m][j] = __builtin_amdgcn_exp2f(-1.44269504089f * (sp + 0.5f)); }
                    avp[tt][m] = (u32x2){cvtpk_s(avv[0], avv[1]), cvtpk_s(avv[2], avv[3])};
                    u32x2 go; go.x = cvtpk_s(ag[0], ag[1]); go.y = cvtpk_s(ag[2], ag[3]); *(u32x2*)(SG + (size_t)(T0 + 16 * tt + fr) * RW + h * 64 + cl) = go; }
                __builtin_amdgcn_sched_barrier(0); }
#pragma unroll 1
            for (int tt = 0; tt < 2; ++tt) { u32x2 kkt[4], b0t[4], kmt[4]; int frl = fr, fql = fq; asm volatile("" : "+v"(frl), "+v"(fql)); const int PFR = frl; const int tk = 16 * tt + frl; const size_t tok = (size_t)(T0 + tk); const bool first = (tok % SEQ) == 0; const size_t prow = (size_t)T0 * IN_COLS + 1536 + h * 64 + 4 * fql + (size_t)tk * IN_COLS;
                f32x4 kq[4]; float ss = 0.f;
#pragma unroll
                for (int m = 0; m < 4; ++m) { const int cl = 16 * m + 4 * fql; const f32x4 muk = *(const LAS f32x4*)(cst + 1 * 64 + cl), kkv = *(const LAS f32x4*)(cst + 3 * 64 + cl);
                    const u32x2 cu = *(const u32x2*)(P + prow + 512 + 16 * m); u32x2 pu = (u32x2){0u, 0u}; if (!first && PFR == 0) pu = *(const u32x2*)(P + prow - IN_COLS + 512 + 16 * m); pu.x = (unsigned)__builtin_amdgcn_update_dpp((int)pu.x, (int)cu.x, 0x111, 0xf, 0xf, false); pu.y = (unsigned)__builtin_amdgcn_update_dpp((int)pu.y, (int)cu.y, 0x111, 0xf, 0xf, false);
                    const f32x4 cf = UNPK(cu), pf = UNPK(pu); kq[m] = cf + (pf - cf) * muk;
#pragma unroll
                    for (int j = 0; j < 4; ++j) { const float kr = kq[m][j] * kkv[j]; ss += kr * kr; } }
                ss += __shfl_xor(ss, 16); ss += __shfl_xor(ss, 32); const float inv = 1.0f / fmaxf(sqrtf(ss), 1e-12f);
#pragma unroll
                for (int m = 0; m < 4; ++m) { const int cl = 16 * m + 4 * fql; const f32x4 kkv = *(const LAS f32x4*)(cst + 3 * 64 + cl), kav = *(const LAS f32x4*)(cst + 4 * 64 + cl);
                    const u32x2 avq = (tt == 0) ? avp[0][m] : avp[1][m]; const f32x4 av = UNPK(avq);
                    const f32x4 kk = kq[m] * kkv * inv, bq = kk * av, kmv = kq[m] * (1.0f + (av - 1.0f) * kav);
                    kkt[m] = (u32x2){cvtpk_s(kk[0], kk[1]), cvtpk_s(kk[2], kk[3])}; b0t[m] = (u32x2){cvtpk_s(bq[0], bq[1]), cvtpk_s(bq[2], bq[3])}; kmt[m] = (u32x2){cvtpk_s(kmv[0], kmv[1]), cvtpk_s(kmv[2], kmv[3])}; }
#pragma unroll
                for (int m = 0; m < 4; ++m) { if (tt == 0) { kkp[0][m] = kkt[m]; b0p[0][m] = b0t[m]; kmp[0][m] = kmt[m]; } else { kkp[1][m] = kkt[m]; b0p[1][m] = b0t[m]; kmp[1][m] = kmt[m]; } }
                asm volatile("" ::: "memory"); __builtin_amdgcn_sched_barrier(0); }
            LAS float* pcl = (LAS float*)(wl + 14336);
#pragma unroll
            for (int m = 0; m < 4; ++m)
#pragma unroll
                for (int j = 0; j < 4; ++j) { float x0 = ev[0][m][j], x1 = ev[1][m][j];
#define DPP_SHR(v_, n_) __builtin_bit_cast(float, __builtin_amdgcn_update_dpp(0, __builtin_bit_cast(int, (v_)), 0x110 + (n_), 0xf, 0xf, false))
                    x0 += DPP_SHR(x0, 1); x1 += DPP_SHR(x1, 1); x0 += DPP_SHR(x0, 2); x1 += DPP_SHR(x1, 2); x0 += DPP_SHR(x0, 4); x1 += DPP_SHR(x1, 4); x0 += DPP_SHR(x0, 8); x1 += DPP_SHR(x1, 8);
                    const float tot0 = __shfl(x0, 15, 16); x1 += tot0; ev[0][m][j] = x0; ev[1][m][j] = x1; }
#define cum ev
            if (fr == 15) {
#pragma unroll
                for (int m = 0; m < 4; ++m) { *(LAS f32x4*)(pcl + 16 * m + 4 * fq) = cum[1][m]; f32x4 pcv;
#pragma unroll
                    for (int j = 0; j < 4; ++j) pcv[j] = __expf(-cum[1][m][j]);
                    *(f32x4*)(PCG + (size_t)chh * 64 + 16 * m + 4 * fq) = pcv; } }
            LDS_WAIT(); asm volatile("" ::: "memory");
            v4u* frw = FRG + (size_t)gw * 32 * 64 + lane_;
#define FR_ST(f_, val_) (frw[(f_) * 64] = __builtin_bit_cast(v4u, (val_)))
            {
                f32x4 em0[4];
#pragma unroll
                for (int tt = 0; tt < 2; ++tt) { f32x4 x1[4];
#pragma unroll
                    for (int m = 0; m < 4; ++m) { const f32x4 kk = UNPK(kkp[tt][m]);
#pragma unroll
                        for (int j = 0; j < 4; ++j) { const float em = __expf(-cum[tt][m][j]); float pv = DPP_SHR(em, 1);
                            if (tt == 0) { em0[m][j] = em; if (fr == 0) pv = 1.0f; } else { const float last0 = __shfl(em0[m][j], 15, 16); if (fr == 0) pv = last0; }
                            x1[m][j] = -kk[j] * pv; } }
#pragma unroll
                    for (int ks = 0; ks < 2; ++ks) FR_ST(0 + 2 * tt + ks, PACK8(x1[2 * ks], x1[2 * ks + 1]));
                    TB_WRITE_T(x1, tt); }
            }
            TB_READ(16);
#pragma unroll
            for (int tt = 0; tt < 2; ++tt) {
                f32x4 x1[4], x2[4];
#pragma unroll
                for (int m = 0; m < 4; ++m) { const f32x4 bq = UNPK(b0p[tt][m]); const f32x4 cC = *(const LAS f32x4*)(pcl + 16 * m + 4 * fq);
#pragma unroll
                    for (int j = 0; j < 4; ++j) { x1[m][j] = bq[j] * __expf(cum[tt][m][j] - cC[j]); x2[m][j] = bq[j] * __expf(cum[tt][m][j]); } }
#pragma unroll
                for (int ks = 0; ks < 2; ++ks) FR_ST(4 + 2 * tt + ks, PACK8(x2[2 * ks], x2[2 * ks + 1]));
                TB_WRITE_T(x1, tt); }
            TB_READ(20);
#pragma unroll
            for (int tt = 0; tt < 2; ++tt) {
                f32x4 x1[4], x2[4];
#pragma unroll
                for (int m = 0; m < 4; ++m) { const f32x4 kmv = UNPK(kmp[tt][m]); const f32x4 cC = *(const LAS f32x4*)(pcl + 16 * m + 4 * fq);
#pragma unroll
                    for (int j = 0; j < 4; ++j) { x1[m][j] = kmv[j] * __expf(cum[tt][m][j] - cC[j]); x2[m][j] = kmv[j] * __expf(cum[tt][m][j]); } }
#pragma unroll
                for (int ks = 0; ks < 2; ++ks) FR_ST(8 + 2 * tt + ks, PACK8(x2[2 * ks], x2[2 * ks + 1]));
                TB_WRITE_T(x1, tt); }
            TB_READ(24);
            pg8::bf16x8 Rt[2][2];
#pragma unroll
            for (int tt = 0; tt < 2; ++tt) {
                f32x4 x1[4]; const int PFR = fr; const int tk = 16 * tt + fr; const bool first = ((T0 + tk) % SEQ) == 0; const size_t prow = prow0 + (size_t)tk * IN_COLS; float bd = 0.f;
#pragma unroll
                for (int m = 0; m < 4; ++m) { const int c = h * 64 + 16 * m + 4 * fq; const f32x4 mur = *(const LAS f32x4*)(cst + 0 * 64 + 16 * m + 4 * fq), rkv = *(const LAS f32x4*)(cst + 7 * 64 + 16 * m + 4 * fq);
                    const u32x2 cu = *(const u32x2*)(P + prow + 16 * m); u32x2 pu = (u32x2){0u, 0u}; if (!first && PFR == 0) pu = *(const u32x2*)(P + prow - IN_COLS + 16 * m); pu.x = (unsigned)__builtin_amdgcn_update_dpp((int)pu.x, (int)cu.x, 0x111, 0xf, 0xf, false); pu.y = (unsigned)__builtin_amdgcn_update_dpp((int)pu.y, (int)cu.y, 0x111, 0xf, 0xf, false);
                    const f32x4 cf = UNPK(cu), pf = UNPK(pu); const f32x4 rq = cf + (pf - cf) * mur; const f32x4 pr = rq * UNPK(kmp[tt][m]) * rkv; bd += (pr.x + pr.y) + (pr.z + pr.w);
#pragma unroll
                    for (int j = 0; j < 4; ++j) x1[m][j] = rq[j] * __expf(-cum[tt][m][j]); }
                bd += __shfl_xor(bd, 16); bd += __shfl_xor(bd, 32);
                if (fq == 0) BDOT[(size_t)(T0 + tk) * NH + h] = bd;
#pragma unroll
                for (int ks = 0; ks < 2; ++ks) Rt[tt][ks] = PACK8(x1[2 * ks], x1[2 * ks + 1]); }
#pragma unroll
            for (int tt = 0; tt < 2; ++tt) {
                f32x4 x1[4]; const int PFR = fr; const int tk = 16 * tt + fr; const bool first = ((T0 + tk) % SEQ) == 0; const size_t prow = prow0 + (size_t)tk * IN_COLS;
#pragma unroll
                for (int m = 0; m < 4; ++m) { const int c = h * 64 + 16 * m + 4 * fq; const f32x4 muv = *(const LAS f32x4*)(cst + 2 * 64 + 16 * m + 4 * fq);
                    const u32x2 cu = *(const u32x2*)(P + prow + 1024 + 16 * m); u32x2 pu = (u32x2){0u, 0u}; if (!first && PFR == 0) pu = *(const u32x2*)(P + prow - IN_COLS + 1024 + 16 * m); pu.x = (unsigned)__builtin_amdgcn_update_dpp((int)pu.x, (int)cu.x, 0x111, 0xf, 0xf, false); pu.y = (unsigned)__builtin_amdgcn_update_dpp((int)pu.y, (int)cu.y, 0x111, 0xf, 0xf, false);
                    const f32x4 cf = UNPK(cu), pf = UNPK(pu); x1[m] = cf + (pf - cf) * muv; *(u32x2*)((bf16*)SV + (size_t)(T0 + tk) * RW + c) = (u32x2){cvtpk_s(x1[m][0], x1[m][1]), cvtpk_s(x1[m][2], x1[m][3])}; }
                TB_WRITE_T(x1, tt); }
            pg8::bf16x8 Vf[4];
            { LDS_WAIT(); asm volatile("" ::: "memory");
#pragma unroll
              for (int q_ = 0; q_ < 4; ++q_) { const u32x2 lo_ = *(const LAS u32x2*)(TB + (16 * q_ + fr) * 40 + 4 * fq), hi_ = *(const LAS u32x2*)(TB + (16 * q_ + fr) * 40 + 16 + 4 * fq); Vf[q_] = __builtin_bit_cast(pg8::bf16x8, (v4u){lo_.x, lo_.y, hi_.x, hi_.y}); }
              LDS_WAIT(); asm volatile("" ::: "memory"); }
            asm volatile("s_waitcnt vmcnt(0)" ::: "memory");
#define FR_LD(f_) __builtin_bit_cast(pg8::bf16x8, __builtin_nontemporal_load(frw + (f_) * 64))
            pg8::bf16x8 Aak[2], Arb[2], Ark[2];
            {
                pg8::bf16x8 At[2][2], Bt[2][2], Kt[2][2];
#pragma unroll
                for (int tt = 0; tt < 2; ++tt)
#pragma unroll
                    for (int ks = 0; ks < 2; ++ks) { At[tt][ks] = FR_LD(0 + 2 * tt + ks); Bt[tt][ks] = FR_LD(4 + 2 * tt + ks); Kt[tt][ks] = FR_LD(8 + 2 * tt + ks); }
                f32x4 Dab[2][2], Dak[2][2], Drb[2][2], Drk[2][2];
#pragma unroll
                for (int jt = 0; jt < 2; ++jt)
#pragma unroll
                    for (int tt = 0; tt < 2; ++tt) { Dab[jt][tt] = Z4; Dak[jt][tt] = Z4; Drb[jt][tt] = Z4; Drk[jt][tt] = Z4;
#pragma unroll
                        for (int ks = 0; ks < 2; ++ks) { Dab[jt][tt] = MFMA16(Bt[jt][ks], At[tt][ks], Dab[jt][tt]); Dak[jt][tt] = MFMA16(Kt[jt][ks], At[tt][ks], Dak[jt][tt]);
                            Drb[jt][tt] = MFMA16(Bt[jt][ks], Rt[tt][ks], Drb[jt][tt]); Drk[jt][tt] = MFMA16(Kt[jt][ks], Rt[tt][ks], Drk[jt][tt]); }
#pragma unroll
                        for (int jj = 0; jj < 4; ++jj) { const int j = 16 * jt + 4 * fq + jj, t = 16 * tt + fr;
                            if (!(j < t)) { Dab[jt][tt][jj] = 0.f; Dak[jt][tt][jj] = 0.f; }
                            if (!(j <= t)) { Drb[jt][tt][jj] = 0.f; Drk[jt][tt][jj] = 0.f; } }
                        *(LAS f32x4*)(Amat + (16 * tt + fr) * 36 + 16 * jt + 4 * fq) = Dab[jt][tt]; }
#pragma unroll
                for (int tt = 0; tt < 2; ++tt) { Aak[tt] = PACK8(Dak[0][tt], Dak[1][tt]); Arb[tt] = PACK8(Drb[0][tt], Drb[1][tt]); Ark[tt] = PACK8(Drk[0][tt], Drk[1][tt]); }
            }
            LDS_WAIT(); asm volatile("" ::: "memory");
            {
                const int col = lane_ & 31; float xs[32];
#pragma unroll
                for (int t = 0; t < 32; ++t) { float s0 = (t == col) ? 1.0f : 0.0f, s1 = 0.f;
#pragma unroll
                    for (int j4 = 0; j4 < (t + 3) / 4; ++j4) { const f32x4 a4 = *(const LAS f32x4*)(Amat + t * 36 + 4 * j4);
                        if (4 * j4 + 0 < t) s0 += a4[0] * xs[4 * j4 + 0]; if (4 * j4 + 1 < t) s1 += a4[1] * xs[4 * j4 + 1];
                        if (4 * j4 + 2 < t) s0 += a4[2] * xs[4 * j4 + 2]; if (4 * j4 + 3 < t) s1 += a4[3] * xs[4 * j4 + 3]; }
                    xs[t] = s0 + s1; }
                if (lane_ < 32) {
#pragma unroll
                    for (int t = 0; t < 32; ++t) Tm[t * 40 + col] = (bf16)f2bf(xs[t]); }
            }
            LDS_WAIT(); asm volatile("" ::: "memory");
            pg8::bf16x8 Tf[2];
#pragma unroll
            for (int tt = 0; tt < 2; ++tt) { const u32x2 lo = *(const LAS u32x2*)(Tm + (16 * tt + fr) * 40 + 4 * fq), hi = *(const LAS u32x2*)(Tm + (16 * tt + fr) * 40 + 16 + 4 * fq);
                Tf[tt] = __builtin_bit_cast(pg8::bf16x8, (v4u){lo.x, lo.y, hi.x, hi.y}); }
            pg8::bf16x8 Wp[4], U0p[4];
            {
                pg8::bf16x8 Y2p[4], Af[4];
#pragma unroll
                for (int q = 0; q < 4; ++q) Af[q] = FR_LD(16 + q);
#pragma unroll
                for (int vt = 0; vt < 4; ++vt) { const f32x4 y0 = MFMA16(Aak[0], Vf[vt], Z4), y1 = MFMA16(Aak[1], Vf[vt], Z4); Y2p[vt] = PACK8(y0, y1); }
#pragma unroll
                for (int q = 0; q < 4; ++q) { const f32x4 wa = MFMA16(Tf[0], Af[q], Z4), wb = MFMA16(Tf[1], Af[q], Z4); Wp[q] = PACK8(wa, wb);
                    const f32x4 u0 = MFMA16(Tf[0], Y2p[q], Z4), u1 = MFMA16(Tf[1], Y2p[q], Z4); U0p[q] = PACK8(u0, u1); }
            }
#pragma unroll
            for (int tt = 0; tt < 2; ++tt) {
                f32x4 qt[4];
#pragma unroll
                for (int ct = 0; ct < 4; ++ct) { const v4u rw = __builtin_bit_cast(v4u, Rt[tt][ct >> 1]); const unsigned r0 = (ct & 1) ? rw.z : rw.x, r1 = (ct & 1) ? rw.w : rw.y;
                    qt[ct] = MFMA16(Wp[ct], Arb[tt], ((f32x4){bf_lo(r0), bf_hi(r0), bf_lo(r1), bf_hi(r1)})); }
#pragma unroll
                for (int ks = 0; ks < 2; ++ks) __builtin_nontemporal_store(__builtin_bit_cast(v4u, PACK8(qt[2 * ks], qt[2 * ks + 1])), QF + (((size_t)chh * 2 + tt) * 2 + ks) * 64 + lane_);
#pragma unroll
                for (int vt = 0; vt < 4; ++vt) { f32x4 o = MFMA16(U0p[vt], Arb[tt], Z4); o = MFMA16(Vf[vt], Ark[tt], o);
                    u32x2 w; w.x = cvtpk_s(o[0], o[1]); w.y = cvtpk_s(o[2], o[3]); __builtin_nontemporal_store(w, O1F + (((size_t)chh * 4 + vt) * 2 + tt) * 64 + lane_); } }
            pg8::bf16x8 Bh[4], Kh[4];
#pragma unroll
            for (int q = 0; q < 4; ++q) { Bh[q] = FR_LD(20 + q); Kh[q] = FR_LD(24 + q); }
#pragma unroll
            for (int m = 0; m < 4; ++m) { f32x4 gt[4];
#pragma unroll
                for (int ct = 0; ct < 4; ++ct) gt[ct] = MFMA16(Wp[ct], Bh[m], Z4);
#pragma unroll
                for (int ks = 0; ks < 2; ++ks) __builtin_nontemporal_store(__builtin_bit_cast(v4u, PACK8(gt[2 * ks], gt[2 * ks + 1])), GF + (((size_t)chh * 4 + m) * 2 + ks) * 64 + lane_); }
#pragma unroll
            for (int mp = 0; mp < 2; ++mp)
#pragma unroll
                for (int vt = 0; vt < 4; ++vt) { f32x4 ha = MFMA16(Bh[2 * mp], U0p[vt], Z4); ha = MFMA16(Kh[2 * mp], Vf[vt], ha); f32x4 hb2 = MFMA16(Bh[2 * mp + 1], U0p[vt], Z4); hb2 = MFMA16(Kh[2 * mp + 1], Vf[vt], hb2);
                    __builtin_nontemporal_store(__builtin_bit_cast(v4u, PACK8(ha, hb2)), HF + (((size_t)chh * 4 + vt) * 2 + mp) * 64 + lane_); }
            {
                const int t0 = T0 + wave * 4, tb0 = t0 % SEQ; const int c8 = lane_ * 8;
                v4u ur[6], cr[6], br[4];
#pragma unroll
                for (int d = 0; d < 6; ++d) { const bool ok = (tb0 + d - 2) >= 0; const size_t ro = (size_t)(t0 + d - 2) * IN_COLS;
                    ur[d] = (v4u){0u, 0u, 0u, 0u}; cr[d] = ur[d]; if (ok) { ur[d] = *(const v4u*)(P + ro + c8); cr[d] = *(const v4u*)(P + ro + 1024 + c8); } }
#pragma unroll
                for (int i = 0; i < 4; ++i) br[i] = *(const v4u*)(P + (size_t)(t0 + i) * IN_COLS + 512 + c8);
                float cw0[8], cw1[8], cw2[8], cg[8];
#pragma unroll
                for (int j = 0; j < 8; ++j) { cw0[j] = conv_w[c8 + j]; cw1[j] = conv_w[512 + c8 + j]; cw2[j] = conv_w[1024 + c8 + j]; cg[j] = conv_g[c8 + j]; }
                float z[6][8];
#pragma unroll
                for (int d = 0; d < 6; ++d) { const unsigned uw[4] = {ur[d].x, ur[d].y, ur[d].z, ur[d].w}, cw[4] = {cr[d].x, cr[d].y, cr[d].z, cr[d].w};
#pragma unroll
                    for (int j = 0; j < 4; ++j) { z[d][2 * j] = bf_lo(uw[j]) * bf_lo(cw[j]); z[d][2 * j + 1] = bf_hi(uw[j]) * bf_hi(cw[j]); } }
#pragma unroll
                for (int i = 0; i < 4; ++i) { const unsigned bw[4] = {br[i].x, br[i].y, br[i].z, br[i].w}; float yv[8], ss = 0.f;
#pragma unroll
                    for (int j = 0; j < 8; ++j) { const float bg = (j & 1) ? bf_hi(bw[j >> 1]) : bf_lo(bw[j >> 1]); const float cv = cw0[j] * z[i][j] + cw1[j] * z[i + 1][j] + cw2[j] * z[i + 2][j]; yv[j] = bg * cv; ss += yv[j] * yv[j]; }
                    ss += __shfl_xor(ss, 1); ss += __shfl_xor(ss, 2); ss += __shfl_xor(ss, 4);
                    const float rs = 1.0f / sqrtf(ss * (1.0f / 64.0f) + NORM_EPS);
                    v4u o; o.x = pk2(yv[0] * rs * cg[0], yv[1] * rs * cg[1]); o.y = pk2(yv[2] * rs * cg[2], yv[3] * rs * cg[3]); o.z = pk2(yv[4] * rs * cg[4], yv[5] * rs * cg[5]); o.w = pk2(yv[6] * rs * cg[6], yv[7] * rs * cg[7]);
                    *(v4u*)(Y + (size_t)(t0 + i) * D + c8) = o; }
            }
            LDS_WAIT();
            __syncthreads();
        }
#undef TB_WRITE_T
#undef DPP_SHR
#undef FR_ST
#undef FR_LD
#undef cum
#undef TB_READ
#undef UNPK
#undef PACK8
#undef MFMA16
        if (BOTH(2)) GRID_BAR();
    }

#define PACK8(lo, hi) __builtin_bit_cast(pg8::bf16x8, (v4u){cvtpk_s((lo)[0], (lo)[1]), cvtpk_s((lo)[2], (lo)[3]), cvtpk_s((hi)[0], (hi)[1]), cvtpk_s((hi)[2], (hi)[3])})
#define MFMA16(a, b, c) __builtin_amdgcn_mfma_f32_16x16x32_bf16((a), (b), (c), 0, 0, 0)
    if (IN(3)) {
        constexpr int RSLOT = 10752, RING_R = 15, RING_D = 13, NSCAN = BATCH * NH * 4;
        static_assert(RSLOT * RING_R <= LDSCTL_OFF && NCH % 2 == 0, "scan ring fits");
        if ((int)blockIdx.x < NSCAN) {
            const int fr = lane & 15, fq = lane >> 4; const int bxs = (int)blockIdx.x; const int vt = (bxs >> 3) & 3, bh = (bxs & 7) + 8 * (bxs >> 5); const bool ldr = wave < 4, act = wave == 0;
            const v4u* GF = (const v4u*)(ws + WS_GF); const v4u* HF = (const v4u*)(ws + WS_HF); const float* PCG = (const float*)(ws + WS_PC); v4u* SF = (v4u*)(ws + WS_SF);
            const int ch0 = bh * NCH;
            f32x4 acc[4];
#pragma unroll
            for (int m = 0; m < 4; ++m) acc[m] = (f32x4){0.f, 0.f, 0.f, 0.f};
#define P3B_ISSUE(step_) do { const int cn_ = ch0 + ((step_) < NCH ? (step_) : NCH - 1); LAS unsigned char* sl_ = lds + ((step_) % RING_R) * RSLOT; \
                __builtin_amdgcn_global_load_lds((const unsigned*)(GF + (((size_t)cn_ * 4 + wave) * 2 + 0) * 64 + lane), (LAS unsigned*)(sl_ + (wave * 2 + 0) * 1024), 16, 0, 0); \
                __builtin_amdgcn_global_load_lds((const unsigned*)(GF + (((size_t)cn_ * 4 + wave) * 2 + 1) * 64 + lane), (LAS unsigned*)(sl_ + (wave * 2 + 1) * 1024), 16, 0, 0); \
                if (wave == 1) { __builtin_amdgcn_global_load_lds((const unsigned*)(HF + (((size_t)cn_ * 4 + vt) * 2 + 0) * 64 + lane), (LAS unsigned*)(sl_ + 8192), 16, 0, 0); \
                                 __builtin_amdgcn_global_load_lds((const unsigned*)(HF + (((size_t)cn_ * 4 + vt) * 2 + 1) * 64 + lane), (LAS unsigned*)(sl_ + 9216), 16, 0, 0); } \
                if (wave == 2) __builtin_amdgcn_global_load_lds((const unsigned*)(PCG + (size_t)cn_ * 64 + lane), (LAS unsigned*)(sl_ + 10240), 4, 0, 0); } while (0)
#define P3B_READ(G_, H_, P_, step_) do { const LAS unsigned char* sl_ = lds + ((step_) % RING_R) * RSLOT; _Pragma("unroll") for (int m = 0; m < 4; ++m) { \
                G_[m][0] = *(const LAS pg8::bf16x8*)(sl_ + (m * 2 + 0) * 1024 + lane * 16); G_[m][1] = *(const LAS pg8::bf16x8*)(sl_ + (m * 2 + 1) * 1024 + lane * 16); \
                P_[m] = *(const LAS f32x4*)(sl_ + 10240 + (16 * m + 4 * fq) * 4); } \
                H_[0] = *(const LAS pg8::bf16x8*)(sl_ + 8192 + lane * 16); H_[1] = *(const LAS pg8::bf16x8*)(sl_ + 9216 + lane * 16); } while (0)
#define P3B_STEP(G_, H_, P_, n_) do { pg8::bf16x8 sb_[2]; _Pragma("unroll") for (int ks = 0; ks < 2; ++ks) { sb_[ks] = PACK8(acc[2 * ks], acc[2 * ks + 1]); SF[(((size_t)(ch0 + (n_)) * 4 + vt) * 2 + ks) * 64 + lane] = __builtin_bit_cast(v4u, sb_[ks]); } \
                _Pragma("unroll") for (int m = 0; m < 4; ++m) { const v4u hw_ = __builtin_bit_cast(v4u, H_[m >> 1]); const unsigned h0w_ = (m & 1) ? hw_.z : hw_.x, h1w_ = (m & 1) ? hw_.w : hw_.y; \
                    f32x4 nw_ = P_[m] * acc[m] + (f32x4){bf_lo(h0w_), bf_hi(h0w_), bf_lo(h1w_), bf_hi(h1w_)}; \
                    nw_ = MFMA16(G_[m][0], sb_[0], nw_); nw_ = MFMA16(G_[m][1], sb_[1], nw_); acc[m] = nw_; } } while (0)
            if (ldr) {
#pragma unroll 1
                for (int s0 = 0; s0 < RING_D; ++s0) P3B_ISSUE(s0);
            }
            for (int n = 0; n < NCH; n += 2) {
                if (wave == 1) asm volatile("s_waitcnt vmcnt(44)" ::: "memory"); else if (wave == 2) asm volatile("s_waitcnt vmcnt(33)" ::: "memory"); else if (ldr) asm volatile("s_waitcnt vmcnt(22)" ::: "memory");
                __builtin_amdgcn_s_barrier(); asm volatile("" ::: "memory");
                if (act) {
                    pg8::bf16x8 gA[4][2], hA[2], gB[4][2], hB[2]; f32x4 pA[4], pB[4];
                    P3B_READ(gA, hA, pA, n); P3B_READ(gB, hB, pB, n + 1);
                    asm volatile("s_waitcnt lgkmcnt(0)" ::: "memory"); __builtin_amdgcn_sched_barrier(0);
                    P3B_STEP(gA, hA, pA, n);
                    P3B_STEP(gB, hB, pB, n + 1);
                }
                if (ldr) { P3B_ISSUE(n + RING_D); P3B_ISSUE(n + RING_D + 1); }
            }
            if (ldr) asm volatile("s_waitcnt vmcnt(0)" ::: "memory");
            __builtin_amdgcn_s_barrier(); asm volatile("" ::: "memory");
#undef P3B_READ
#undef P3B_STEP
#undef P3B_ISSUE
        }
        {
            LAS float* scr = (LAS float*)(lds + wave * 16384);
            const int p1i = (G == 256) ? MOE_P1_ITEMS : 0; const int NSPLIT = p1i + (int)((MOE_NIT - p1i) * 0.74f);
            const bool scanwg = (int)blockIdx.x < NSCAN && G > NSCAN;
            const int nw = scanwg ? NSCAN * NWAVES : (G > NSCAN ? (G - NSCAN) * NWAVES : G * NWAVES);
            const int widx = scanwg ? NSPLIT + (int)blockIdx.x * NWAVES + wave : p1i + (G > NSCAN ? ((int)blockIdx.x - NSCAN) * NWAVES + wave : gw);
            const int ilim = scanwg ? MOE_NIT : (G > NSCAN ? NSPLIT : MOE_NIT);
            moe_convert_items(args.in[22], args.in[20], (unsigned char*)WDN_T, (unsigned char*)WGU_T, scr, widx, ilim, nw, lane);
        }
        if (BOTH(3)) GRID_BAR();
    }

    if (IN(4)) {
        const int fr = lane & 15, fq = lane >> 4;
        const v4u* QF = (const v4u*)(ws + WS_QF); const u32x2* O1F = (const u32x2*)(ws + WS_O1); const v4u* SF = (const v4u*)(ws + WS_SF);
        const float* gnw = args.in[13]; const float* gnb = args.in[14];
        for (int chh = gw; chh < NCHH; chh += NGW) {
            const int n = chh & (NCH - 1), bh = chh >> 8, b = bh >> 3, h = bh & 7;
            const size_t tok0 = (size_t)b * SEQ + (size_t)n * CHK;
            pg8::bf16x8 Sf[4][2], Qf[2][2];
#pragma unroll
            for (int vt = 0; vt < 4; ++vt)
#pragma unroll
                for (int ks = 0; ks < 2; ++ks) Sf[vt][ks] = __builtin_bit_cast(pg8::bf16x8, SF[(((size_t)chh * 4 + vt) * 2 + ks) * 64 + lane]);
#pragma unroll
            for (int tt = 0; tt < 2; ++tt)
#pragma unroll
                for (int ks = 0; ks < 2; ++ks) Qf[tt][ks] = __builtin_bit_cast(pg8::bf16x8, QF[(((size_t)chh * 2 + tt) * 2 + ks) * 64 + lane]);
#pragma unroll
            for (int tt = 0; tt < 2; ++tt) { const size_t tok = tok0 + 16 * tt + fr;
                f32x4 o[4]; float s = 0.f;
#pragma unroll
                for (int vt = 0; vt < 4; ++vt) { const u32x2 w = O1F[(((size_t)chh * 4 + vt) * 2 + tt) * 64 + lane]; o[vt] = (f32x4){bf_lo(w.x), bf_hi(w.x), bf_lo(w.y), bf_hi(w.y)};
                    o[vt] = MFMA16(Sf[vt][0], Qf[tt][0], o[vt]); o[vt] = MFMA16(Sf[vt][1], Qf[tt][1], o[vt]); s += (o[vt][0] + o[vt][1]) + (o[vt][2] + o[vt][3]); }
                s += __shfl_xor(s, 16); s += __shfl_xor(s, 32);
                const float mean = s * (1.0f / 64.0f); float q = 0.f;
#pragma unroll
                for (int vt = 0; vt < 4; ++vt) { o[vt] = o[vt] - mean; q += (o[vt][0] * o[vt][0] + o[vt][1] * o[vt][1]) + (o[vt][2] * o[vt][2] + o[vt][3] * o[vt][3]); }
                q += __shfl_xor(q, 16); q += __shfl_xor(q, 32);
                const float rs = 1.0f / sqrtf(q * (1.0f / 64.0f) + GN_EPS); const float bd = BDOT[tok * NH + h];
#pragma unroll
                for (int vt = 0; vt < 4; ++vt) { const int c = h * 64 + 16 * vt + 4 * fq; const f32x4 gw4 = *(const f32x4*)(gnw + c), gb4 = *(const f32x4*)(gnb + c), vv = ({ const u32x2 vw_ = *(const u32x2*)((const bf16*)SV + tok * RW + c); (f32x4){bf_lo(vw_.x), bf_hi(vw_.x), bf_lo(vw_.y), bf_hi(vw_.y)}; });
                    const u32x2 gg = *(const u32x2*)(SG + tok * RW + c); const f32x4 g4 = (f32x4){bf_lo(gg.x), bf_hi(gg.x), bf_lo(gg.y), bf_hi(gg.y)};
                    const f32x4 yv = (o[vt] * rs * gw4 + gb4 + bd * vv) * g4;
                    u32x2 w; w.x = cvtpk_s(yv[0], yv[1]); w.y = cvtpk_s(yv[2], yv[3]); *(u32x2*)(Y + tok * D + 512 + c) = w; } }
        }
#undef PACK8
#undef MFMA16
        if (BOTH(4)) GRID_BAR();
    }

    if (IN(5)) {
        pg8::Gemm g{Y, WOUT_T, M, D, D, 0, 0, nullptr}; pg8::StaticOrder S; S.init(M, D, G, (int)blockIdx.x);
        pg8::EpiResXn E{(const pg8::bf16_t*)XN, (const float*)(ws + WS_RMS), (pg8::bf16_t*)X1, D};
        pg8::gemm_phase<pg8::EpiResXn, pg8::StaticOrder, PG8_ALIGN, PG8_SP2>(lds, g, S, E);
        if (BOTH(5)) GRID_BAR();
    }

    if (IN(6)) {
        const float* gf = args.in[17]; const float* wr = args.in[18]; const float* br = args.in[19]; int* LISTG = (int*)(ws + WS_LIST);
        constexpr int WRS2 = 1032;
        LAS unsigned short* wH = (LAS unsigned short*)lds;
        LAS unsigned short* wL = wH + 32 * WRS2;
#pragma unroll
        for (int q = 0; q < 8; ++q) { const int i4 = tid + q * NWAVES * 64, kp = i4 >> 3, e0 = (i4 & 7) * 4;
            const f32x4 wa = *(const f32x4*)(wr + (2 * kp) * 32 + e0), wb = *(const f32x4*)(wr + (2 * kp + 1) * 32 + e0); const float ga = gf[2 * kp], gb = gf[2 * kp + 1];
#pragma unroll
            for (int j = 0; j < 4; ++j) { const float va = wa[j] * ga, vb = wb[j] * gb; const unsigned ha = f2bf(va), hb = f2bf(vb);
                const unsigned la = f2bf(va - __uint_as_float(ha << 16)), lb = f2bf(vb - __uint_as_float(hb << 16));
                ((LAS unsigned*)(wH + (e0 + j) * WRS2))[kp] = ha | (hb << 16); ((LAS unsigned*)(wL + (e0 + j) * WRS2))[kp] = la | (lb << 16); } }
        __syncthreads();
        const int fr = lane & 15, fq = lane >> 4;
        LAS unsigned* lcnt = (LAS unsigned*)(lds + 2 * 32 * WRS2 * 2);
        for (int it = 0; it < (M / 16 + NGW - 1) / NGW; ++it) {
            int tile = gw + it * NGW; const bool live = tile < M / 16; if (!live) tile = M / 16 - 1;
            if (tid < 64) lcnt[tid] = 0u;
            __syncthreads();
            const int t = tile * 16 + fr;
            const bf16* xrow = X1 + (size_t)t * D + 8 * fq;
            const LAS unsigned short* h0p = wH + fr * WRS2 + 8 * fq; const LAS unsigned short* h1p = wH + (16 + fr) * WRS2 + 8 * fq;
            const LAS unsigned short* l0p = wL + fr * WRS2 + 8 * fq; const LAS unsigned short* l1p = wL + (16 + fr) * WRS2 + 8 * fq;
            f32x4 acc0 = (f32x4){0.f, 0.f, 0.f, 0.f}, acc1 = acc0; float ss = 0.f;
#pragma unroll 4
            for (int sp = 0; sp < 32; ++sp) {
                const pg8::u32x4 xw = *(const pg8::u32x4*)(xrow + 32 * sp); const pg8::bf16x8 xb = __builtin_bit_cast(pg8::bf16x8, xw);
                const pg8::bf16x8 h0 = *(const LAS pg8::bf16x8*)(h0p + 32 * sp), h1 = *(const LAS pg8::bf16x8*)(h1p + 32 * sp), l0 = *(const LAS pg8::bf16x8*)(l0p + 32 * sp), l1 = *(const LAS pg8::bf16x8*)(l1p + 32 * sp);
                const f32x4 x0 = (f32x4){__uint_as_float(xw.x << 16), __uint_as_float(xw.x & 0xffff0000u), __uint_as_float(xw.y << 16), __uint_as_float(xw.y & 0xffff0000u)};
                const f32x4 x1 = (f32x4){__uint_as_float(xw.z << 16), __uint_as_float(xw.z & 0xffff0000u), __uint_as_float(xw.w << 16), __uint_as_float(xw.w & 0xffff0000u)};
                ss += ((x0[0] * x0[0] + x0[1] * x0[1]) + (x0[2] * x0[2] + x0[3] * x0[3])) + ((x1[0] * x1[0] + x1[1] * x1[1]) + (x1[2] * x1[2] + x1[3] * x1[3]));
                acc0 = __builtin_amdgcn_mfma_f32_16x16x32_bf16(l0, xb, acc0, 0, 0, 0); acc1 = __builtin_amdgcn_mfma_f32_16x16x32_bf16(l1, xb, acc1, 0, 0, 0);
                acc0 = __builtin_amdgcn_mfma_f32_16x16x32_bf16(h0, xb, acc0, 0, 0, 0); acc1 = __builtin_amdgcn_mfma_f32_16x16x32_bf16(h1, xb, acc1, 0, 0, 0);
            }
            ss += __shfl_xor(ss, 16); ss += __shfl_xor(ss, 32);
            const float rstd = 1.0f / sqrtf(ss * (1.f / D) + NORM_EPS);
            float lg[8]; const f32x4 b0 = *(const f32x4*)(br + 4 * fq), b1 = *(const f32x4*)(br + 16 + 4 * fq);
#pragma unroll
            for (int j = 0; j < 4; ++j) { lg[j] = acc0[j] * rstd + b0[j]; lg[4 + j] = acc1[j] * rstd + b1[j]; }
            int te[4]; float tv[4];
#pragma unroll
            for (int r = 0; r < 4; ++r) { float bv = lg[0]; int bi = 4 * fq;
#pragma unroll
                for (int j = 1; j < 8; ++j) { const int ei = (j < 4) ? 4 * fq + j : 16 + 4 * fq + (j - 4); if (lg[j] > bv) { bv = lg[j]; bi = ei; } }
#pragma unroll
                for (int o = 16; o <= 32; o <<= 1) { const float ov = __shfl_xor(bv, o); const int oi = __shfl_xor(bi, o); if (ov > bv || (ov == bv && oi < bi)) { bv = ov; bi = oi; } }
                te[r] = bi; tv[r] = bv;
#pragma unroll
                for (int j = 0; j < 8; ++j) { const int ei = (j < 4) ? 4 * fq + j : 16 + 4 * fq + (j - 4); if (ei == bi) lg[j] = -3.0e38f; } }
            const float e1 = __expf(tv[1] - tv[0]), e2 = __expf(tv[2] - tv[0]), e3 = __expf(tv[3] - tv[0]); const float inv = 1.0f / (1.0f + e1 + e2 + e3);
            int rk[4] = {0, 0, 0, 0};
            if (fq == 0 && live) {
#pragma unroll
                for (int r = 0; r < 4; ++r) rk[r] = (int)__hip_atomic_fetch_add(lcnt + te[r], 1u, __ATOMIC_RELAXED, __HIP_MEMORY_SCOPE_WORKGROUP); }
            __syncthreads();
            if (tid < 32) { const unsigned c = lcnt[tid]; lcnt[32 + tid] = c ? __hip_atomic_fetch_add(ctl + CW_CNT + tid, c, __ATOMIC_RELAXED, __HIP_MEMORY_SCOPE_AGENT) : 0u; }
            __syncthreads();
            if (fq == 0 && live) {
#pragma unroll
                for (int r = 0; r < 4; ++r) rk[r] += (int)lcnt[32 + te[r]];
                *(int4*)(TOKE + (size_t)t * 4) = make_int4(te[0], te[1], te[2], te[3]); *(f32x4*)(TOKG + (size_t)t * 4) = (f32x4){inv, e1 * inv, e2 * inv, e3 * inv}; *(int4*)(TOKR + (size_t)t * 4) = make_int4(rk[0], rk[1], rk[2], rk[3]);
#pragma unroll
                for (int r = 0; r < 4; ++r) LISTG[(size_t)te[r] * M + rk[r]] = t; }
            if (live)
#pragma unroll 4
            for (int r = 0; r < 16; ++r) { const float rs = __shfl(rstd, r); const size_t row = (size_t)(tile * 16 + r) * D;
                GAS u32x2* o8 = (GAS u32x2*)((unsigned char*)XN + row) + lane;
#pragma unroll
                for (int j = 0; j < 2; ++j) { const pg8::u32x4 xw = ((const GAS pg8::u32x4*)(X1 + row))[lane + 64 * j]; const f32x4 g0 = ((const GAS f32x4*)gf)[2 * (lane + 64 * j)], g1 = ((const GAS f32x4*)gf)[2 * (lane + 64 * j) + 1];
                    u32x2 w;
                    w.x = pk4_fp8(__uint_as_float(xw.x << 16) * rs * g0.x, __uint_as_float(xw.x & 0xffff0000u) * rs * g0.y, __uint_as_float(xw.y << 16) * rs * g0.z, __uint_as_float(xw.y & 0xffff0000u) * rs * g0.w, F8_H_SCALE);
                    w.y = pk4_fp8(__uint_as_float(xw.z << 16) * rs * g1.x, __uint_as_float(xw.z & 0xffff0000u) * rs * g1.y, __uint_as_float(xw.w << 16) * rs * g1.z, __uint_as_float(xw.w & 0xffff0000u) * rs * g1.w, F8_H_SCALE);
                    o8[64 * j] = w; } }
        }
        __syncthreads();
        if (BOTH(6)) GRID_BAR();
    }

#define MOE_BUILD_TABLES() \
        LAS int* tabL = (LAS int*)(lds + MOE_TAB_OFF); LAS bf16* biasL = (LAS bf16*)(lds + MOE_BIAS_OFF); LAS int* metaL = (LAS int*)(lds + MOE_TOK_OFF + MOE_MAXU * 512);     \
        if (wave == 0) { unsigned cntv = 0u; if (lane < 32) cntv = __hip_atomic_load(ctl + CW_CNT + lane, __ATOMIC_RELAXED, __HIP_MEMORY_SCOPE_AGENT); \
            const int ntile = (int)((cntv + 255u) >> 8); int incl = ntile; \
            _Pragma("unroll") for (int o = 1; o < 32; o <<= 1) { const int nn = __shfl_up(incl, o); if (lane >= o) incl += nn; } \
            const int tst = incl - ntile; \
            if (lane < 32) { metaL[lane] = tst; metaL[32 + lane] = (int)cntv; for (int i = 0; i < ntile; ++i) tabL[tst + i] = lane; } \
            if (lane == 31) metaL[64] = incl; } \
        LDS_WAIT(); __syncthreads(); \
        const int MT = metaL[64];
    if (IN(7)) {
        MOE_BUILD_TABLES();
        LAS unsigned short* tokL = (LAS unsigned short*)(lds + MOE_TOK_OFF);
        { const int pnw = ((int)blockIdx.x >> 3) % 8;
          const float* bgu = args.in[21];
          for (int i = tid; i < 32 * 256; i += NWAVES * 64) { const int e = i >> 8, j = i & 255; biasL[i] = (bf16)f2bf(bgu[e * 2048 + (j >> 7) * 1024 + pnw * 128 + (j & 127)]); }
          const int* LISTG = (const int*)(ws + WS_LIST); const int per_round = G / 8, mpx = per_round / 8, xcd = (int)blockIdx.x & 7, loc = (int)blockIdx.x >> 3;
          int tokv[MOE_MAXU * 256 / (NWAVES * 64)];
#pragma unroll
          for (int q = 0; q < MOE_MAXU * 256 / (NWAVES * 64); ++q) { const int idx = tid + q * NWAVES * 64, u = idx >> 8, r = idx & 255; const int mt = u * per_round + xcd * mpx + loc / 8; tokv[q] = 0;
              if (mt < MT) { const int e = tabL[mt]; const int lr = (mt - metaL[e]) * 256 + r; if (lr < metaL[32 + e]) tokv[q] = LISTG[(size_t)e * M + lr]; } }
#pragma unroll
          for (int q = 0; q < MOE_MAXU * 256 / (NWAVES * 64); ++q) tokL[tid + q * NWAVES * 64] = (unsigned short)tokv[q];
          LDS_WAIT(); __syncthreads(); }
        pg8::Gemm g{XN, WGU_T, SLOT_ROWS, 2048, D / 2, F8_W_BYTE, F8_H_BYTE, (const LAS unsigned short*)tokL};         pg8::MoeOrder S{(const LAS int*)tabL, MT, 8, G, (int)blockIdx.x};
        pg8::EpiSwiGLU E{ACT, FF, (const LAS unsigned short*)biasL};
        pg8::gemm_phase<pg8::EpiSwiGLU, pg8::MoeOrder, PG8_ALIGN, PG8_SP2, true, true>(lds, g, S, E);
        if (BOTH(7)) GRID_BAR();
    }

    if (IN(8)) {
        MOE_BUILD_TABLES();
        { const int pnw = ((int)blockIdx.x >> 3) % 4;
          const float* bdn = args.in[23];
          for (int i = tid; i < 32 * 256; i += NWAVES * 64) { const int e = i >> 8, j = i & 255; biasL[i] = (bf16)f2bf(bdn[e * 1024 + pnw * 256 + j]); }
          LDS_WAIT(); __syncthreads(); }
        pg8::Gemm g{ACT, WDN_T, SLOT_ROWS, 1024, FF / 2, F8_W_BYTE, F8_ACT_BYTE}; pg8::MoeOrder S{(const LAS int*)tabL, MT, 4, G, (int)blockIdx.x};
        pg8::EpiBiasLdsBf16 E{YSLOT, D, (const LAS unsigned short*)biasL};
        pg8::gemm_phase<pg8::EpiBiasLdsBf16, pg8::MoeOrder, PG8_ALIGN, PG8_SP2, true>(lds, g, S, E);
        if (BOTH(8)) GRID_BAR();
    }

    if (IN(9)) {
        const float* gfin = args.in[24];
        unsigned cntv = 0u; if (lane < 32) cntv = __hip_atomic_load(ctl + CW_CNT + lane, __ATOMIC_RELAXED, __HIP_MEMORY_SCOPE_AGENT);
        const int padded = (int)((cntv + 255u) & ~255u); int incl = padded;
#pragma unroll
        for (int o = 1; o < 32; o <<= 1) { const int nn = __shfl_up(incl, o); if (lane >= o) incl += nn; }
        const int pstart = incl - padded;
        for (int t = gw; t < M; t += NGW) {
            const GAS u32x2* xr = (const GAS u32x2*)(X1 + (size_t)t * D) + lane; f32x4 v[4];
#pragma unroll
            for (int j = 0; j < 4; ++j) { const u32x2 xw = xr[64 * j]; v[j] = (f32x4){__uint_as_float(xw.x << 16), __uint_as_float(xw.x & 0xffff0000u), __uint_as_float(xw.y << 16), __uint_as_float(xw.y & 0xffff0000u)}; }
            const int4 e4 = *(const int4*)(TOKE + (size_t)t * 4), r4 = *(const int4*)(TOKR + (size_t)t * 4); const f32x4 g4 = *(const f32x4*)(TOKG + (size_t)t * 4);
            const int dd[4] = {__shfl(pstart, e4.x) + r4.x, __shfl(pstart, e4.y) + r4.y, __shfl(pstart, e4.z) + r4.z, __shfl(pstart, e4.w) + r4.w}; const float gg[4] = {g4.x, g4.y, g4.z, g4.w};
#pragma unroll
            for (int q = 0; q < 4; ++q) { const GAS unsigned* yr = (const GAS unsigned*)((const unsigned char*)YSLOT + (size_t)dd[q] * D) + lane; const float gq8 = gg[q] * 0.125f;
#pragma unroll
                for (int j = 0; j < 4; ++j) { const unsigned w = yr[64 * j]; const f32x2_t lo = __builtin_amdgcn_cvt_pk_f32_fp8((int)w, false), hi = __builtin_amdgcn_cvt_pk_f32_fp8((int)w, true);
                    v[j].x += gq8 * lo.x; v[j].y += gq8 * lo.y; v[j].z += gq8 * hi.x; v[j].w += gq8 * hi.y; } }
            float s = 0.f;
#pragma unroll
            for (int j = 0; j < 4; ++j) s += (v[j].x * v[j].x + v[j].y * v[j].y) + (v[j].z * v[j].z + v[j].w * v[j].w);
            const float rstd = 1.0f / sqrtf(wave_sum(s) * (1.f / D) + NORM_EPS);
            GAS f32x4* orow = (GAS f32x4*)(args.out + (size_t)t * D) + lane;
#pragma unroll
            for (int j = 0; j < 4; ++j) { const f32x4 gq = ((const GAS f32x4*)gfin)[lane + 64 * j]; orow[64 * j] = v[j] * rstd * gq; }
        }
    }
#undef IN
#undef BOTH
#undef GRID_BAR
}

extern "C" void kernel_launch(void* const* d_in, const int* in_sizes, int n_in, void* d_out, int out_size, void* d_ws, size_t ws_size, hipStream_t stream) {
    static int grid = 0;
    if (grid == 0) {
        if (n_in != 25 || in_sizes[0] != M * D || out_size != M * D || ws_size < WS_END) { fprintf(stderr, "kernel_launch: unexpected shapes / workspace (%d inputs, ws %zu)\n", n_in, ws_size); grid = -1; return; }
        int dev = 0, cus = 0, per_cu = 0;
        if (hipGetDevice(&dev) != hipSuccess || hipDeviceGetAttribute(&cus, hipDeviceAttributeMultiprocessorCount, dev) != hipSuccess) { grid = -1; return; }
        if (hipFuncSetAttribute((const void*)mk_fwd, hipFuncAttributeMaxDynamicSharedMemorySize, LDS_BYTES) != hipSuccess) { grid = -1; return; }
        if (hipOccupancyMaxActiveBlocksPerMultiprocessor(&per_cu, (const void*)mk_fwd, NWAVES * 64, LDS_BYTES) != hipSuccess || per_cu < 1) { fprintf(stderr, "kernel_launch: occupancy query says %d blocks per CU\n", per_cu); grid = -1; (void)hipGetLastError(); return; }
        (void)hipGetLastError();
        grid = cus;
    }
    if (grid < 0) return;
    if (hipMemsetAsync((char*)d_ws + WS_CTL, 0, CTL_ZERO_BYTES, stream) != hipSuccess) return;
    Args a{};
    for (int i = 0; i < 25; ++i) a.in[i] = (const float*)d_in[i];
    a.out = (float*)d_out; a.ws = (unsigned char*)d_ws;
    if (N_LAUNCHES == 1) { a.ph_lo = 0; a.ph_hi = NPHASE; a.li = 0; hipLaunchKernelGGL(mk_fwd, dim3(grid), dim3(NWAVES * 64), LDS_BYTES, stream, a); }
    else for (int li = 0; li < NPHASE; ++li) { a.ph_lo = li; a.ph_hi = li + 1; a.li = li; hipLaunchKernelGGL(mk_fwd, dim3(grid), dim3(NWAVES * 64), LDS_BYTES, stream, a); }
}
```

```cpp
#include <hip/hip_runtime.h>
#include <cstdio>
#include <cstdint>
namespace pg8 {
#define PG8_LAS __attribute__((address_space(3)))
typedef unsigned short bf16_t;
typedef short bf16x8 __attribute__((ext_vector_type(8)));
typedef float f32x4 __attribute__((ext_vector_type(4)));
typedef unsigned u32x4 __attribute__((ext_vector_type(4)));
constexpr int BM = 256, BK = 64, HALF = 128, HTB = HALF * BK * 2  , STAGE_BYTES = 8 * HTB, NXCD = 8, WGM = 8;

__host__ __device__ __forceinline__ int lds_byte(int r, int c) { const int st = (r >> 4) * 2 + (c >> 5), rr = r & 15, cc = c & 31, ob = rr * 64 + cc * 2; return st * 1024 + (ob ^ (((ob >> 9) & 1) << 5)); }
__host__ __device__ __forceinline__ void stage_rc(int b, int& R, int& C) { const int st = b / 1024, sb = b % 1024, swz = sb ^ (((sb >> 9) & 1) << 5); R = (st >> 1) * 16 + swz / 64; C = (st & 1) * 32 + (swz % 64) / 2; }
__host__ __device__ __forceinline__ int perm32(int rho) { const int n = rho >> 4, i = rho & 15; return 8 * (i >> 2) + 4 * n + (i & 3); }

struct Unit { int pm, pn, pb, e; };
struct Gemm { const bf16_t* A; const bf16_t* Bt; int M, N, K; int scl_w, scl_a; const PG8_LAS unsigned short* tokL; };

struct StaticOrder {
    int nM, nN, nwg, G, c;
    __host__ __device__ void init(int M, int N, int G_, int c_) { nM = M / BM; nN = N / BM; nwg = nM * nN; G = G_; c = c_; }
    __host__ __device__ bool next(int i, Unit& u) const {
        const long L = (long)i * G + c; if (L >= nwg) return false;
        int wgid = (int)L; { const int q = nwg / NXCD, r = nwg % NXCD, xcd = wgid % NXCD, off = wgid / NXCD; wgid = (xcd < r ? xcd * (q + 1) : r * (q + 1) + (xcd - r) * q) + off; }
        const int nig = WGM * nN, gid = wgid / nig, fm = gid * WGM, gsz = (nM - fm) < WGM ? (nM - fm) : WGM;
        u.pm = fm + ((wgid % nig) % gsz); u.pn = (wgid % nig) / gsz; u.pb = u.pn; u.e = 0; return true;
    }
    __device__ __forceinline__ void a_ready(const Unit&) const {}
    __device__ __forceinline__ void done(const Unit&) const {}
};

__device__ __forceinline__ unsigned cvt_pk_bf16(float lo, float hi) { unsigned r; asm volatile("v_cvt_pk_bf16_f32 %0, %1, %2" : "=v"(r) : "v"(lo), "v"(hi)); return r; }
typedef float f32x2 __attribute__((ext_vector_type(2)));
__device__ __forceinline__ f32x2 gelu_pk(f32x2 v) {
    const f32x2 av = __builtin_elementwise_abs(v), d = av * 0.2316418882f + 1.0f;
    f32x2 t; t.x = __builtin_amdgcn_rcpf(d.x); t.y = __builtin_amdgcn_rcpf(d.y);
    f32x2 q = t * 0.5307027145f + (-0.7265760135f); q = q * t + 0.7107068705f; q = q * t + (-0.142248368f); q = q * t + 0.127414796f; q = q * t;
    const f32x2 s = (v * v) * (-0.72134752044f);
    f32x2 e; e.x = __builtin_amdgcn_exp2f(s.x); e.y = __builtin_amdgcn_exp2f(s.y);
    const f32x2 m = v * (q * e), r = v - m;
    f32x2 o; o.x = v.x < 0.f ? m.x : r.x; o.y = v.y < 0.f ? m.y : r.y; return o;
}

template <int ACT  > struct EpiBf16 {
    static constexpr bool PERM = true, AFTER_DRAIN = false; static_assert(ACT == 0 || ACT == 1, "EpiBf16: ACT is 0 (none) or 1 (gelu_pk)");
    bf16_t* O; int ldc; const float* bias; int split_cols; size_t split_stride; float scale0;
    __device__ __forceinline__ void operator()(const f32x4 (&acc)[2][2][4][2], const Unit& u, int wr, int wc, int fr, int fq) const {
        const int row0 = u.pm * BM + wr * 64 + fr; int colt = u.pn * BM; bf16_t* base = O;
        float sc = 1.f; if (split_cols) { const int t = colt / split_cols; base += (size_t)t * split_stride; colt -= t * split_cols; if (t == 0) sc = scale0; }
        const int col0 = colt + wc * 32 + 8 * fq, bcol0 = u.pn * BM + wc * 32 + 8 * fq;
        f32x4 bv[2][2];
#pragma unroll
        for (int bj = 0; bj < 2; ++bj)
#pragma unroll
            for (int n = 0; n < 2; ++n) bv[bj][n] = bias ? *(const f32x4*)(bias + bcol0 + bj * HALF + 4 * n) : (f32x4){0.f, 0.f, 0.f, 0.f};
#pragma unroll
        for (int ai = 0; ai < 2; ++ai)
#pragma unroll
            for (int m = 0; m < 4; ++m) { bf16_t* rowp = base + (size_t)(row0 + ai * HALF + m * 16) * ldc + col0;
#pragma unroll
                for (int bj = 0; bj < 2; ++bj) { f32x4 v0 = acc[ai][bj][m][0] + bv[bj][0], v1 = acc[ai][bj][m][1] + bv[bj][1];
                    if (ACT == 1) { f32x2 a = gelu_pk((f32x2){v0[0], v0[1]}), b = gelu_pk((f32x2){v0[2], v0[3]}), c = gelu_pk((f32x2){v1[0], v1[1]}), d = gelu_pk((f32x2){v1[2], v1[3]});
                        v0 = (f32x4){a.x, a.y, b.x, b.y}; v1 = (f32x4){c.x, c.y, d.x, d.y}; }
                    v0 = v0 * sc; v1 = v1 * sc; u32x4 w; w.x = cvt_pk_bf16(v0[0], v0[1]); w.y = cvt_pk_bf16(v0[2], v0[3]); w.z = cvt_pk_bf16(v1[0], v1[1]); w.w = cvt_pk_bf16(v1[2], v1[3]);
                    *(u32x4*)(rowp + bj * HALF) = w; } }
    }
};

typedef int v8i_t __attribute__((ext_vector_type(8))); typedef int v4i_t __attribute__((ext_vector_type(4)));
__device__ __forceinline__ v8i_t cat8(bf16x8 lo, bf16x8 hi) { return __builtin_shufflevector(__builtin_bit_cast(v4i_t, lo), __builtin_bit_cast(v4i_t, hi), 0, 1, 2, 3, 4, 5, 6, 7); }
template <class Epi, class Sched, bool ALIGN_EPI = false, bool SP2 = false, bool FP8 = false, bool GATHER = false>
__device__ __forceinline__ void gemm_phase(PG8_LAS unsigned char* lds, const Gemm g, const Sched& S, const Epi& E) {
    const int tid = threadIdx.x, wid = __builtin_amdgcn_readfirstlane(tid >> 6), lane = tid & 63, wr = wid >> 2, wc = wid & 3, fr = lane & 15, fq = lane >> 4;
    const int K = g.K, nt = K / BK;
    unsigned voffA[2], voffB[2];
#pragma unroll
    for (int i = 0; i < 2; ++i) { int R, C; stage_rc(tid * 16 + i * 8192, R, C); const int Rb = Epi::PERM ? ((R & ~31) + perm32(R & 31)) : R;
        voffA[i] = (unsigned)(R * K + C) * 2u; voffB[i] = (unsigned)(Rb * K + C) * 2u; }
    unsigned voffAc[2][2] = {{0u, 0u}, {0u, 0u}}, voffAn[2][2] = {{0u, 0u}, {0u, 0u}}; int gRA[2] = {0, 0}; unsigned gCb[2] = {0u, 0u};
    if constexpr (GATHER) {
#pragma unroll
        for (int i = 0; i < 2; ++i) { int R, C; stage_rc(tid * 16 + i * 8192, R, C); gRA[i] = R; gCb[i] = (unsigned)C * 2u; } }
#define PG8_GVOFF(dst, uidx) do { _Pragma("unroll") for (int h_ = 0; h_ < 2; ++h_) _Pragma("unroll") for (int i_ = 0; i_ < 2; ++i_) dst[h_][i_] = (unsigned)g.tokL[(uidx) * 256 + 128 * h_ + gRA[i_]] * (unsigned)(K * 2) + gCb[i_]; } while (0)
    const size_t kstep = (size_t)(BK * 2);
    const size_t hstep = (size_t)HALF * K * 2;
    const size_t tstep = 2 * hstep;
    const unsigned ldsw = (unsigned)wid * 1024u;
    const int aoff = lds_byte(wr * 64 + fr, fq * 8), boff = lds_byte(wc * 32 + fr, fq * 8);
#define PG8_SA(b, h) (((b) * 2 + (h)) * HTB)
#define PG8_SB(b, h) ((4 + (b) * 2 + (h)) * HTB)
#define PG8_STAGE(bufoff, gbase, voff) do { _Pragma("unroll") for (int _i = 0; _i < 2; ++_i) \
        __builtin_amdgcn_global_load_lds((const unsigned*)((const char*)(gbase) + (voff)[_i]), (PG8_LAS unsigned*)(lds + (bufoff) + ldsw + _i * 8192), 16, 0, 0); } while (0)
#define PG8_STAGE_A(bufoff, gbase, half, nx) do { if constexpr (GATHER) { const unsigned v0_ = (nx) ? voffAn[half][0] : voffAc[half][0], v1_ = (nx) ? voffAn[half][1] : voffAc[half][1]; \
        __builtin_amdgcn_global_load_lds((const unsigned*)((const char*)(gbase) + v0_), (PG8_LAS unsigned*)(lds + (bufoff) + ldsw), 16, 0, 0); \
        __builtin_amdgcn_global_load_lds((const unsigned*)((const char*)(gbase) + v1_), (PG8_LAS unsigned*)(lds + (bufoff) + ldsw + 8192), 16, 0, 0); } \
        else { PG8_STAGE(bufoff, (gbase) + (half) * hstep, voffA); } } while (0)
#define PG8_LDA(dst, b, h) do { if constexpr (FP8) { _Pragma("unroll") for (int m = 0; m < 4; ++m) dst##8[m] = cat8(*(const PG8_LAS bf16x8*)(lds + PG8_SA(b, h) + aoff + m * 2048), *(const PG8_LAS bf16x8*)(lds + PG8_SA(b, h) + aoff + m * 2048 + 1024)); } \
        else { _Pragma("unroll") for (int m = 0; m < 4; ++m) _Pragma("unroll") for (int k = 0; k < 2; ++k) dst[m][k] = *(const PG8_LAS bf16x8*)(lds + PG8_SA(b, h) + aoff + m * 2048 + k * 1024); } } while (0)
#define PG8_LDB(dst, b, h) do { if constexpr (FP8) { _Pragma("unroll") for (int n = 0; n < 2; ++n) dst##8[n] = cat8(*(const PG8_LAS bf16x8*)(lds + PG8_SB(b, h) + boff + n * 2048), *(const PG8_LAS bf16x8*)(lds + PG8_SB(b, h) + boff + n * 2048 + 1024)); } \
        else { _Pragma("unroll") for (int n = 0; n < 2; ++n) _Pragma("unroll") for (int k = 0; k < 2; ++k) dst[n][k] = *(const PG8_LAS bf16x8*)(lds + PG8_SB(b, h) + boff + n * 2048 + k * 1024); } } while (0)
#define PG8_MMA(ai, bj, At, Bt) do { __builtin_amdgcn_s_setprio(1); if constexpr (FP8) { _Pragma("unroll") for (int m = 0; m < 4; ++m) _Pragma("unroll") for (int n = 0; n < 2; ++n) \
        acc[ai][bj][m][n] = __builtin_amdgcn_mfma_scale_f32_16x16x128_f8f6f4(Bt##8[n], At##8[m], acc[ai][bj][m][n], 0, 0, 0, g.scl_w, 0, g.scl_a); \
        _Pragma("unroll") for (int m = 0; m < 4; ++m) _Pragma("unroll") for (int n = 0; n < 2; ++n) asm volatile("" : "+v"(acc[ai][bj][m][n]));   } else { \
        _Pragma("unroll") for (int m = 0; m < 4; ++m) _Pragma("unroll") for (int n = 0; n < 2; ++n) _Pragma("unroll") for (int k = 0; k < 2; ++k) \
        acc[ai][bj][m][n] = __builtin_amdgcn_mfma_f32_16x16x32_bf16(Bt[n][k], At[m][k], acc[ai][bj][m][n], 0, 0, 0); } __builtin_amdgcn_s_setprio(0); } while (0)
#define PG8_WAIT_V(n) asm volatile("s_waitcnt vmcnt(" #n ")" ::: "memory")
#define PG8_WAIT_L(n) asm volatile("s_waitcnt lgkmcnt(" #n ")" ::: "memory")
#define PG8_BAR __builtin_amdgcn_s_barrier()
#define PG8_SCHED __builtin_amdgcn_sched_barrier(0)
    Unit cur, nxt; int ui = 0;
    if (!S.next(0, cur)) return;
    f32x4 acc[2][2][4][2];
#pragma unroll
    for (int a = 0; a < 2; ++a)
#pragma unroll
        for (int b = 0; b < 2; ++b)
#pragma unroll
            for (int m = 0; m < 4; ++m)
#pragma unroll
                for (int n = 0; n < 2; ++n) acc[a][b][m][n] = (f32x4){0.f, 0.f, 0.f, 0.f};
    bf16x8 At[4][2], B0[2][2], B1[2][2]; v8i_t At8[4], B08[2], B18[2];
    const char* cA = (const char*)g.A + (GATHER ? (size_t)0 : (size_t)cur.pm * tstep); const char* cB = (const char*)g.Bt + (size_t)cur.pb * tstep;
    if constexpr (GATHER) { PG8_GVOFF(voffAc, 0); }
    S.a_ready(cur);
    if constexpr (SP2) {
        PG8_STAGE(PG8_SB(0, 0), cB, voffB); PG8_STAGE(PG8_SB(0, 1), cB + hstep, voffB); PG8_STAGE_A(PG8_SA(0, 0), cA, 0, false); PG8_STAGE_A(PG8_SA(0, 1), cA, 1, false);
        if (wr == 1) PG8_BAR;
        PG8_WAIT_V(2); PG8_BAR;
        PG8_STAGE(PG8_SB(1, 0), cB + kstep, voffB); PG8_STAGE_A(PG8_SA(1, 0), cA + kstep, 0, false); PG8_STAGE(PG8_SB(1, 1), cB + hstep + kstep, voffB);
        PG8_WAIT_V(6); PG8_BAR;
    } else {
        PG8_STAGE(PG8_SB(0, 0), cB, voffB); PG8_STAGE_A(PG8_SA(0, 0), cA, 0, false); PG8_STAGE(PG8_SB(0, 1), cB + hstep, voffB); PG8_STAGE_A(PG8_SA(0, 1), cA, 1, false);
        if (wr == 1) PG8_BAR;
        PG8_WAIT_V(4); PG8_BAR;
        PG8_STAGE(PG8_SB(1, 0), cB + kstep, voffB); PG8_STAGE_A(PG8_SA(1, 0), cA + kstep, 0, false); PG8_STAGE(PG8_SB(1, 1), cB + hstep + kstep, voffB);
        PG8_WAIT_V(6); PG8_BAR;
    }
    for (;;) {
        const bool has_next = S.next(ui + 1, nxt);
        const char* nA = (has_next && !GATHER) ? (const char*)g.A + (size_t)nxt.pm * tstep : cA; const char* nB = has_next ? (const char*)g.Bt + (size_t)nxt.pb * tstep : cB;
        if constexpr (GATHER) { if (has_next) { PG8_GVOFF(voffAn, ui + 1); } else {
#pragma unroll
            for (int h_ = 0; h_ < 2; ++h_) { voffAn[h_][0] = voffAc[h_][0]; voffAn[h_][1] = voffAc[h_][1]; } } }
        for (int t = 0; t < nt; t += 2) {
            const bool last = (t == nt - 2);
            const char* a1 = cA + (size_t)(t + 1) * kstep;
            const char* a2 = last ? nA : cA + (size_t)(t + 2) * kstep; const char* b2 = last ? nB : cB + (size_t)(t + 2) * kstep;
            const char* a3 = a2 + kstep; const char* b3 = b2 + kstep;
            if (last && has_next) S.a_ready(nxt);
            if constexpr (SP2) {
            PG8_LDB(B0, 0, 0); PG8_LDB(B1, 0, 1); PG8_SCHED; PG8_LDA(At, 0, 0); PG8_STAGE_A(PG8_SA(1, 1), a1, 1, false);
            PG8_WAIT_V(8); PG8_WAIT_L(0); PG8_BAR; PG8_MMA(0, 0, At, B0); PG8_MMA(0, 1, At, B1); PG8_BAR; PG8_SCHED;
            PG8_LDA(At, 0, 1); PG8_STAGE(PG8_SB(0, 0), b2, voffB); PG8_STAGE(PG8_SB(0, 1), b2 + hstep, voffB); PG8_STAGE_A(PG8_SA(0, 0), a2, 0, last);
            PG8_WAIT_V(8); PG8_WAIT_L(0); PG8_BAR; PG8_MMA(1, 0, At, B0); PG8_MMA(1, 1, At, B1); PG8_BAR; PG8_SCHED;
            PG8_LDB(B0, 1, 0); PG8_LDB(B1, 1, 1); PG8_SCHED; PG8_LDA(At, 1, 0); PG8_STAGE_A(PG8_SA(0, 1), a2, 1, last);
            PG8_WAIT_V(8); PG8_WAIT_L(0); PG8_BAR; PG8_MMA(0, 0, At, B0); PG8_MMA(0, 1, At, B1); PG8_BAR; PG8_SCHED;
            PG8_LDA(At, 1, 1); PG8_STAGE(PG8_SB(1, 0), b3, voffB); PG8_STAGE(PG8_SB(1, 1), b3 + hstep, voffB); PG8_STAGE_A(PG8_SA(1, 0), a3, 0, last);
            PG8_WAIT_V(8); PG8_WAIT_L(0); PG8_BAR; PG8_MMA(1, 0, At, B0); PG8_MMA(1, 1, At, B1); PG8_BAR; PG8_SCHED;
            } else {
            PG8_LDB(B0, 0, 0); PG8_SCHED; PG8_LDA(At, 0, 0); PG8_STAGE_A(PG8_SA(1, 1), a1, 1, false);
            PG8_WAIT_L(8); PG8_BAR; PG8_WAIT_L(0); PG8_MMA(0, 0, At, B0); PG8_BAR; PG8_SCHED;
            PG8_LDB(B1, 0, 1); PG8_STAGE(PG8_SB(0, 0), b2, voffB);
            PG8_BAR; PG8_WAIT_L(0); PG8_MMA(0, 1, At, B1); PG8_BAR;
            PG8_LDA(At, 0, 1); PG8_STAGE_A(PG8_SA(0, 0), a2, 0, last);
            PG8_BAR; PG8_WAIT_L(0); PG8_MMA(1, 0, At, B0); PG8_BAR; PG8_SCHED;
            PG8_STAGE(PG8_SB(0, 1), b2 + hstep, voffB);
            PG8_WAIT_V(6); PG8_BAR; PG8_MMA(1, 1, At, B1); PG8_BAR;
            PG8_LDB(B0, 1, 0); PG8_SCHED; PG8_LDA(At, 1, 0); PG8_STAGE_A(PG8_SA(0, 1), a2, 1, last);
            PG8_WAIT_L(8); PG8_BAR; PG8_WAIT_L(0); PG8_MMA(0, 0, At, B0); PG8_BAR; PG8_SCHED;
            PG8_LDB(B1, 1, 1); PG8_STAGE(PG8_SB(1, 0), b3, voffB);
            PG8_BAR; PG8_WAIT_L(0); PG8_MMA(0, 1, At, B1); PG8_BAR;
            PG8_LDA(At, 1, 1); PG8_STAGE_A(PG8_SA(1, 0), a3, 0, last);
            PG8_BAR; PG8_WAIT_L(0); PG8_MMA(1, 0, At, B0); PG8_BAR; PG8_SCHED;
            PG8_STAGE(PG8_SB(1, 1), b3 + hstep, voffB);
            PG8_WAIT_V(6); PG8_BAR; PG8_MMA(1, 1, At, B1); PG8_BAR;
            }
        }
        if constexpr (ALIGN_EPI) { if (wr == 0) PG8_BAR; }
        if constexpr (!Epi::AFTER_DRAIN) { E(acc, cur, wr, wc, fr, fq); S.done(cur); }
        if (!has_next) break;
#pragma unroll
        for (int a = 0; a < 2; ++a)
#pragma unroll
            for (int b = 0; b < 2; ++b)
#pragma unroll
                for (int m = 0; m < 4; ++m)
#pragma unroll
                    for (int n = 0; n < 2; ++n) acc[a][b][m][n] = (f32x4){0.f, 0.f, 0.f, 0.f};
        cur = nxt; cA = nA; cB = nB; ++ui;
        if constexpr (GATHER) {
#pragma unroll
            for (int h_ = 0; h_ < 2; ++h_) { voffAc[h_][0] = voffAn[h_][0]; voffAc[h_][1] = voffAn[h_][1]; } }
        if constexpr (ALIGN_EPI) { if (wr == 1) PG8_BAR; }
    }
    PG8_WAIT_V(0);
    if constexpr (!ALIGN_EPI) { if (wr == 0) PG8_BAR; }
    PG8_BAR;
    if constexpr (Epi::AFTER_DRAIN) { E.fused(acc, cur, wr, wc, fr, fq, lds, wid, lane); S.done(cur); }
#undef PG8_SA
#undef PG8_SB
#undef PG8_STAGE
#undef PG8_STAGE_A
#undef PG8_GVOFF
#undef PG8_LDA
#undef PG8_LDB
#undef PG8_MMA
#undef PG8_WAIT_V
#undef PG8_WAIT_L
#undef PG8_BAR
#undef PG8_SCHED
}
}
#define GAS __attribute__((address_space(1)))
#define LAS __attribute__((address_space(3)))
typedef unsigned short bf16;
typedef unsigned v4u __attribute__((ext_vector_type(4)));
typedef float f32x4 __attribute__((ext_vector_type(4)));
typedef short bf16x8 __attribute__((ext_vector_type(8)));
typedef GAS unsigned gu32;
typedef GAS unsigned long long gu64;
#define RLX_AGENT __ATOMIC_RELAXED, __HIP_MEMORY_SCOPE_AGENT
#define LDS_WAIT() asm volatile("s_waitcnt lgkmcnt(0)" ::: "memory")
#define VM_WAIT() asm volatile("s_waitcnt vmcnt(0)" ::: "memory")
__device__ __forceinline__ unsigned long long rt() { return __builtin_amdgcn_s_memrealtime(); }
__device__ __forceinline__ unsigned f2bf(float f) { unsigned u = __builtin_bit_cast(unsigned, f); return (u + 0x7fffu + ((u >> 16) & 1u)) >> 16; }
__device__ __forceinline__ unsigned pk2(float lo, float hi) { return f2bf(lo) | (f2bf(hi) << 16); }

#define XB_TMO      128
#define XB_XCNT(j)  (256  + 64 * (j))
#define XB_XSUB(j)  (1280 + 64 * (j))
#define XB_XGEN(j)  (2304 + 64 * (j))
#define XB_TOP      3328
#define XB_TOPGEN   3392
#define XCD_BAR_WORDS 3456
#define XB_SPIN_CAP (1u << 22)

__device__ __forceinline__ unsigned xb_ld(unsigned* p)              { return __hip_atomic_load(p, __ATOMIC_RELAXED, __HIP_MEMORY_SCOPE_AGENT); }
__device__ __forceinline__ unsigned xb_add(unsigned* p, unsigned v) { return __hip_atomic_fetch_add(p, v, __ATOMIC_RELAXED, __HIP_MEMORY_SCOPE_AGENT); }
__device__ __forceinline__ unsigned xb_xcc_id() { return (unsigned)__builtin_amdgcn_s_getreg((3 << 11) | 20) & 0xFu; }
#define XB_SPIN(cond, bar) do { unsigned _sp = 0; while (cond) { __builtin_amdgcn_s_sleep(1); \
    if ((++_sp & 255u) == 0u) { if (xb_ld(&(bar)[XB_TMO])) break; if (_sp > XB_SPIN_CAP) { atomicAdd(&(bar)[XB_TMO], 1u); break; } } } } while (0)

struct XcdBarrier {
    unsigned* bar; unsigned x;
    volatile LAS unsigned* st;
};

__device__ __forceinline__ XcdBarrier xcd_barrier_post(unsigned* bar, volatile LAS unsigned* st) {
    XcdBarrier b; b.bar = bar; b.x = xb_xcc_id(); b.st = st;
    if (threadIdx.x == 0) (void)xb_add(&bar[XB_XCNT(b.x)], 1u);
    return b;
}
__device__ __forceinline__ void xcd_barrier_complete(unsigned* bar, unsigned x, unsigned& nloc, unsigned& nx) {
    const unsigned G = gridDim.x * gridDim.y * gridDim.z;
    unsigned sum, cnt, mine, sp = 0u;
    for (;;) {
        sum = 0u; cnt = 0u; mine = 0u;
#pragma unroll
        for (unsigned j = 0; j < 16; ++j) { const unsigned c = xb_ld(&bar[XB_XCNT(j)]); sum += c; cnt += (c > 0u) ? 1u : 0u; mine = (j == x) ? c : mine; }
        if (sum == G) break;
        __builtin_amdgcn_s_sleep(1);
        if ((++sp & 255u) == 0u) { if (xb_ld(&bar[XB_TMO])) break; if (sp > XB_SPIN_CAP) { atomicAdd(&bar[XB_TMO], 1u); break; } }
    }
    nloc = mine > 0u ? mine : 1u; nx = cnt > 0u ? cnt : 1u;
}

__device__ __forceinline__ void xcd_barrier(const XcdBarrier& b) {
    asm volatile("s_waitcnt vmcnt(0)" ::: "memory");
    __syncthreads();
    if (threadIdx.x == 0) {
        unsigned* bar = b.bar;
        __builtin_amdgcn_s_waitcnt(0);
        unsigned nloc = b.st[0], nx = b.st[1];
        if (nloc == 0u) { xcd_barrier_complete(bar, b.x, nloc, nx); b.st[0] = nloc; b.st[1] = nx; }
        const unsigned old = xb_add(&bar[XB_XSUB(b.x)], 1u);
        const unsigned gen = old / nloc;
        if (old + 1u == (gen + 1u) * nloc) {
            __builtin_amdgcn_fence(__ATOMIC_RELEASE, "agent");
            asm volatile("s_waitcnt vmcnt(0)" ::: "memory");
            const unsigned og = xb_add(&bar[XB_TOP], 1u);
            const unsigned tg = og / nx;
            if (og + 1u == (tg + 1u) * nx) xb_add(&bar[XB_TOPGEN], 1u);
            else XB_SPIN(xb_ld(&bar[XB_TOPGEN]) == tg, bar);
            __builtin_amdgcn_fence(__ATOMIC_ACQUIRE, "agent");
            xb_add(&bar[XB_XGEN(b.x)], 1u);
            asm volatile("s_waitcnt vmcnt(0)" ::: "memory");
        } else {
            XB_SPIN(xb_ld(&bar[XB_XGEN(b.x)]) == gen, bar);
            __builtin_amdgcn_fence(__ATOMIC_ACQUIRE, "agent");
            asm volatile("s_waitcnt vmcnt(0)" ::: "memory");
        }
    }
    __syncthreads();
}

#ifndef PG8_SP2
#define PG8_SP2 true
#endif
#ifndef PG8_ALIGN
#define PG8_ALIGN true
#endif
namespace pg8 {
struct EpiResF32 {
    static constexpr bool PERM = false, AFTER_DRAIN = false;
    const float* base; float* C; int ldc;
    __device__ __forceinline__ void operator()(const f32x4 (&acc)[2][2][4][2], const Unit& u, int wr, int wc, int fr, int fq) const {
        const int row0 = u.pm * BM + wr * 64 + fr, col0 = u.pn * BM + wc * 32 + 4 * fq;
#pragma unroll
        for (int ai = 0; ai < 2; ++ai)
#pragma unroll
            for (int m = 0; m < 4; ++m) { const size_t off = (size_t)(row0 + ai * HALF + m * 16) * ldc + col0;
#pragma unroll
                for (int bj = 0; bj < 2; ++bj)
#pragma unroll
                    for (int n = 0; n < 2; ++n) { const f32x4 bs = *(const f32x4*)(base + off + bj * HALF + n * 16); *(f32x4*)(C + off + bj * HALF + n * 16) = bs + acc[ai][bj][m][n]; }
                asm volatile("" ::: "memory"); }
    }
};
struct EpiResXn {
    static constexpr bool PERM = true, AFTER_DRAIN = false;
    const bf16_t* XN; const float* rms; bf16_t* O; int ldc;
    __device__ __forceinline__ void operator()(const f32x4 (&acc)[2][2][4][2], const Unit& u, int wr, int wc, int fr, int fq) const {
        const int row0 = u.pm * BM + wr * 64 + fr, col0 = u.pn * BM + wc * 32 + 8 * fq;
#pragma unroll
        for (int ai = 0; ai < 2; ++ai)
#pragma unroll
            for (int m = 0; m < 4; ++m) { const int row = row0 + ai * HALF + m * 16; const size_t off = (size_t)row * ldc + col0; const float rs = rms[row];
#pragma unroll
                for (int bj = 0; bj < 2; ++bj) { const u32x4 xw = *(const u32x4*)(XN + off + bj * HALF);
                    const f32x4 b0 = (f32x4){__builtin_bit_cast(float, xw.x << 16), __builtin_bit_cast(float, xw.x & 0xffff0000u), __builtin_bit_cast(float, xw.y << 16), __builtin_bit_cast(float, xw.y & 0xffff0000u)};
                    const f32x4 b1 = (f32x4){__builtin_bit_cast(float, xw.z << 16), __builtin_bit_cast(float, xw.z & 0xffff0000u), __builtin_bit_cast(float, xw.w << 16), __builtin_bit_cast(float, xw.w & 0xffff0000u)};
                    const f32x4 v0 = acc[ai][bj][m][0] + b0 * rs, v1 = acc[ai][bj][m][1] + b1 * rs;
                    u32x4 w; w.x = cvt_pk_bf16(v0[0], v0[1]); w.y = cvt_pk_bf16(v0[2], v0[3]); w.z = cvt_pk_bf16(v1[0], v1[1]); w.w = cvt_pk_bf16(v1[2], v1[3]);
                    *(u32x4*)(O + off + bj * HALF) = w; }
                asm volatile("" ::: "memory"); }
    }
};
struct EpiResBf16 {
    static constexpr bool PERM = true, AFTER_DRAIN = false;
    const float* base; bf16_t* O; int ldc;
    __device__ __forceinline__ void operator()(const f32x4 (&acc)[2][2][4][2], const Unit& u, int wr, int wc, int fr, int fq) const {
        const int row0 = u.pm * BM + wr * 64 + fr, col0 = u.pn * BM + wc * 32 + 8 * fq;
#pragma unroll
        for (int ai = 0; ai < 2; ++ai)
#pragma unroll
            for (int m = 0; m < 4; ++m) { const size_t off = (size_t)(row0 + ai * HALF + m * 16) * ldc + col0;
#pragma unroll
                for (int bj = 0; bj < 2; ++bj) { const f32x4 b0 = *(const f32x4*)(base + off + bj * HALF), b1 = *(const f32x4*)(base + off + bj * HALF + 4);
                    const f32x4 v0 = acc[ai][bj][m][0] + b0, v1 = acc[ai][bj][m][1] + b1;
                    u32x4 w; w.x = cvt_pk_bf16(v0[0], v0[1]); w.y = cvt_pk_bf16(v0[2], v0[3]); w.z = cvt_pk_bf16(v1[0], v1[1]); w.w = cvt_pk_bf16(v1[2], v1[3]);
                    *(u32x4*)(O + off + bj * HALF) = w; }
                asm volatile("" ::: "memory"); }
    }
};
struct EpiBiasBf16 {
    static constexpr bool PERM = true, AFTER_DRAIN = false;
    bf16_t* O; int ldc; const float* bias; int bstride;
    __device__ __forceinline__ void operator()(const f32x4 (&acc)[2][2][4][2], const Unit& u, int wr, int wc, int fr, int fq) const {
        const int row0 = u.pm * BM + wr * 64 + fr; const int col0 = u.pn * BM + wc * 32 + 8 * fq;
        const float* bp = bias ? bias + (size_t)u.e * bstride + col0 : nullptr;
        f32x4 bv[2][2];
#pragma unroll
        for (int bj = 0; bj < 2; ++bj)
#pragma unroll
            for (int n = 0; n < 2; ++n) bv[bj][n] = bias ? *(const f32x4*)(bp + bj * HALF + 4 * n) : (f32x4){0.f, 0.f, 0.f, 0.f};
#pragma unroll
        for (int ai = 0; ai < 2; ++ai)
#pragma unroll
            for (int m = 0; m < 4; ++m) { bf16_t* rowp = O + (size_t)(row0 + ai * HALF + m * 16) * ldc + col0;
#pragma unroll
                for (int bj = 0; bj < 2; ++bj) { const f32x4 v0 = acc[ai][bj][m][0] + bv[bj][0], v1 = acc[ai][bj][m][1] + bv[bj][1];
                    u32x4 w; w.x = cvt_pk_bf16(v0[0], v0[1]); w.y = cvt_pk_bf16(v0[2], v0[3]); w.z = cvt_pk_bf16(v1[0], v1[1]); w.w = cvt_pk_bf16(v1[2], v1[3]);
                    *(u32x4*)(rowp + bj * HALF) = w; } }
    }
};
__device__ __forceinline__ unsigned pk4_fp8e(float a, float b, float c, float d) {
    int w = 0; w = __builtin_amdgcn_cvt_pk_fp8_f32(a * 8.f, b * 8.f, w, false); w = __builtin_amdgcn_cvt_pk_fp8_f32(c * 8.f, d * 8.f, w, true); return (unsigned)w; }
typedef unsigned u32x2v __attribute__((ext_vector_type(2)));
__device__ __forceinline__ unsigned pk4_fp8c(float a, float b, float c, float d) {
    a = fminf(fmaxf(a * 8.f, -448.f), 448.f); b = fminf(fmaxf(b * 8.f, -448.f), 448.f); c = fminf(fmaxf(c * 8.f, -448.f), 448.f); d = fminf(fmaxf(d * 8.f, -448.f), 448.f);
    int w = 0; w = __builtin_amdgcn_cvt_pk_fp8_f32(a, b, w, false); w = __builtin_amdgcn_cvt_pk_fp8_f32(c, d, w, true); return (unsigned)w; }
struct EpiBiasLdsBf16 {
    static constexpr bool PERM = true, AFTER_DRAIN = false;
    bf16_t* O; int ldc; const PG8_LAS unsigned short* biasL;
    __device__ __forceinline__ void operator()(const f32x4 (&acc)[2][2][4][2], const Unit& u, int wr, int wc, int fr, int fq) const {
        const int row0 = u.pm * BM + wr * 64 + fr; const int col0 = u.pn * BM + wc * 32 + 8 * fq;
        f32x4 bv[2][2];
#pragma unroll
        for (int bj = 0; bj < 2; ++bj) { const u32x4 w = *(const PG8_LAS u32x4*)(biasL + u.e * 256 + bj * HALF + wc * 32 + 8 * fq);
            bv[bj][0] = (f32x4){__builtin_bit_cast(float, w.x << 16), __builtin_bit_cast(float, w.x & 0xffff0000u), __builtin_bit_cast(float, w.y << 16), __builtin_bit_cast(float, w.y & 0xffff0000u)};
            bv[bj][1] = (f32x4){__builtin_bit_cast(float, w.z << 16), __builtin_bit_cast(float, w.z & 0xffff0000u), __builtin_bit_cast(float, w.w << 16), __builtin_bit_cast(float, w.w & 0xffff0000u)}; }
#pragma unroll
        for (int ai = 0; ai < 2; ++ai)
#pragma unroll
            for (int m = 0; m < 4; ++m) { unsigned char* rowp = (unsigned char*)O + (size_t)(row0 + ai * HALF + m * 16) * ldc + col0;
#pragma unroll
                for (int bj = 0; bj < 2; ++bj) { const f32x4 v0 = acc[ai][bj][m][0] + bv[bj][0], v1 = acc[ai][bj][m][1] + bv[bj][1];
                    u32x2v w; w.x = pk4_fp8c(v0[0], v0[1], v0[2], v0[3]); w.y = pk4_fp8c(v1[0], v1[1], v1[2], v1[3]);
                    *(u32x2v*)(rowp + bj * HALF) = w; } }
    }
};
struct EpiSwiGLU {
    static constexpr bool PERM = true, AFTER_DRAIN = false;
    bf16_t* O; int ldc; const PG8_LAS unsigned short* biasL;
    __device__ __forceinline__ void operator()(const f32x4 (&acc)[2][2][4][2], const Unit& u, int wr, int wc, int fr, int fq) const {
        const int row0 = u.pm * BM + wr * 64 + fr; const int ff0 = u.pn * HALF + wc * 32 + 8 * fq;
        f32x4 bg[2], bu[2];
        { const PG8_LAS unsigned short* bp = biasL + u.e * 256 + wc * 32 + 8 * fq;
          const u32x4 wg = *(const PG8_LAS u32x4*)bp, wu = *(const PG8_LAS u32x4*)(bp + 128);
          bg[0] = (f32x4){__builtin_bit_cast(float, wg.x << 16), __builtin_bit_cast(float, wg.x & 0xffff0000u), __builtin_bit_cast(float, wg.y << 16), __builtin_bit_cast(float, wg.y & 0xffff0000u)};
          bg[1] = (f32x4){__builtin_bit_cast(float, wg.z << 16), __builtin_bit_cast(float, wg.z & 0xffff0000u), __builtin_bit_cast(float, wg.w << 16), __builtin_bit_cast(float, wg.w & 0xffff0000u)};
          bu[0] = (f32x4){__builtin_bit_cast(float, wu.x << 16), __builtin_bit_cast(float, wu.x & 0xffff0000u), __builtin_bit_cast(float, wu.y << 16), __builtin_bit_cast(float, wu.y & 0xffff0000u)};
          bu[1] = (f32x4){__builtin_bit_cast(float, wu.z << 16), __builtin_bit_cast(float, wu.z & 0xffff0000u), __builtin_bit_cast(float, wu.w << 16), __builtin_bit_cast(float, wu.w & 0xffff0000u)}; }
#pragma unroll
        for (int ai = 0; ai < 2; ++ai)
#pragma unroll
            for (int m = 0; m < 4; ++m) { unsigned char* rowp = (unsigned char*)O + (size_t)(row0 + ai * HALF + m * 16) * ldc + ff0;
                float o[8];
#pragma unroll
                for (int n = 0; n < 2; ++n) { const f32x4 g = acc[ai][0][m][n] + bg[n], up = acc[ai][1][m][n] + bu[n];
#pragma unroll
                    for (int j = 0; j < 4; ++j) { const float gg = fminf(g[j], 7.0f), uu = fminf(fmaxf(up[j], -7.0f), 7.0f);
                        const float sg = __builtin_amdgcn_rcpf(1.0f + __builtin_amdgcn_exp2f(-1.702f * 1.44269504089f * gg));
                        o[4 * n + j] = (uu + 1.0f) * (gg * sg); } }
                u32x2v w; w.x = pk4_fp8e(o[0], o[1], o[2], o[3]); w.y = pk4_fp8e(o[4], o[5], o[6], o[7]);
                *(u32x2v*)rowp = w; }
    }
};
struct MoeOrder {
    const PG8_LAS int* tile_e; int MT, nN, G, c;
    __device__ bool next(int i, Unit& u) const {
        const int per_round = G / nN, mpx = per_round / 8; int mt, pn;
        if (G % (8 * nN) == 0) { const int xcd = c & 7, loc = c >> 3; mt = i * per_round + xcd * mpx + loc / nN; pn = loc % nN; }
        else { const long L = (long)i * G + c; mt = (int)(L / nN); pn = (int)(L % nN); }
        if (mt >= MT) return false; const int e = __builtin_amdgcn_readfirstlane(tile_e[mt]);
        u.pm = mt; u.pn = pn; u.pb = e * nN + pn; u.e = e; return true;
    }
    __device__ __forceinline__ void a_ready(const Unit&) const {}
    __device__ __forceinline__ void done(const Unit&) const {}
};
}

constexpr int NWAVES = 8;
constexpr int BATCH = 4, SEQ = 8192, D = 1024, M = BATCH * SEQ;
constexpr int IN_COLS = 3328, CW = 512, RW = 512, NH = 8, HD = 64;
constexpr int NE = 32, TOPK = 4, FF = 1024;
constexpr int SLOT_ROWS = M * TOPK + NE * 256;
constexpr int MT_MAX = SLOT_ROWS / 256;
constexpr float NORM_EPS = 1e-5f, GN_EPS = 64e-5f;
#ifndef MK_N_LAUNCHES
#define MK_N_LAUNCHES 1
#endif
constexpr int NPHASE = 10;
constexpr int N_LAUNCHES = MK_N_LAUNCHES;

constexpr size_t MiB = 1u << 20;
constexpr size_t WS_CTL = 0, CTL_ZERO_BYTES = 1 * MiB;
constexpr size_t WS_WIN = 2 * MiB;
constexpr size_t WS_WOUT = 9 * MiB;
constexpr size_t WS_LORA = 11 * MiB;
constexpr size_t WS_TOKE = 12 * MiB, WS_TOKG = WS_TOKE + 512 * 1024, WS_TOKR = WS_TOKG + 512 * 1024, WS_DEST = WS_TOKR + 512 * 1024;
constexpr size_t WS_BDOT = 14 * MiB;
constexpr size_t WS_WGU = 16 * MiB;
constexpr size_t WS_WDN = 144 * MiB;
constexpr size_t WS_XN = 208 * MiB;
constexpr size_t WS_Y = 272 * MiB;
constexpr size_t WS_P = 336 * MiB;
constexpr size_t WS_FR = 544 * MiB;
constexpr size_t WS_SR = 544 * MiB, WS_SW = 608 * MiB, WS_SK = 672 * MiB, WS_SV = 864 * MiB, WS_SKK = 800 * MiB, WS_SB = 864 * MiB;
constexpr size_t WS_SG = 928 * MiB;
constexpr size_t WS_XIN = 272 * MiB;
constexpr size_t WS_YSLOT = WS_XIN;
constexpr size_t WS_ACT = 544 * MiB;
constexpr size_t WS_X1 = 816 * MiB;
constexpr size_t WS_END = 960 * MiB;
constexpr int CHK = 32, NCH = SEQ / CHK, NCHH = BATCH * NH * NCH;
constexpr size_t WS_SF = WS_P;
constexpr size_t WS_RMS = 15 * MiB;
constexpr size_t WS_QF = 736 * MiB;
constexpr size_t WS_O1 = 768 * MiB;
constexpr size_t WS_GF = 608 * MiB;
constexpr size_t WS_HF = 672 * MiB;
constexpr size_t WS_PC = 800 * MiB;
static_assert(WS_ACT + (size_t)SLOT_ROWS * 1024 * 2 <= WS_X1 && WS_X1 + (size_t)M * D * 4 <= WS_END && WS_XIN + (size_t)SLOT_ROWS * 1024 * 2 <= WS_ACT, "ws map");
constexpr int CW_BAR = 4096;
constexpr int CW_CNT = 8192;
constexpr int CW_MT = 8256;
constexpr int CW_TILE_E = 8320;
constexpr int RING_BYTES = 131072, LDS_BYTES = 163840, LDSCTL_OFF = LDS_BYTES - 512, MISC_OFF = LDSCTL_OFF + 320;

constexpr int MOE_TOK_OFF = RING_BYTES + 2304 + 32 * 256 * 2, MOE_MAXU = 18;
constexpr size_t WS_LIST = 240 * MiB;
constexpr int MOE_TAB_OFF = RING_BYTES, MOE_BIAS_OFF = RING_BYTES + 2304;
static_assert(MOE_TOK_OFF + MOE_MAXU * 512 + 512 <= LDSCTL_OFF, "MoE LDS tables fit");
typedef unsigned u32x2 __attribute__((ext_vector_type(2)));
typedef float f32x2 __attribute__((ext_vector_type(2)));

typedef float f32x2_t __attribute__((ext_vector_type(2))); typedef __bf16 bf16x2_t __attribute__((ext_vector_type(2)));
__device__ __forceinline__ unsigned cvtpk_s(float lo, float hi) { f32x2_t v = {lo, hi}; bf16x2_t b = __builtin_convertvector(v, bf16x2_t); return __builtin_bit_cast(unsigned, b); }
__device__ __forceinline__ float wave_sum(float v) {
#pragma unroll
    for (int o = 1; o < 64; o <<= 1) v += __shfl_xor(v, o);
    return v;
}
__device__ __forceinline__ float bf_lo(unsigned w) { return __builtin_bit_cast(float, w << 16); }
__device__ __forceinline__ float bf_hi(unsigned w) { return __builtin_bit_cast(float, w & 0xffff0000u); }
__device__ __forceinline__ float fast_sigmoid(float x) { return __builtin_amdgcn_rcpf(1.0f + __builtin_amdgcn_exp2f(-1.44269504089f * x)); }
__device__ __forceinline__ float fast_tanh(float x) { const float xc = fminf(fmaxf(x, -15.f), 15.f); const float e = __builtin_amdgcn_exp2f(2.88539008178f * xc); return 1.0f - 2.0f * __builtin_amdgcn_rcpf(e + 1.0f); }

__device__ __forceinline__ void p0_transpose_item(const float* W, int K, int N, bf16* WT, int dst_row0, LAS float* scr, int k0, int n0, int lane) {
#pragma unroll
    for (int i = 0; i < 8; ++i) { const int kk = 8 * i + (lane >> 3), c4 = (lane & 7) * 4; const f32x4 v = *(const f32x4*)(W + (size_t)(k0 + kk) * N + n0 + c4);
        scr[kk * 33 + c4] = v.x; scr[kk * 33 + c4 + 1] = v.y; scr[kk * 33 + c4 + 2] = v.z; scr[kk * 33 + c4 + 3] = v.w; }
    LDS_WAIT(); asm volatile("" ::: "memory");
    const int c = lane & 7;
#pragma unroll
    for (int j = 0; j < 4; ++j) { const int n = (lane >> 3) + 8 * j; const LAS float* s = scr + (8 * c) * 33 + n;
        v4u o; o.x = pk2(s[0 * 33], s[1 * 33]); o.y = pk2(s[2 * 33], s[3 * 33]); o.z = pk2(s[4 * 33], s[5 * 33]); o.w = pk2(s[6 * 33], s[7 * 33]);
        *(GAS v4u*)(WT + (size_t)(dst_row0 + n) * K + k0 + 8 * c) = o; }
    LDS_WAIT(); asm volatile("" ::: "memory");
}

__device__ __forceinline__ void p0_transpose_item_g(const float* W, int K, int N, bf16* WT, int dst_row0, LAS float* scr, int k0, int n0, int lane, const float* gk) {
#pragma unroll
    for (int i = 0; i < 8; ++i) { const int kk = 8 * i + (lane >> 3), c4 = (lane & 7) * 4; const f32x4 v = *(const f32x4*)(W + (size_t)(k0 + kk) * N + n0 + c4);
        scr[kk * 33 + c4] = v.x; scr[kk * 33 + c4 + 1] = v.y; scr[kk * 33 + c4 + 2] = v.z; scr[kk * 33 + c4 + 3] = v.w; }
    const int c = lane & 7;
    const f32x4 ga = *(const f32x4*)(gk + k0 + 8 * c), gb = *(const f32x4*)(gk + k0 + 8 * c + 4);
    LDS_WAIT(); asm volatile("" ::: "memory");
#pragma unroll
    for (int j = 0; j < 4; ++j) { const int n = (lane >> 3) + 8 * j; const LAS float* s = scr + (8 * c) * 33 + n;
        v4u o; o.x = pk2(s[0 * 33] * ga.x, s[1 * 33] * ga.y); o.y = pk2(s[2 * 33] * ga.z, s[3 * 33] * ga.w); o.z = pk2(s[4 * 33] * gb.x, s[5 * 33] * gb.y); o.w = pk2(s[6 * 33] * gb.z, s[7 * 33] * gb.w);
        *(GAS v4u*)(WT + (size_t)(dst_row0 + n) * K + k0 + 8 * c) = o; }
    LDS_WAIT(); asm volatile("" ::: "memory");
}

__device__ __forceinline__ unsigned pk4_fp8(float a, float b, float c, float d, float s) {
    a = fminf(fmaxf(a * s, -448.f), 448.f); b = fminf(fmaxf(b * s, -448.f), 448.f); c = fminf(fmaxf(c * s, -448.f), 448.f); d = fminf(fmaxf(d * s, -448.f), 448.f);
    int w = 0; w = __builtin_amdgcn_cvt_pk_fp8_f32(a, b, w, false); w = __builtin_amdgcn_cvt_pk_fp8_f32(c, d, w, true); return (unsigned)w; }
constexpr float F8_W_SCALE = 1024.f, F8_H_SCALE = 32.f, F8_ACT_SCALE = 8.f;
constexpr int F8_W_BYTE = 0x75757575, F8_H_BYTE = 0x7a7a7a7a, F8_ACT_BYTE = 0x7c7c7c7c;
struct F8Item { f32x4 v[8]; };
__device__ __forceinline__ void f8_item_load(F8Item& it, const float* W, int N, int k0, int n0, int lane) {
#pragma unroll
    for (int i = 0; i < 8; ++i) { const int kk = 8 * i + (lane >> 3), c4 = (lane & 7) * 4; it.v[i] = *(const f32x4*)(W + (size_t)(k0 + kk) * N + n0 + c4); }
}
__device__ __forceinline__ void f8_item_finish(const F8Item& it, int K, unsigned char* WT, int dst_row0, LAS float* scr, int k0, int lane) {
#pragma unroll
    for (int i = 0; i < 8; ++i) { const int kk = 8 * i + (lane >> 3), c4 = (lane & 7) * 4; scr[kk * 33 + c4] = it.v[i].x; scr[kk * 33 + c4 + 1] = it.v[i].y; scr[kk * 33 + c4 + 2] = it.v[i].z; scr[kk * 33 + c4 + 3] = it.v[i].w; }
    LDS_WAIT(); asm volatile("" ::: "memory");
    const int c = lane & 7;
#pragma unroll
    for (int j = 0; j < 4; ++j) { const int n = (lane >> 3) + 8 * j; const LAS float* s = scr + (8 * c) * 33 + n;
        u32x2 o; o.x = pk4_fp8(s[0 * 33], s[1 * 33], s[2 * 33], s[3 * 33], F8_W_SCALE); o.y = pk4_fp8(s[4 * 33], s[5 * 33], s[6 * 33], s[7 * 33], F8_W_SCALE);
        *(GAS u32x2*)(WT + (size_t)(dst_row0 + n) * K + k0 + 8 * c) = o; }
    LDS_WAIT(); asm volatile("" ::: "memory");
}
__device__ __forceinline__ void p0_transpose_item_f8(const float* W, int K, int N, unsigned char* WT, int dst_row0, LAS float* scr, int k0, int n0, int lane) {
#pragma unroll
    for (int i = 0; i < 8; ++i) { const int kk = 8 * i + (lane >> 3), c4 = (lane & 7) * 4; const f32x4 v = *(const f32x4*)(W + (size_t)(k0 + kk) * N + n0 + c4);
        scr[kk * 33 + c4] = v.x; scr[kk * 33 + c4 + 1] = v.y; scr[kk * 33 + c4 + 2] = v.z; scr[kk * 33 + c4 + 3] = v.w; }
    LDS_WAIT(); asm volatile("" ::: "memory");
    const int c = lane & 7;
#pragma unroll
    for (int j = 0; j < 4; ++j) { const int n = (lane >> 3) + 8 * j; const LAS float* s = scr + (8 * c) * 33 + n;
        u32x2 o; o.x = pk4_fp8(s[0 * 33], s[1 * 33], s[2 * 33], s[3 * 33], F8_W_SCALE); o.y = pk4_fp8(s[4 * 33], s[5 * 33], s[6 * 33], s[7 * 33], F8_W_SCALE);
        *(GAS u32x2*)(WT + (size_t)(dst_row0 + n) * K + k0 + 8 * c) = o; }
    LDS_WAIT(); asm volatile("" ::: "memory");
}

constexpr int MOE_I_DN = 32 * 512, MOE_I_GU = 32 * 1024, MOE_NIT = MOE_I_DN + MOE_I_GU, MOE_P1_ITEMS = 28672;
__device__ __forceinline__ void moe_convert_items(const float* wdn, const float* wgu, unsigned char* WDN8, unsigned char* WGU8, LAS float* scr, int first, int limit, int stride, int lane) {
#define MOE_ITEM(it_, W_, N_, WT_, DR_, K0_, N0_) do { int r_ = (it_); if (r_ < MOE_I_DN) { const int e_ = r_ / 512, q_ = r_ % 512, kb_ = q_ / 32, nb_ = q_ % 32; W_ = wdn + (size_t)e_ * 1024 * 1024; N_ = 1024; \
            WT_ = WDN8 + (size_t)e_ * 1024 * 1024; DR_ = 32 * nb_; K0_ = 64 * kb_; N0_ = 32 * nb_; } \
        else { r_ -= MOE_I_DN; const int e_ = r_ / 1024, q_ = r_ % 1024, kb_ = q_ / 64, nb_ = q_ % 64; const int n0_ = 32 * nb_, half_ = n0_ >> 10, j_ = n0_ & 1023; W_ = wgu + (size_t)e_ * 1024 * 2048; N_ = 2048; \
            WT_ = WGU8 + (size_t)e_ * 2048 * 1024; DR_ = 256 * (j_ >> 7) + 128 * half_ + (j_ & 127); K0_ = 64 * kb_; N0_ = n0_; } } while (0)
    F8Item q0, q1, q2, q3; const float* Wq[4]; int Nq[4], DRq[4], K0q[4], N0q[4]; unsigned char* WTq[4];
#define MOE_PREF(Q_, slot_, it_) do { if ((it_) < limit) { MOE_ITEM((it_), Wq[slot_], Nq[slot_], WTq[slot_], DRq[slot_], K0q[slot_], N0q[slot_]); f8_item_load(Q_, Wq[slot_], Nq[slot_], K0q[slot_], N0q[slot_], lane); } } while (0)
    MOE_PREF(q0, 0, first); MOE_PREF(q1, 1, first + stride); MOE_PREF(q2, 2, first + 2 * stride);
    for (int it = first; it < limit; it += 4 * stride) {
        MOE_PREF(q3, 3, it + 3 * stride); f8_item_finish(q0, 1024, WTq[0], DRq[0], scr, K0q[0], lane);
        if (it + stride < limit) { MOE_PREF(q0, 0, it + 4 * stride); f8_item_finish(q1, 1024, WTq[1], DRq[1], scr, K0q[1], lane); }
        if (it + 2 * stride < limit) { MOE_PREF(q1, 1, it + 5 * stride); f8_item_finish(q2, 1024, WTq[2], DRq[2], scr, K0q[2], lane); }
        if (it + 3 * stride < limit) { MOE_PREF(q2, 2, it + 6 * stride); f8_item_finish(q3, 1024, WTq[3], DRq[3], scr, K0q[3], lane); }
    }
#undef MOE_PREF
#undef MOE_ITEM
}

struct Args { const float* in[25]; float* out; unsigned char* ws; int ph_lo, ph_hi, li, pad; };

__global__ void __launch_bounds__(NWAVES * 64, 2) mk_fwd(Args args) {
    extern __shared__ __attribute__((aligned(16))) unsigned char lds_raw[];
    LAS unsigned char* lds = (LAS unsigned char*)lds_raw;
    volatile LAS unsigned* MISC = (volatile LAS unsigned*)(lds + MISC_OFF);
    const int tid = threadIdx.x, lane = tid & 63, wave = __builtin_amdgcn_readfirstlane(tid >> 6);
    const int G = gridDim.x; const int vcu = (G % 8 == 0) ? ((int)blockIdx.x % 8) * (G / 8) + (int)blockIdx.x / 8 : (int)blockIdx.x;
    const int gw = vcu * NWAVES + wave, NGW = G * NWAVES;
    unsigned char* ws = args.ws;
    unsigned* ctl = (unsigned*)(ws + WS_CTL);
    const float* x = args.in[0];
    bf16* WIN_T = (bf16*)(ws + WS_WIN); bf16* WOUT_T = (bf16*)(ws + WS_WOUT); bf16* WGU_T = (bf16*)(ws + WS_WGU); bf16* WDN_T = (bf16*)(ws + WS_WDN);
    bf16* WUP_T = (bf16*)(ws + WS_LORA); bf16* AUP_T = WUP_T + 512 * 64; bf16* GUP_T = AUP_T + 512 * 64;
    bf16* XN = (bf16*)(ws + WS_XN); bf16* Y = (bf16*)(ws + WS_Y); bf16* P = (bf16*)(ws + WS_P);
    float* SR = (float*)(ws + WS_SR); float* SW = (float*)(ws + WS_SW); float* SK = (float*)(ws + WS_SK); float* SV = (float*)(ws + WS_SV); float* SKK = (float*)(ws + WS_SKK); float* SB = (float*)(ws + WS_SB);
    bf16* SG = (bf16*)(ws + WS_SG); float* BDOT = (float*)(ws + WS_BDOT);
    bf16* X1 = (bf16*)(ws + WS_X1); bf16* XIN = (bf16*)(ws + WS_XIN); bf16* ACT = (bf16*)(ws + WS_ACT); bf16* YSLOT = (bf16*)(ws + WS_YSLOT);
    int* TOKE = (int*)(ws + WS_TOKE); float* TOKG = (float*)(ws + WS_TOKG); int* TOKR = (int*)(ws + WS_TOKR); int* DEST = (int*)(ws + WS_DEST);

    for (int u = tid; u < (LDS_BYTES - LDSCTL_OFF) / 4; u += NWAVES * 64) ((LAS unsigned*)(lds + LDSCTL_OFF))[u] = 0u;
    __syncthreads();
    XcdBarrier bar; bar.bar = ctl + CW_BAR; bar.x = 0; bar.st = nullptr;
    if (N_LAUNCHES == 1) bar = xcd_barrier_post(ctl + CW_BAR, MISC + 8);
#define GRID_BAR() do { if (N_LAUNCHES == 1) xcd_barrier(bar); } while (0)
    const int lo = args.ph_lo, hi = args.ph_hi;
#ifndef PHASE_MASK
#define PHASE_MASK 0x3ff
#endif
#define IN(k) (((PHASE_MASK >> (k)) & 1) && lo <= (k) && (k) < hi)
#define BOTH(k) (IN(k) && IN((k) + 1))

    if (IN(0)) {
        LAS float* scr = (LAS float*)(lds + wave * 16384);
        constexpr int I_IN = 16 * 104, I_OUT = 16 * 32, I_WUP = 16, I_AUP = 16, I_GUP = 32;
        constexpr int NITEMS = I_IN + I_OUT + I_WUP + I_AUP + I_GUP;
        for (int it = gw; it < NITEMS; it += NGW) {
            int r = it;
            if (r < I_IN) { const int kb = r / 104, nb = r % 104; p0_transpose_item_g(args.in[1], 1024, IN_COLS, WIN_T, 32 * nb, scr, 64 * kb, 32 * nb, lane, args.in[16]); continue; } r -= I_IN;
            if (r < I_OUT) { const int kb = r / 32, nb = r % 32; p0_transpose_item(args.in[15], 1024, 1024, WOUT_T, 32 * nb, scr, 64 * kb, 32 * nb, lane); continue; } r -= I_OUT;
            if (r < I_WUP) { p0_transpose_item(args.in[6], 64, 512, WUP_T, 32 * r, scr, 0, 32 * r, lane); continue; } r -= I_WUP;
            if (r < I_AUP) { p0_transpose_item(args.in[8], 64, 512, AUP_T, 32 * r, scr, 0, 32 * r, lane); continue; } r -= I_AUP;
            { const int kb = r / 16, nb = r % 16; p0_transpose_item(args.in[9], 128, 512, GUP_T, 32 * nb, scr, 64 * kb, 32 * nb, lane); }
        }
        float* RMS = (float*)(ws + WS_RMS);
        for (int m = gw; m < M; m += NGW) {
            const GAS f32x4* xr = (const GAS f32x4*)(x + (size_t)m * D) + lane; f32x4 v[4]; float s = 0.f;
#pragma unroll
            for (int j = 0; j < 4; ++j) { v[j] = xr[64 * j]; s += (v[j].x * v[j].x + v[j].y * v[j].y) + (v[j].z * v[j].z + v[j].w * v[j].w); }
            const float ms = wave_sum(s) * (1.f / D) + NORM_EPS; const float rstd = 1.0f / sqrtf(ms);
            if (lane == 0) RMS[m] = sqrtf(ms);
            GAS unsigned long long* o8 = (GAS unsigned long long*)(XN + (size_t)m * D) + lane;
#pragma unroll
            for (int j = 0; j < 4; ++j)
                o8[64 * j] = (unsigned long long)pk2(v[j].x * rstd, v[j].y * rstd) | ((unsigned long long)pk2(v[j].z * rstd, v[j].w * rstd) << 32);
        }
        if (BOTH(0)) GRID_BAR();
    }

    if (IN(1)) {
        constexpr int P1_GEMM_WGS = 208;
        const bool split = (G == 256);
        if (!split || (int)blockIdx.x < P1_GEMM_WGS) {
            pg8::Gemm g{XN, WIN_T, M, IN_COLS, D, 0, 0, nullptr}; pg8::StaticOrder S; S.init(M, IN_COLS, split ? P1_GEMM_WGS : G, (int)blockIdx.x);
            pg8::EpiBiasBf16 E{P, IN_COLS, nullptr, 0};
            pg8::gemm_phase<pg8::EpiBiasBf16, pg8::StaticOrder, PG8_ALIGN, PG8_SP2>(lds, g, S, E);
        } else {
            moe_convert_items(args.in[22], args.in[20], (unsigned char*)WDN_T, (unsigned char*)WGU_T, (LAS float*)(lds + wave * 16384), ((int)blockIdx.x - P1_GEMM_WGS) * NWAVES + wave, MOE_P1_ITEMS, (G - P1_GEMM_WGS) * NWAVES, lane);
        }
        if (BOTH(1)) GRID_BAR();
    }

    if (IN(2)) {
        const float* mu = args.in[4]; const float* w0 = args.in[5]; const float* a0 = args.in[7]; const float* k_k = args.in[10]; const float* k_a = args.in[11]; const float* r_k = args.in[12];
        const float* conv_w = args.in[2]; const float* conv_g = args.in[3];
        v4u* QF = (v4u*)(ws + WS_QF); u32x2* O1F = (u32x2*)(ws + WS_O1); v4u* GF = (v4u*)(ws + WS_GF); v4u* HF = (v4u*)(ws + WS_HF); float* PCG = (float*)(ws + WS_PC);
        v4u* FRG = (v4u*)(ws + WS_FR);
#define PACK8(lo, hi) __builtin_bit_cast(pg8::bf16x8, (v4u){cvtpk_s((lo)[0], (lo)[1]), cvtpk_s((lo)[2], (lo)[3]), cvtpk_s((hi)[0], (hi)[1]), cvtpk_s((hi)[2], (hi)[3])})
#define MFMA16(a, b, c) __builtin_amdgcn_mfma_f32_16x16x32_bf16((a), (b), (c), 0, 0, 0)
        const f32x4 Z4 = (f32x4){0.f, 0.f, 0.f, 0.f};
        const int h = wave;
        {
            LAS float* cst0 = (LAS float*)(lds + 16896 + wave * 16128 + 12288);
            cst0[0 * 64 + lane] = mu[h * 64 + lane]; cst0[1 * 64 + lane] = mu[512 + h * 64 + lane]; cst0[2 * 64 + lane] = mu[1024 + h * 64 + lane]; cst0[3 * 64 + lane] = k_k[h * 64 + lane];
            cst0[4 * 64 + lane] = k_a[h * 64 + lane]; cst0[5 * 64 + lane] = a0[h * 64 + lane]; cst0[6 * 64 + lane] = w0[h * 64 + lane]; cst0[7 * 64 + lane] = r_k[h * 64 + lane];
            LDS_WAIT(); }
        for (int ck = vcu; ck < M / CHK; ck += G) {
            int tid_ = tid; asm volatile("" : "+v"(tid_)); const int lane_ = tid_ & 63;
            const int fr = lane_ & 15, fq = lane_ >> 4;
            LAS unsigned char* wl = lds + 16896 + wave * 16128;
            LAS bf16* TB = (LAS bf16*)wl;
            LAS float* Amat = (LAS float*)(wl + 5120);
            LAS bf16* Tm = (LAS bf16*)(wl + 9728);
            const LAS float* cst = (const LAS float*)(wl + 12288);
            const int T0 = ck * CHK; const int bb = T0 / SEQ, n = (T0 % SEQ) / CHK; const int chh = (bb * NH + h) * NCH + n;
            {
                const int c8 = (tid_ & 31) * 8, tr = tid_ >> 5;
                const f32x4 mu0 = *(const f32x4*)(mu + 1536 + c8), mu1 = *(const f32x4*)(mu + 1536 + c8 + 4);
                const float mm[8] = {mu0.x, mu0.y, mu0.z, mu0.w, mu1.x, mu1.y, mu1.z, mu1.w};
#pragma unroll
                for (int i = 0; i < 2; ++i) { const int tk = tr + 16 * i, t = T0 + tk;
                    const v4u cur = *(const v4u*)(P + (size_t)t * IN_COLS + 3072 + c8);
                    v4u prv = (v4u){0u, 0u, 0u, 0u}; if ((t % SEQ) != 0) prv = *(const v4u*)(P + (size_t)(t - 1) * IN_COLS + 3072 + c8);
                    const unsigned cw[4] = {cur.x, cur.y, cur.z, cur.w}, pw[4] = {prv.x, prv.y, prv.z, prv.w}; float f[8];
#pragma unroll
                    for (int j = 0; j < 4; ++j) { const float c0 = bf_lo(cw[j]), c1 = bf_hi(cw[j]), p0 = bf_lo(pw[j]), p1 = bf_hi(pw[j]);
                        const float q0 = c0 + (p0 - c0) * mm[2 * j], q1 = c1 + (p1 - c1) * mm[2 * j + 1];
                        f[2 * j] = (c8 < 64) ? fast_tanh(q0) : ((c8 < 128) ? q0 : fast_sigmoid(q0)); f[2 * j + 1] = (c8 < 64) ? fast_tanh(q1) : ((c8 < 128) ? q1 : fast_sigmoid(q1)); }
                    v4u o; o.x = pk2(f[0], f[1]); o.y = pk2(f[2], f[3]); o.z = pk2(f[4], f[5]); o.w = pk2(f[6], f[7]);
                    *(LAS v4u*)(lds + tk * 528 + c8 * 2) = o; }
            }
            __syncthreads();
#define TB_WRITE_T(X_, tt_) do { _Pragma("unroll") for (int m_ = 0; m_ < 4; ++m_) _Pragma("unroll") for (int j_ = 0; j_ < 4; ++j_) \
                TB[(16 * m_ + 4 * fq + j_) * 40 + 16 * (tt_) + fr] = (bf16)(cvtpk_s(X_[m_][j_], 0.f) & 0xffffu); } while (0)
#define TB_READ(fbase_) do { LDS_WAIT(); asm volatile("" ::: "memory"); _Pragma("unroll") for (int q_ = 0; q_ < 4; ++q_) { const u32x2 lo_ = *(const LAS u32x2*)(TB + (16 * q_ + fr) * 40 + 4 * fq), hi_ = *(const LAS u32x2*)(TB + (16 * q_ + fr) * 40 + 16 + 4 * fq); \
                frw[((fbase_) + q_) * 64] = (v4u){lo_.x, lo_.y, hi_.x, hi_.y}; } LDS_WAIT(); asm volatile("" ::: "memory"); } while (0)
#define UNPK(w_) ((f32x4){bf_lo((w_).x), bf_hi((w_).x), bf_lo((w_).y), bf_hi((w_).y)})
            const size_t prow0 = (size_t)T0 * IN_COLS + 1536 + h * 64 + 4 * fq;
            f32x4 ev[2][4]; u32x2 avp[2][4]; u32x2 kkp[2][4] = {}, b0p[2][4] = {}, kmp[2][4] = {};
#pragma unroll
            for (int m = 0; m < 4; ++m) { const int row = h * 64 + 16 * m + fr; const int cl = 16 * m + 4 * fq;
                pg8::bf16x8 ww[2], wa[2], wg[4];
#pragma unroll
                for (int ks = 0; ks < 2; ++ks) { ww[ks] = *(const pg8::bf16x8*)(WUP_T + row * 64 + ks * 32 + fq * 8); wa[ks] = *(const pg8::bf16x8*)(AUP_T + row * 64 + ks * 32 + fq * 8); }
#pragma unroll
                for (int ks = 0; ks < 4; ++ks) wg[ks] = *(const pg8::bf16x8*)(GUP_T + row * 128 + ks * 32 + fq * 8);
                const f32x4 a0v = *(const LAS f32x4*)(cst + 5 * 64 + cl), w0v = *(const LAS f32x4*)(cst + 6 * 64 + cl);
#pragma unroll
                for (int tt = 0; tt < 2; ++tt) { const LAS unsigned char* lrow = lds + (16 * tt + fr) * 528 + fq * 16; f32x4 aw = Z4, aa = Z4, ag = Z4;
#pragma unroll
                    for (int ks = 0; ks < 2; ++ks) { aw = MFMA16(ww[ks], *(const LAS pg8::bf16x8*)(lrow + ks * 64), aw); aa = MFMA16(wa[ks], *(const LAS pg8::bf16x8*)(lrow + (2 + ks) * 64), aa); }
#pragma unroll
                    for (int ks = 0; ks < 4; ++ks) ag = MFMA16(wg[ks], *(const LAS pg8::bf16x8*)(lrow + (4 + ks) * 64), ag);
                    f32x4 avv;
#pragma unroll
                    for (int j = 0; j < 4; ++j) { avv[j] = fast_sigmoid(a0v[j] + aa[j]); const float wlin = w0v[j] + aw[j];
                        const float sp = fmaxf(-wlin, 0.f) + 0.69314718056f * __builtin_amdgcn_logf(1.0f + __builtin_amdgcn_exp2f(-1.44269504089f * fabsf(wlin))); ev[tt][m][j] = __builtin_amdgcn_exp2f(-1.44269504089f * (sp + 0.5f)); }
                    avp[tt][m] = (u32x2){cvtpk_s(avv[0], avv[1]), cvtpk_s(avv[2], avv[3])};
                    u32x2 go; go.x = cvtpk_s(ag[0], ag[1]); go.y = cvtpk_s(ag[2], ag[3]); *(u32x2*)(SG + (size_t)(T0 + 16 * tt + fr) * RW + h * 64 + cl) = go; }
                __builtin_amdgcn_sched_barrier(0); }
#pragma unroll 1
            for (int tt = 0; tt < 2; ++tt) { u32x2 kkt[4], b0t[4], kmt[4]; int frl = fr, fql = fq; asm volatile("" : "+v"(frl), "+v"(fql)); const int PFR = frl; const int tk = 16 * tt + frl; const size_t tok = (size_t)(T0 + tk); const bool first = (tok % SEQ) == 0; const size_t prow = (size_t)T0 * IN_COLS + 1536 + h * 64 + 4 * fql + (size_t)tk * IN_COLS;
                f32x4 kq[4]; float ss = 0.f;
#pragma unroll
                for (int m = 0; m < 4; ++m) { const int cl = 16 * m + 4 * fql; const f32x4 muk = *(const LAS f32x4*)(cst + 1 * 64 + cl), kkv = *(const LAS f32x4*)(cst + 3 * 64 + cl);
                    const u32x2 cu = *(const u32x2*)(P + prow + 512 + 16 * m); u32x2 pu = (u32x2){0u, 0u}; if (!first && PFR == 0) pu = *(const u32x2*)(P + prow - IN_COLS + 512 + 16 * m); pu.x = (unsigned)__builtin_amdgcn_update_dpp((int)pu.x, (int)cu.x, 0x111, 0xf, 0xf, false); pu.y = (unsigned)__builtin_amdgcn_update_dpp((int)pu.y, (int)cu.y, 0x111, 0xf, 0xf, false);
                    const f32x4 cf = UNPK(cu), pf = UNPK(pu); kq[m] = cf + (pf - cf) * muk;
#pragma unroll
                    for (int j = 0; j < 4; ++j) { const float kr = kq[m][j] * kkv[j]; ss += kr * kr; } }
                ss += __shfl_xor(ss, 16); ss += __shfl_xor(ss, 32); const float inv = 1.0f / fmaxf(sqrtf(ss), 1e-12f);
#pragma unroll
                for (int m = 0; m < 4; ++m) { const int cl = 16 * m + 4 * fql; const f32x4 kkv = *(const LAS f32x4*)(cst + 3 * 64 + cl), kav = *(const LAS f32x4*)(cst + 4 * 64 + cl);
                    const u32x2 avq = (tt == 0) ? avp[0][m] : avp[1][m]; const f32x4 av = UNPK(avq);
                    const f32x4 kk = kq[m] * kkv * inv, bq = kk * av, kmv = kq[m] * (1.0f + (av - 1.0f) * kav);
                    kkt[m] = (u32x2){cvtpk_s(kk[0], kk[1]), cvtpk_s(kk[2], kk[3])}; b0t[m] = (u32x2){cvtpk_s(bq[0], bq[1]), cvtpk_s(bq[2], bq[3])}; kmt[m] = (u32x2){cvtpk_s(kmv[0], kmv[1]), cvtpk_s(kmv[2], kmv[3])}; }
#pragma unroll
                for (int m = 0; m < 4; ++m) { if (tt == 0) { kkp[0][m] = kkt[m]; b0p[0][m] = b0t[m]; kmp[0][m] = kmt[m]; } else { kkp[1][m] = kkt[m]; b0p[1][m] = b0t[m]; kmp[1][m] = kmt[m]; } }
                asm volatile("" ::: "memory"); __builtin_amdgcn_sched_barrier(0); }
            LAS float* pcl = (LAS float*)(wl + 14336);
#pragma unroll
            for (int m = 0; m < 4; ++m)
#pragma unroll
                for (int j = 0; j < 4; ++j) { float x0 = ev[0][m][j], x1 = ev[1][m][j];
#define DPP_SHR(v_, n_) __builtin_bit_cast(float, __builtin_amdgcn_update_dpp(0, __builtin_bit_cast(int, (v_)), 0x110 + (n_), 0xf, 0xf, false))
                    x0 += DPP_SHR(x0, 1); x1 += DPP_SHR(x1, 1); x0 += DPP_SHR(x0, 2); x1 += DPP_SHR(x1, 2); x0 += DPP_SHR(x0, 4); x1 += DPP_SHR(x1, 4); x0 += DPP_SHR(x0, 8); x1 += DPP_SHR(x1, 8);
                    const float tot0 = __shfl(x0, 15, 16); x1 += tot0; ev[0][m][j] = x0; ev[1][m][j] = x1; }
#define cum ev
            if (fr == 15) {
#pragma unroll
                for (int m = 0; m < 4; ++m) { *(LAS f32x4*)(pcl + 16 * m + 4 * fq) = cum[1][m]; f32x4 pcv;
#pragma unroll
                    for (int j = 0; j < 4; ++j) pcv[j] = __expf(-cum[1][m][j]);
                    *(f32x4*)(PCG + (size_t)chh * 64 + 16 * m + 4 * fq) = pcv; } }
            LDS_WAIT(); asm volatile("" ::: "memory");
            v4u* frw = FRG + (size_t)gw * 32 * 64 + lane_;
#define FR_ST(f_, val_) (frw[(f_) * 64] = __builtin_bit_cast(v4u, (val_)))
#ifndef KEEP_AT
#define KEEP_AT 0
#endif
#ifndef KEEP_BT
#define KEEP_BT 1
#endif
#ifndef KEEP_KT
#define KEEP_KT 1
#endif
            pg8::bf16x8 AtR[2][2], BtR[2][2], KtR[2][2];
            {
                f32x4 em0[4];
#pragma unroll
                for (int tt = 0; tt < 2; ++tt) { f32x4 x1[4];
#pragma unroll
                    for (int m = 0; m < 4; ++m) { const f32x4 kk = UNPK(kkp[tt][m]);
#pragma unroll
                        for (int j = 0; j < 4; ++j) { const float em = __expf(-cum[tt][m][j]); float pv = DPP_SHR(em, 1);
                            if (tt == 0) { em0[m][j] = em; if (fr == 0) pv = 1.0f; } else { const float last0 = __shfl(em0[m][j], 15, 16); if (fr == 0) pv = last0; }
                            x1[m][j] = -kk[j] * pv; } }
#pragma unroll
                    for (int ks = 0; ks < 2; ++ks) { if (KEEP_AT) AtR[tt][ks] = PACK8(x1[2 * ks], x1[2 * ks + 1]); else FR_ST(0 + 2 * tt + ks, PACK8(x1[2 * ks], x1[2 * ks + 1])); }
                    TB_WRITE_T(x1, tt); }
            }
            TB_READ(16);
#pragma unroll
            for (int tt = 0; tt < 2; ++tt) {
                f32x4 x1[4], x2[4];
#pragma unroll
                for (int m = 0; m < 4; ++m) { const f32x4 bq = UNPK(b0p[tt][m]); const f32x4 cC = *(const LAS f32x4*)(pcl + 16 * m + 4 * fq);
#pragma unroll
                    for (int j = 0; j < 4; ++j) { x1[m][j] = bq[j] * __expf(cum[tt][m][j] - cC[j]); x2[m][j] = bq[j] * __expf(cum[tt][m][j]); } }
#pragma unroll
                for (int ks = 0; ks < 2; ++ks) { if (KEEP_BT) BtR[tt][ks] = PACK8(x2[2 * ks], x2[2 * ks + 1]); else FR_ST(4 + 2 * tt + ks, PACK8(x2[2 * ks], x2[2 * ks + 1])); }
                TB_WRITE_T(x1, tt); }
            TB_READ(20);
#pragma unroll
            for (int tt = 0; tt < 2; ++tt) {
                f32x4 x1[4], x2[4];
#pragma unroll
                for (int m = 0; m < 4; ++m) { const f32x4 kmv = UNPK(kmp[tt][m]); const f32x4 cC = *(const LAS f32x4*)(pcl + 16 * m + 4 * fq);
#pragma unroll
                    for (int j = 0; j < 4; ++j) { x1[m][j] = kmv[j] * __expf(cum[tt][m][j] - cC[j]); x2[m][j] = kmv[j] * __expf(cum[tt][m][j]); } }
#pragma unroll
                for (int ks = 0; ks < 2; ++ks) { if (KEEP_KT) KtR[tt][ks] = PACK8(x2[2 * ks], x2[2 * ks + 1]); else FR_ST(8 + 2 * tt + ks, PACK8(x2[2 * ks], x2[2 * ks + 1])); }
                TB_WRITE_T(x1, tt); }
            TB_READ(24);
            pg8::bf16x8 Rt[2][2];
#pragma unroll
            for (int tt = 0; tt < 2; ++tt) {
                f32x4 x1[4]; const int PFR = fr; const int tk = 16 * tt + fr; const bool first = ((T0 + tk) % SEQ) == 0; const size_t prow = prow0 + (size_t)tk * IN_COLS; float bd = 0.f;
#pragma unroll
                for (int m = 0; m < 4; ++m) { const int c = h * 64 + 16 * m + 4 * fq; const f32x4 mur = *(const LAS f32x4*)(cst + 0 * 64 + 16 * m + 4 * fq), rkv = *(const LAS f32x4*)(cst + 7 * 64 + 16 * m + 4 * fq);
                    const u32x2 cu = *(const u32x2*)(P + prow + 16 * m); u32x2 pu = (u32x2){0u, 0u}; if (!first && PFR == 0) pu = *(const u32x2*)(P + prow - IN_COLS + 16 * m); pu.x = (unsigned)__builtin_amdgcn_update_dpp((int)pu.x, (int)cu.x, 0x111, 0xf, 0xf, false); pu.y = (unsigned)__builtin_amdgcn_update_dpp((int)pu.y, (int)cu.y, 0x111, 0xf, 0xf, false);
                    const f32x4 cf = UNPK(cu), pf = UNPK(pu); const f32x4 rq = cf + (pf - cf) * mur; const f32x4 pr = rq * UNPK(kmp[tt][m]) * rkv; bd += (pr.x + pr.y) + (pr.z + pr.w);
#pragma unroll
                    for (int j = 0; j < 4; ++j) x1[m][j] = rq[j] * __expf(-cum[tt][m][j]); }
                bd += __shfl_xor(bd, 16); bd += __shfl_xor(bd, 32);
                if (fq == 0) BDOT[(size_t)(T0 + tk) * NH + h] = bd;
#pragma unroll
                for (int ks = 0; ks < 2; ++ks) Rt[tt][ks] = PACK8(x1[2 * ks], x1[2 * ks + 1]); }
#pragma unroll
            for (int tt = 0; tt < 2; ++tt) {
                f32x4 x1[4]; const int PFR = fr; const int tk = 16 * tt + fr; const bool first = ((T0 + tk) % SEQ) == 0; const size_t prow = prow0 + (size_t)tk * IN_COLS;
#pragma unroll
                for (int m = 0; m < 4; ++m) { const int c = h * 64 + 16 * m + 4 * fq; const f32x4 muv = *(const LAS f32x4*)(cst + 2 * 64 + 16 * m + 4 * fq);
                    const u32x2 cu = *(const u32x2*)(P + prow + 1024 + 16 * m); u32x2 pu = (u32x2){0u, 0u}; if (!first && PFR == 0) pu = *(const u32x2*)(P + prow - IN_COLS + 1024 + 16 * m); pu.x = (unsigned)__builtin_amdgcn_update_dpp((int)pu.x, (int)cu.x, 0x111, 0xf, 0xf, false); pu.y = (unsigned)__builtin_amdgcn_update_dpp((int)pu.y, (int)cu.y, 0x111, 0xf, 0xf, false);
                    const f32x4 cf = UNPK(cu), pf = UNPK(pu); x1[m] = cf + (pf - cf) * muv; *(u32x2*)((bf16*)SV + (size_t)(T0 + tk) * RW + c) = (u32x2){cvtpk_s(x1[m][0], x1[m][1]), cvtpk_s(x1[m][2], x1[m][3])}; }
                TB_WRITE_T(x1, tt); }
            pg8::bf16x8 Vf[4];
            { LDS_WAIT(); asm volatile("" ::: "memory");
#pragma unroll
              for (int q_ = 0; q_ < 4; ++q_) { const u32x2 lo_ = *(const LAS u32x2*)(TB + (16 * q_ + fr) * 40 + 4 * fq), hi_ = *(const LAS u32x2*)(TB + (16 * q_ + fr) * 40 + 16 + 4 * fq); Vf[q_] = __builtin_bit_cast(pg8::bf16x8, (v4u){lo_.x, lo_.y, hi_.x, hi_.y}); }
              LDS_WAIT(); asm volatile("" ::: "memory"); }
            asm volatile("s_waitcnt vmcnt(0)" ::: "memory");
#define FR_LD(f_) __builtin_bit_cast(pg8::bf16x8, __builtin_nontemporal_load(frw + (f_) * 64))
            pg8::bf16x8 Aak[2], Arb[2], Ark[2];
            {
                pg8::bf16x8 At[2][2], Bt[2][2], Kt[2][2];
#pragma unroll
                for (int tt = 0; tt < 2; ++tt)
#pragma unroll
                    for (int ks = 0; ks < 2; ++ks) { At[tt][ks] = KEEP_AT ? AtR[tt][ks] : FR_LD(0 + 2 * tt + ks); Bt[tt][ks] = KEEP_BT ? BtR[tt][ks] : FR_LD(4 + 2 * tt + ks); Kt[tt][ks] = KEEP_KT ? KtR[tt][ks] : FR_LD(8 + 2 * tt + ks); }
                f32x4 Dab[2][2], Dak[2][2], Drb[2][2], Drk[2][2];
#pragma unroll
                for (int jt = 0; jt < 2; ++jt)
#pragma unroll
                    for (int tt = 0; tt < 2; ++tt) { Dab[jt][tt] = Z4; Dak[jt][tt] = Z4; Drb[jt][tt] = Z4; Drk[jt][tt] = Z4;
#pragma unroll
                        for (int ks = 0; ks < 2; ++ks) { Dab[jt][tt] = MFMA16(Bt[jt][ks], At[tt][ks], Dab[jt][tt]); Dak[jt][tt] = MFMA16(Kt[jt][ks], At[tt][ks], Dak[jt][tt]);
                            Drb[jt][tt] = MFMA16(Bt[jt][ks], Rt[tt][ks], Drb[jt][tt]); Drk[jt][tt] = MFMA16(Kt[jt][ks], Rt[tt][ks], Drk[jt][tt]); }
#pragma unroll
                        for (int jj = 0; jj < 4; ++jj) { const int j = 16 * jt + 4 * fq + jj, t = 16 * tt + fr;
                            if (!(j < t)) { Dab[jt][tt][jj] = 0.f; Dak[jt][tt][jj] = 0.f; }
                            if (!(j <= t)) { Drb[jt][tt][jj] = 0.f; Drk[jt][tt][jj] = 0.f; } }
                        *(LAS f32x4*)(Amat + (16 * tt + fr) * 36 + 16 * jt + 4 * fq) = Dab[jt][tt]; }
#pragma unroll
                for (int tt = 0; tt < 2; ++tt) { Aak[tt] = PACK8(Dak[0][tt], Dak[1][tt]); Arb[tt] = PACK8(Drb[0][tt], Drb[1][tt]); Ark[tt] = PACK8(Drk[0][tt], Drk[1][tt]); }
            }
            LDS_WAIT(); asm volatile("" ::: "memory");
            {
                const int col = lane_ & 31; float xs[32];
#pragma unroll
                for (int t = 0; t < 32; ++t) { float s0 = (t == col) ? 1.0f : 0.0f, s1 = 0.f;
#pragma unroll
                    for (int j4 = 0; j4 < (t + 3) / 4; ++j4) { const f32x4 a4 = *(const LAS f32x4*)(Amat + t * 36 + 4 * j4);
                        if (4 * j4 + 0 < t) s0 += a4[0] * xs[4 * j4 + 0]; if (4 * j4 + 1 < t) s1 += a4[1] * xs[4 * j4 + 1];
                        if (4 * j4 + 2 < t) s0 += a4[2] * xs[4 * j4 + 2]; if (4 * j4 + 3 < t) s1 += a4[3] * xs[4 * j4 + 3]; }
                    xs[t] = s0 + s1; }
                if (lane_ < 32) {
#pragma unroll
                    for (int t = 0; t < 32; ++t) Tm[t * 40 + col] = (bf16)f2bf(xs[t]); }
            }
            LDS_WAIT(); asm volatile("" ::: "memory");
            pg8::bf16x8 Tf[2];
#pragma unroll
            for (int tt = 0; tt < 2; ++tt) { const u32x2 lo = *(const LAS u32x2*)(Tm + (16 * tt + fr) * 40 + 4 * fq), hi = *(const LAS u32x2*)(Tm + (16 * tt + fr) * 40 + 16 + 4 * fq);
                Tf[tt] = __builtin_bit_cast(pg8::bf16x8, (v4u){lo.x, lo.y, hi.x, hi.y}); }
            pg8::bf16x8 Wp[4], U0p[4];
            {
                pg8::bf16x8 Y2p[4], Af[4];
#pragma unroll
                for (int q = 0; q < 4; ++q) Af[q] = FR_LD(16 + q);
#pragma unroll
                for (int vt = 0; vt < 4; ++vt) { const f32x4 y0 = MFMA16(Aak[0], Vf[vt], Z4), y1 = MFMA16(Aak[1], Vf[vt], Z4); Y2p[vt] = PACK8(y0, y1); }
#pragma unroll
                for (int q = 0; q < 4; ++q) { const f32x4 wa = MFMA16(Tf[0], Af[q], Z4), wb = MFMA16(Tf[1], Af[q], Z4); Wp[q] = PACK8(wa, wb);
                    const f32x4 u0 = MFMA16(Tf[0], Y2p[q], Z4), u1 = MFMA16(Tf[1], Y2p[q], Z4); U0p[q] = PACK8(u0, u1); }
            }
#pragma unroll
            for (int tt = 0; tt < 2; ++tt) {
                f32x4 qt[4];
#pragma unroll
                for (int ct = 0; ct < 4; ++ct) { const v4u rw = __builtin_bit_cast(v4u, Rt[tt][ct >> 1]); const unsigned r0 = (ct & 1) ? rw.z : rw.x, r1 = (ct & 1) ? rw.w : rw.y;
                    qt[ct] = MFMA16(Wp[ct], Arb[tt], ((f32x4){bf_lo(r0), bf_hi(r0), bf_lo(r1), bf_hi(r1)})); }
#pragma unroll
                for (int ks = 0; ks < 2; ++ks) __builtin_nontemporal_store(__builtin_bit_cast(v4u, PACK8(qt[2 * ks], qt[2 * ks + 1])), QF + (((size_t)chh * 2 + tt) * 2 + ks) * 64 + lane_);
#pragma unroll
                for (int vt = 0; vt < 4; ++vt) { f32x4 o = MFMA16(U0p[vt], Arb[tt], Z4); o = MFMA16(Vf[vt], Ark[tt], o);
                    u32x2 w; w.x = cvtpk_s(o[0], o[1]); w.y = cvtpk_s(o[2], o[3]); __builtin_nontemporal_store(w, O1F + (((size_t)chh * 4 + vt) * 2 + tt) * 64 + lane_); } }
            pg8::bf16x8 Bh[4], Kh[4];
#pragma unroll
            for (int q = 0; q < 4; ++q) { Bh[q] = FR_LD(20 + q); Kh[q] = FR_LD(24 + q); }
#pragma unroll
            for (int m = 0; m < 4; ++m) { f32x4 gt[4];
#pragma unroll
                for (int ct = 0; ct < 4; ++ct) gt[ct] = MFMA16(Wp[ct], Bh[m], Z4);
#pragma unroll
                for (int ks = 0; ks < 2; ++ks) __builtin_nontemporal_store(__builtin_bit_cast(v4u, PACK8(gt[2 * ks], gt[2 * ks + 1])), GF + (((size_t)chh * 4 + m) * 2 + ks) * 64 + lane_); }
#pragma unroll
            for (int mp = 0; mp < 2; ++mp)
#pragma unroll
                for (int vt = 0; vt < 4; ++vt) { f32x4 ha = MFMA16(Bh[2 * mp], U0p[vt], Z4); ha = MFMA16(Kh[2 * mp], Vf[vt], ha); f32x4 hb2 = MFMA16(Bh[2 * mp + 1], U0p[vt], Z4); hb2 = MFMA16(Kh[2 * mp + 1], Vf[vt], hb2);
                    __builtin_nontemporal_store(__builtin_bit_cast(v4u, PACK8(ha, hb2)), HF + (((size_t)chh * 4 + vt) * 2 + mp) * 64 + lane_); }
            {
                const int t0 = T0 + wave * 4, tb0 = t0 % SEQ; const int c8 = lane_ * 8;
                v4u ur[6], cr[6], br[4];
#pragma unroll
                for (int d = 0; d < 6; ++d) { const bool ok = (tb0 + d - 2) >= 0; const size_t ro = (size_t)(t0 + d - 2) * IN_COLS;
                    ur[d] = (v4u){0u, 0u, 0u, 0u}; cr[d] = ur[d]; if (ok) { ur[d] = *(const v4u*)(P + ro + c8); cr[d] = *(const v4u*)(P + ro + 1024 + c8); } }
#pragma unroll
                for (int i = 0; i < 4; ++i) br[i] = *(const v4u*)(P + (size_t)(t0 + i) * IN_COLS + 512 + c8);
                float cw0[8], cw1[8], cw2[8], cg[8];
#pragma unroll
                for (int j = 0; j < 8; ++j) { cw0[j] = conv_w[c8 + j]; cw1[j] = conv_w[512 + c8 + j]; cw2[j] = conv_w[1024 + c8 + j]; cg[j] = conv_g[c8 + j]; }
                float z[6][8];
#pragma unroll
                for (int d = 0; d < 6; ++d) { const unsigned uw[4] = {ur[d].x, ur[d].y, ur[d].z, ur[d].w}, cw[4] = {cr[d].x, cr[d].y, cr[d].z, cr[d].w};
#pragma unroll
                    for (int j = 0; j < 4; ++j) { z[d][2 * j] = bf_lo(uw[j]) * bf_lo(cw[j]); z[d][2 * j + 1] = bf_hi(uw[j]) * bf_hi(cw[j]); } }
#pragma unroll
                for (int i = 0; i < 4; ++i) { const unsigned bw[4] = {br[i].x, br[i].y, br[i].z, br[i].w}; float yv[8], ss = 0.f;
#pragma unroll
                    for (int j = 0; j < 8; ++j) { const float bg = (j & 1) ? bf_hi(bw[j >> 1]) : bf_lo(bw[j >> 1]); const float cv = cw0[j] * z[i][j] + cw1[j] * z[i + 1][j] + cw2[j] * z[i + 2][j]; yv[j] = bg * cv; ss += yv[j] * yv[j]; }
                    ss += __shfl_xor(ss, 1); ss += __shfl_xor(ss, 2); ss += __shfl_xor(ss, 4);
                    const float rs = 1.0f / sqrtf(ss * (1.0f / 64.0f) + NORM_EPS);
                    v4u o; o.x = pk2(yv[0] * rs * cg[0], yv[1] * rs * cg[1]); o.y = pk2(yv[2] * rs * cg[2], yv[3] * rs * cg[3]); o.z = pk2(yv[4] * rs * cg[4], yv[5] * rs * cg[5]); o.w = pk2(yv[6] * rs * cg[6], yv[7] * rs * cg[7]);
                    *(v4u*)(Y + (size_t)(t0 + i) * D + c8) = o; }
            }
            LDS_WAIT();
            __syncthreads();
        }
#undef TB_WRITE_T
#undef DPP_SHR
#undef FR_ST
#undef FR_LD
#undef cum
#undef TB_READ
#undef UNPK
#undef PACK8
#undef MFMA16
        if (BOTH(2)) GRID_BAR();
    }

#define PACK8(lo, hi) __builtin_bit_cast(pg8::bf16x8, (v4u){cvtpk_s((lo)[0], (lo)[1]), cvtpk_s((lo)[2], (lo)[3]), cvtpk_s((hi)[0], (hi)[1]), cvtpk_s((hi)[2], (hi)[3])})
#define MFMA16(a, b, c) __builtin_amdgcn_mfma_f32_16x16x32_bf16((a), (b), (c), 0, 0, 0)
    if (IN(3)) {
        constexpr int RSLOT = 10752, RING_R = 15, RING_D = 13, NSCAN = BATCH * NH * 4;
        static_assert(RSLOT * RING_R <= LDSCTL_OFF && NCH % 2 == 0, "scan ring fits");
        if ((int)blockIdx.x < NSCAN) {
            const int fr = lane & 15, fq = lane >> 4; const int bxs = (int)blockIdx.x; const int vt = (bxs >> 3) & 3, bh = (bxs & 7) + 8 * (bxs >> 5); const bool ldr = wave < 4, act = wave == 0;
            const v4u* GF = (const v4u*)(ws + WS_GF); const v4u* HF = (const v4u*)(ws + WS_HF); const float* PCG = (const float*)(ws + WS_PC); v4u* SF = (v4u*)(ws + WS_SF);
            const int ch0 = bh * NCH;
            f32x4 acc[4];
#pragma unroll
            for (int m = 0; m < 4; ++m) acc[m] = (f32x4){0.f, 0.f, 0.f, 0.f};
#define P3B_ISSUE(step_) do { const int cn_ = ch0 + ((step_) < NCH ? (step_) : NCH - 1); LAS unsigned char* sl_ = lds + ((step_) % RING_R) * RSLOT; \
                __builtin_amdgcn_global_load_lds((const unsigned*)(GF + (((size_t)cn_ * 4 + wave) * 2 + 0) * 64 + lane), (LAS unsigned*)(sl_ + (wave * 2 + 0) * 1024), 16, 0, 0); \
                __builtin_amdgcn_global_load_lds((const unsigned*)(GF + (((size_t)cn_ * 4 + wave) * 2 + 1) * 64 + lane), (LAS unsigned*)(sl_ + (wave * 2 + 1) * 1024), 16, 0, 0); \
                if (wave == 1) { __builtin_amdgcn_global_load_lds((const unsigned*)(HF + (((size_t)cn_ * 4 + vt) * 2 + 0) * 64 + lane), (LAS unsigned*)(sl_ + 8192), 16, 0, 0); \
                                 __builtin_amdgcn_global_load_lds((const unsigned*)(HF + (((size_t)cn_ * 4 + vt) * 2 + 1) * 64 + lane), (LAS unsigned*)(sl_ + 9216), 16, 0, 0); } \
                if (wave == 2) __builtin_amdgcn_global_load_lds((const unsigned*)(PCG + (size_t)cn_ * 64 + lane), (LAS unsigned*)(sl_ + 10240), 4, 0, 0); } while (0)
#define P3B_READ(G_, H_, P_, step_) do { const LAS unsigned char* sl_ = lds + ((step_) % RING_R) * RSLOT; _Pragma("unroll") for (int m = 0; m < 4; ++m) { \
                G_[m][0] = *(const LAS pg8::bf16x8*)(sl_ + (m * 2 + 0) * 1024 + lane * 16); G_[m][1] = *(const LAS pg8::bf16x8*)(sl_ + (m * 2 + 1) * 1024 + lane * 16); \
                P_[m] = *(const LAS f32x4*)(sl_ + 10240 + (16 * m + 4 * fq) * 4); } \
                H_[0] = *(const LAS pg8::bf16x8*)(sl_ + 8192 + lane * 16); H_[1] = *(const LAS pg8::bf16x8*)(sl_ + 9216 + lane * 16); } while (0)
#define P3B_STEP(G_, H_, P_, n_) do { pg8::bf16x8 sb_[2]; _Pragma("unroll") for (int ks = 0; ks < 2; ++ks) { sb_[ks] = PACK8(acc[2 * ks], acc[2 * ks + 1]); SF[(((size_t)(ch0 + (n_)) * 4 + vt) * 2 + ks) * 64 + lane] = __builtin_bit_cast(v4u, sb_[ks]); } \
                _Pragma("unroll") for (int m = 0; m < 4; ++m) { const v4u hw_ = __builtin_bit_cast(v4u, H_[m >> 1]); const unsigned h0w_ = (m & 1) ? hw_.z : hw_.x, h1w_ = (m & 1) ? hw_.w : hw_.y; \
                    f32x4 nw_ = P_[m] * acc[m] + (f32x4){bf_lo(h0w_), bf_hi(h0w_), bf_lo(h1w_), bf_hi(h1w_)}; \
                    nw_ = MFMA16(G_[m][0], sb_[0], nw_); nw_ = MFMA16(G_[m][1], sb_[1], nw_); acc[m] = nw_; } } while (0)
            if (ldr) {
#pragma unroll 1
                for (int s0 = 0; s0 < RING_D; ++s0) P3B_ISSUE(s0);
            }
            for (int n = 0; n < NCH; n += 2) {
                if (wave == 1) asm volatile("s_waitcnt vmcnt(44)" ::: "memory"); else if (wave == 2) asm volatile("s_waitcnt vmcnt(33)" ::: "memory"); else if (ldr) asm volatile("s_waitcnt vmcnt(22)" ::: "memory");
                __builtin_amdgcn_s_barrier(); asm volatile("" ::: "memory");
                if (act) {
                    pg8::bf16x8 gA[4][2], hA[2], gB[4][2], hB[2]; f32x4 pA[4], pB[4];
                    P3B_READ(gA, hA, pA, n); P3B_READ(gB, hB, pB, n + 1);
                    asm volatile("s_waitcnt lgkmcnt(0)" ::: "memory"); __builtin_amdgcn_sched_barrier(0);
                    P3B_STEP(gA, hA, pA, n);
                    P3B_STEP(gB, hB, pB, n + 1);
                }
                if (ldr) { P3B_ISSUE(n + RING_D); P3B_ISSUE(n + RING_D + 1); }
            }
            if (ldr) asm volatile("s_waitcnt vmcnt(0)" ::: "memory");
            __builtin_amdgcn_s_barrier(); asm volatile("" ::: "memory");
#undef P3B_READ
#undef P3B_STEP
#undef P3B_ISSUE
        }
        {
            LAS float* scr = (LAS float*)(lds + wave * 16384);
            const int p1i = (G == 256) ? MOE_P1_ITEMS : 0; const int NSPLIT = p1i + (int)((MOE_NIT - p1i) * 0.74f);
            const bool scanwg = (int)blockIdx.x < NSCAN && G > NSCAN;
            const int nw = scanwg ? NSCAN * NWAVES : (G > NSCAN ? (G - NSCAN) * NWAVES : G * NWAVES);
            const int widx = scanwg ? NSPLIT + (int)blockIdx.x * NWAVES + wave : p1i + (G > NSCAN ? ((int)blockIdx.x - NSCAN) * NWAVES + wave : gw);
            const int ilim = scanwg ? MOE_NIT : (G > NSCAN ? NSPLIT : MOE_NIT);
            moe_convert_items(args.in[22], args.in[20], (unsigned char*)WDN_T, (unsigned char*)WGU_T, scr, widx, ilim, nw, lane);
        }
        if (BOTH(3)) GRID_BAR();
    }

    if (IN(4)) {
        const int fr = lane & 15, fq = lane >> 4;
        const v4u* QF = (const v4u*)(ws + WS_QF); const u32x2* O1F = (const u32x2*)(ws + WS_O1); const v4u* SF = (const v4u*)(ws + WS_SF);
        const float* gnw = args.in[13]; const float* gnb = args.in[14];
        for (int chh = gw; chh < NCHH; chh += NGW) {
            const int n = chh & (NCH - 1), bh = chh >> 8, b = bh >> 3, h = bh & 7;
            const size_t tok0 = (size_t)b * SEQ + (size_t)n * CHK;
            pg8::bf16x8 Sf[4][2], Qf[2][2];
#pragma unroll
            for (int vt = 0; vt < 4; ++vt)
#pragma unroll
                for (int ks = 0; ks < 2; ++ks) Sf[vt][ks] = __builtin_bit_cast(pg8::bf16x8, SF[(((size_t)chh * 4 + vt) * 2 + ks) * 64 + lane]);
#pragma unroll
            for (int tt = 0; tt < 2; ++tt)
#pragma unroll
                for (int ks = 0; ks < 2; ++ks) Qf[tt][ks] = __builtin_bit_cast(pg8::bf16x8, QF[(((size_t)chh * 2 + tt) * 2 + ks) * 64 + lane]);
#pragma unroll
            for (int tt = 0; tt < 2; ++tt) { const size_t tok = tok0 + 16 * tt + fr;
                f32x4 o[4]; float s = 0.f;
#pragma unroll
                for (int vt = 0; vt < 4; ++vt) { const u32x2 w = O1F[(((size_t)chh * 4 + vt) * 2 + tt) * 64 + lane]; o[vt] = (f32x4){bf_lo(w.x), bf_hi(w.x), bf_lo(w.y), bf_hi(w.y)};
                    o[vt] = MFMA16(Sf[vt][0], Qf[tt][0], o[vt]); o[vt] = MFMA16(Sf[vt][1], Qf[tt][1], o[vt]); s += (o[vt][0] + o[vt][1]) + (o[vt][2] + o[vt][3]); }
                s += __shfl_xor(s, 16); s += __shfl_xor(s, 32);
                const float mean = s * (1.0f / 64.0f); float q = 0.f;
#pragma unroll
                for (int vt = 0; vt < 4; ++vt) { o[vt] = o[vt] - mean; q += (o[vt][0] * o[vt][0] + o[vt][1] * o[vt][1]) + (o[vt][2] * o[vt][2] + o[vt][3] * o[vt][3]); }
                q += __shfl_xor(q, 16); q += __shfl_xor(q, 32);
                const float rs = 1.0f / sqrtf(q * (1.0f / 64.0f) + GN_EPS); const float bd = BDOT[tok * NH + h];
#pragma unroll
                for (int vt = 0; vt < 4; ++vt) { const int c = h * 64 + 16 * vt + 4 * fq; const f32x4 gw4 = *(const f32x4*)(gnw + c), gb4 = *(const f32x4*)(gnb + c), vv = ({ const u32x2 vw_ = *(const u32x2*)((const bf16*)SV + tok * RW + c); (f32x4){bf_lo(vw_.x), bf_hi(vw_.x), bf_lo(vw_.y), bf_hi(vw_.y)}; });
                    const u32x2 gg = *(const u32x2*)(SG + tok * RW + c); const f32x4 g4 = (f32x4){bf_lo(gg.x), bf_hi(gg.x), bf_lo(gg.y), bf_hi(gg.y)};
                    const f32x4 yv = (o[vt] * rs * gw4 + gb4 + bd * vv) * g4;
                    u32x2 w; w.x = cvtpk_s(yv[0], yv[1]); w.y = cvtpk_s(yv[2], yv[3]); *(u32x2*)(Y + tok * D + 512 + c) = w; } }
        }
#undef PACK8
#undef MFMA16
        if (BOTH(4)) GRID_BAR();
    }

    if (IN(5)) {
        pg8::Gemm g{Y, WOUT_T, M, D, D, 0, 0, nullptr}; pg8::StaticOrder S; S.init(M, D, G, (int)blockIdx.x);
        pg8::EpiResXn E{(const pg8::bf16_t*)XN, (const float*)(ws + WS_RMS), (pg8::bf16_t*)X1, D};
        pg8::gemm_phase<pg8::EpiResXn, pg8::StaticOrder, PG8_ALIGN, PG8_SP2>(lds, g, S, E);
        if (BOTH(5)) GRID_BAR();
    }

    if (IN(6)) {
        const float* gf = args.in[17]; const float* wr = args.in[18]; const float* br = args.in[19]; int* LISTG = (int*)(ws + WS_LIST);
        constexpr int WRS2 = 1032;
        LAS unsigned short* wH = (LAS unsigned short*)lds;
        LAS unsigned short* wL = wH + 32 * WRS2;
#pragma unroll
        for (int q = 0; q < 8; ++q) { const int i4 = tid + q * NWAVES * 64, kp = i4 >> 3, e0 = (i4 & 7) * 4;
            const f32x4 wa = *(const f32x4*)(wr + (2 * kp) * 32 + e0), wb = *(const f32x4*)(wr + (2 * kp + 1) * 32 + e0); const float ga = gf[2 * kp], gb = gf[2 * kp + 1];
#pragma unroll
            for (int j = 0; j < 4; ++j) { const float va = wa[j] * ga, vb = wb[j] * gb; const unsigned ha = f2bf(va), hb = f2bf(vb);
                const unsigned la = f2bf(va - __uint_as_float(ha << 16)), lb = f2bf(vb - __uint_as_float(hb << 16));
                ((LAS unsigned*)(wH + (e0 + j) * WRS2))[kp] = ha | (hb << 16); ((LAS unsigned*)(wL + (e0 + j) * WRS2))[kp] = la | (lb << 16); } }
        __syncthreads();
        const int fr = lane & 15, fq = lane >> 4;
        LAS unsigned* lcnt = (LAS unsigned*)(lds + 2 * 32 * WRS2 * 2);
        for (int it = 0; it < (M / 16 + NGW - 1) / NGW; ++it) {
            int tile = gw + it * NGW; const bool live = tile < M / 16; if (!live) tile = M / 16 - 1;
            if (tid < 64) lcnt[tid] = 0u;
            __syncthreads();
            const int t = tile * 16 + fr;
            const bf16* xrow = X1 + (size_t)t * D + 8 * fq;
            const LAS unsigned short* h0p = wH + fr * WRS2 + 8 * fq; const LAS unsigned short* h1p = wH + (16 + fr) * WRS2 + 8 * fq;
            const LAS unsigned short* l0p = wL + fr * WRS2 + 8 * fq; const LAS unsigned short* l1p = wL + (16 + fr) * WRS2 + 8 * fq;
            f32x4 acc0 = (f32x4){0.f, 0.f, 0.f, 0.f}, acc1 = acc0; float ss = 0.f;
#pragma unroll 4
            for (int sp = 0; sp < 32; ++sp) {
                const pg8::u32x4 xw = *(const pg8::u32x4*)(xrow + 32 * sp); const pg8::bf16x8 xb = __builtin_bit_cast(pg8::bf16x8, xw);
                const pg8::bf16x8 h0 = *(const LAS pg8::bf16x8*)(h0p + 32 * sp), h1 = *(const LAS pg8::bf16x8*)(h1p + 32 * sp), l0 = *(const LAS pg8::bf16x8*)(l0p + 32 * sp), l1 = *(const LAS pg8::bf16x8*)(l1p + 32 * sp);
                const f32x4 x0 = (f32x4){__uint_as_float(xw.x << 16), __uint_as_float(xw.x & 0xffff0000u), __uint_as_float(xw.y << 16), __uint_as_float(xw.y & 0xffff0000u)};
                const f32x4 x1 = (f32x4){__uint_as_float(xw.z << 16), __uint_as_float(xw.z & 0xffff0000u), __uint_as_float(xw.w << 16), __uint_as_float(xw.w & 0xffff0000u)};
                ss += ((x0[0] * x0[0] + x0[1] * x0[1]) + (x0[2] * x0[2] + x0[3] * x0[3])) + ((x1[0] * x1[0] + x1[1] * x1[1]) + (x1[2] * x1[2] + x1[3] * x1[3]));
                acc0 = __builtin_amdgcn_mfma_f32_16x16x32_bf16(l0, xb, acc0, 0, 0, 0); acc1 = __builtin_amdgcn_mfma_f32_16x16x32_bf16(l1, xb, acc1, 0, 0, 0);
                acc0 = __builtin_amdgcn_mfma_f32_16x16x32_bf16(h0, xb, acc0, 0, 0, 0); acc1 = __builtin_amdgcn_mfma_f32_16x16x32_bf16(h1, xb, acc1, 0, 0, 0);
            }
            ss += __shfl_xor(ss, 16); ss += __shfl_xor(ss, 32);
            const float rstd = 1.0f / sqrtf(ss * (1.f / D) + NORM_EPS);
            float lg[8]; const f32x4 b0 = *(const f32x4*)(br + 4 * fq), b1 = *(const f32x4*)(br + 16 + 4 * fq);
#pragma unroll
            for (int j = 0; j < 4; ++j) { lg[j] = acc0[j] * rstd + b0[j]; lg[4 + j] = acc1[j] * rstd + b1[j]; }
            int te[4]; float tv[4];
#pragma unroll
            for (int r = 0; r < 4; ++r) { float bv = lg[0]; int bi = 4 * fq;
#pragma unroll
                for (int j = 1; j < 8; ++j) { const int ei = (j < 4) ? 4 * fq + j : 16 + 4 * fq + (j - 4); if (lg[j] > bv) { bv = lg[j]; bi = ei; } }
#pragma unroll
                for (int o = 16; o <= 32; o <<= 1) { const float ov = __shfl_xor(bv, o); const int oi = __shfl_xor(bi, o); if (ov > bv || (ov == bv && oi < bi)) { bv = ov; bi = oi; } }
                te[r] = bi; tv[r] = bv;
#pragma unroll
                for (int j = 0; j < 8; ++j) { const int ei = (j < 4) ? 4 * fq + j : 16 + 4 * fq + (j - 4); if (ei == bi) lg[j] = -3.0e38f; } }
            const float e1 = __expf(tv[1] - tv[0]), e2 = __expf(tv[2] - tv[0]), e3 = __expf(tv[3] - tv[0]); const float inv = 1.0f / (1.0f + e1 + e2 + e3);
            int rk[4] = {0, 0, 0, 0};
            if (fq == 0 && live) {
#pragma unroll
                for (int r = 0; r < 4; ++r) rk[r] = (int)__hip_atomic_fetch_add(lcnt + te[r], 1u, __ATOMIC_RELAXED, __HIP_MEMORY_SCOPE_WORKGROUP); }
            __syncthreads();
            if (tid < 32) { const unsigned c = lcnt[tid]; lcnt[32 + tid] = c ? __hip_atomic_fetch_add(ctl + CW_CNT + tid, c, __ATOMIC_RELAXED, __HIP_MEMORY_SCOPE_AGENT) : 0u; }
            __syncthreads();
            if (fq == 0 && live) {
#pragma unroll
                for (int r = 0; r < 4; ++r) rk[r] += (int)lcnt[32 + te[r]];
                *(int4*)(TOKE + (size_t)t * 4) = make_int4(te[0], te[1], te[2], te[3]); *(f32x4*)(TOKG + (size_t)t * 4) = (f32x4){inv, e1 * inv, e2 * inv, e3 * inv}; *(int4*)(TOKR + (size_t)t * 4) = make_int4(rk[0], rk[1], rk[2], rk[3]);
#pragma unroll
                for (int r = 0; r < 4; ++r) LISTG[(size_t)te[r] * M + rk[r]] = t; }
            if (live)
#pragma unroll 4
            for (int r = 0; r < 16; ++r) { const float rs = __shfl(rstd, r); const size_t row = (size_t)(tile * 16 + r) * D;
                GAS u32x2* o8 = (GAS u32x2*)((unsigned char*)XN + row) + lane;
#pragma unroll
                for (int j = 0; j < 2; ++j) { const pg8::u32x4 xw = ((const GAS pg8::u32x4*)(X1 + row))[lane + 64 * j]; const f32x4 g0 = ((const GAS f32x4*)gf)[2 * (lane + 64 * j)], g1 = ((const GAS f32x4*)gf)[2 * (lane + 64 * j) + 1];
                    u32x2 w;
                    w.x = pk4_fp8(__uint_as_float(xw.x << 16) * rs * g0.x, __uint_as_float(xw.x & 0xffff0000u) * rs * g0.y, __uint_as_float(xw.y << 16) * rs * g0.z, __uint_as_float(xw.y & 0xffff0000u) * rs * g0.w, F8_H_SCALE);
                    w.y = pk4_fp8(__uint_as_float(xw.z << 16) * rs * g1.x, __uint_as_float(xw.z & 0xffff0000u) * rs * g1.y, __uint_as_float(xw.w << 16) * rs * g1.z, __uint_as_float(xw.w & 0xffff0000u) * rs * g1.w, F8_H_SCALE);
                    o8[64 * j] = w; } }
        }
        __syncthreads();
        if (BOTH(6)) GRID_BAR();
    }

#define MOE_BUILD_TABLES() \
        LAS int* tabL = (LAS int*)(lds + MOE_TAB_OFF); LAS bf16* biasL = (LAS bf16*)(lds + MOE_BIAS_OFF); LAS int* metaL = (LAS int*)(lds + MOE_TOK_OFF + MOE_MAXU * 512);     \
        if (wave == 0) { unsigned cntv = 0u; if (lane < 32) cntv = __hip_atomic_load(ctl + CW_CNT + lane, __ATOMIC_RELAXED, __HIP_MEMORY_SCOPE_AGENT); \
            const int ntile = (int)((cntv + 255u) >> 8); int incl = ntile; \
            _Pragma("unroll") for (int o = 1; o < 32; o <<= 1) { const int nn = __shfl_up(incl, o); if (lane >= o) incl += nn; } \
            const int tst = incl - ntile; \
            if (lane < 32) { metaL[lane] = tst; metaL[32 + lane] = (int)cntv; for (int i = 0; i < ntile; ++i) tabL[tst + i] = lane; } \
            if (lane == 31) metaL[64] = incl; } \
        LDS_WAIT(); __syncthreads(); \
        const int MT = metaL[64];
    if (IN(7)) {
        MOE_BUILD_TABLES();
        LAS unsigned short* tokL = (LAS unsigned short*)(lds + MOE_TOK_OFF);
        { const int pnw = ((int)blockIdx.x >> 3) % 8;
          const float* bgu = args.in[21];
          for (int i = tid; i < 32 * 256; i += NWAVES * 64) { const int e = i >> 8, j = i & 255; biasL[i] = (bf16)f2bf(bgu[e * 2048 + (j >> 7) * 1024 + pnw * 128 + (j & 127)]); }
          const int* LISTG = (const int*)(ws + WS_LIST); const int per_round = G / 8, mpx = per_round / 8, xcd = (int)blockIdx.x & 7, loc = (int)blockIdx.x >> 3;
          int tokv[MOE_MAXU * 256 / (NWAVES * 64)];
#pragma unroll
          for (int q = 0; q < MOE_MAXU * 256 / (NWAVES * 64); ++q) { const int idx = tid + q * NWAVES * 64, u = idx >> 8, r = idx & 255; const int mt = u * per_round + xcd * mpx + loc / 8; tokv[q] = 0;
              if (mt < MT) { const int e = tabL[mt]; const int lr = (mt - metaL[e]) * 256 + r; if (lr < metaL[32 + e]) tokv[q] = LISTG[(size_t)e * M + lr]; } }
#pragma unroll
          for (int q = 0; q < MOE_MAXU * 256 / (NWAVES * 64); ++q) tokL[tid + q * NWAVES * 64] = (unsigned short)tokv[q];
          LDS_WAIT(); __syncthreads(); }
        pg8::Gemm g{XN, WGU_T, SLOT_ROWS, 2048, D / 2, F8_W_BYTE, F8_H_BYTE, (const LAS unsigned short*)tokL};         pg8::MoeOrder S{(const LAS int*)tabL, MT, 8, G, (int)blockIdx.x};
        pg8::EpiSwiGLU E{ACT, FF, (const LAS unsigned short*)biasL};
        pg8::gemm_phase<pg8::EpiSwiGLU, pg8::MoeOrder, PG8_ALIGN, PG8_SP2, true, true>(lds, g, S, E);
        if (BOTH(7)) GRID_BAR();
    }

    if (IN(8)) {
        MOE_BUILD_TABLES();
        { const int pnw = ((int)blockIdx.x >> 3) % 4;
          const float* bdn = args.in[23];
          for (int i = tid; i < 32 * 256; i += NWAVES * 64) { const int e = i >> 8, j = i & 255; biasL[i] = (bf16)f2bf(bdn[e * 1024 + pnw * 256 + j]); }
          LDS_WAIT(); __syncthreads(); }
        pg8::Gemm g{ACT, WDN_T, SLOT_ROWS, 1024, FF / 2, F8_W_BYTE, F8_ACT_BYTE}; pg8::MoeOrder S{(const LAS int*)tabL, MT, 4, G, (int)blockIdx.x};
        pg8::EpiBiasLdsBf16 E{YSLOT, D, (const LAS unsigned short*)biasL};
        pg8::gemm_phase<pg8::EpiBiasLdsBf16, pg8::MoeOrder, PG8_ALIGN, PG8_SP2, true>(lds, g, S, E);
        if (BOTH(8)) GRID_BAR();
    }

    if (IN(9)) {
        const float* gfin = args.in[24];
        unsigned cntv = 0u; if (lane < 32) cntv = __hip_atomic_load(ctl + CW_CNT + lane, __ATOMIC_RELAXED, __HIP_MEMORY_SCOPE_AGENT);
        const int padded = (int)((cntv + 255u) & ~255u); int incl = padded;
#pragma unroll
        for (int o = 1; o < 32; o <<= 1) { const int nn = __shfl_up(incl, o); if (lane >= o) incl += nn; }
        const int pstart = incl - padded;
        for (int t = gw; t < M; t += NGW) {
            const GAS u32x2* xr = (const GAS u32x2*)(X1 + (size_t)t * D) + lane; f32x4 v[4];
#pragma unroll
            for (int j = 0; j < 4; ++j) { const u32x2 xw = xr[64 * j]; v[j] = (f32x4){__uint_as_float(xw.x << 16), __uint_as_float(xw.x & 0xffff0000u), __uint_as_float(xw.y << 16), __uint_as_float(xw.y & 0xffff0000u)}; }
            const int4 e4 = *(const int4*)(TOKE + (size_t)t * 4), r4 = *(const int4*)(TOKR + (size_t)t * 4); const f32x4 g4 = *(const f32x4*)(TOKG + (size_t)t * 4);
            const int dd[4] = {__shfl(pstart, e4.x) + r4.x, __shfl(pstart, e4.y) + r4.y, __shfl(pstart, e4.z) + r4.z, __shfl(pstart, e4.w) + r4.w}; const float gg[4] = {g4.x, g4.y, g4.z, g4.w};
#pragma unroll
            for (int q = 0; q < 4; ++q) { const GAS unsigned* yr = (const GAS unsigned*)((const unsigned char*)YSLOT + (size_t)dd[q] * D) + lane; const float gq8 = gg[q] * 0.125f;
#pragma unroll
                for (int j = 0; j < 4; ++j) { const unsigned w = yr[64 * j]; const f32x2_t lo = __builtin_amdgcn_cvt_pk_f32_fp8((int)w, false), hi = __builtin_amdgcn_cvt_pk_f32_fp8((int)w, true);
                    v[j].x += gq8 * lo.x; v[j].y += gq8 * lo.y; v[j].z += gq8 * hi.x; v[j].w += gq8 * hi.y; } }
            float s = 0.f;
#pragma unroll
            for (int j = 0; j < 4; ++j) s += (v[j].x * v[j].x + v[j].y * v[j].y) + (v[j].z * v[j].z + v[j].w * v[j].w);
            const float rstd = 1.0f / sqrtf(wave_sum(s) * (1.f / D) + NORM_EPS);
            GAS f32x4* orow = (GAS f32x4*)(args.out + (size_t)t * D) + lane;
#pragma unroll
            for (int j = 0; j < 4; ++j) { const f32x4 gq = ((const GAS f32x4*)gfin)[lane + 64 * j]; orow[64 * j] = v[j] * rstd * gq; }
        }
    }
#undef IN
#undef BOTH
#undef GRID_BAR
}

extern "C" void kernel_launch(void* const* d_in, const int* in_sizes, int n_in, void* d_out, int out_size, void* d_ws, size_t ws_size, hipStream_t stream) {
    static int grid = 0;
    if (grid == 0) {
        if (n_in != 25 || in_sizes[0] != M * D || out_size != M * D || ws_size < WS_END) { fprintf(stderr, "kernel_launch: unexpected shapes / workspace (%d inputs, ws %zu)\n", n_in, ws_size); grid = -1; return; }
        int dev = 0, cus = 0, per_cu = 0;
        if (hipGetDevice(&dev) != hipSuccess || hipDeviceGetAttribute(&cus, hipDeviceAttributeMultiprocessorCount, dev) != hipSuccess) { grid = -1; return; }
        if (hipFuncSetAttribute((const void*)mk_fwd, hipFuncAttributeMaxDynamicSharedMemorySize, LDS_BYTES) != hipSuccess) { grid = -1; return; }
        if (hipOccupancyMaxActiveBlocksPerMultiprocessor(&per_cu, (const void*)mk_fwd, NWAVES * 64, LDS_BYTES) != hipSuccess || per_cu < 1) { fprintf(stderr, "kernel_launch: occupancy query says %d blocks per CU\n", per_cu); grid = -1; (void)hipGetLastError(); return; }
        (void)hipGetLastError();
        grid = cus;
    }
    if (grid < 0) return;
    if (hipMemsetAsync((char*)d_ws + WS_CTL, 0, CTL_ZERO_BYTES, stream) != hipSuccess) return;
    Args a{};
    for (int i = 0; i < 25; ++i) a.in[i] = (const float*)d_in[i];
    a.out = (float*)d_out; a.ws = (unsigned char*)d_ws;
    if (N_LAUNCHES == 1) { a.ph_lo = 0; a.ph_hi = NPHASE; a.li = 0; hipLaunchKernelGGL(mk_fwd, dim3(grid), dim3(NWAVES * 64), LDS_BYTES, stream, a); }
    else for (int li = 0; li < NPHASE; ++li) { a.ph_lo = li; a.ph_hi = li + 1; a.li = li; hipLaunchKernelGGL(mk_fwd, dim3(grid), dim3(NWAVES * 64), LDS_BYTES, stream, a); }
}
```
